# Optimizing an MI355X kernel written in HIP

```python
import jax, jax.numpy as jnp
from jax import lax
import numpy as np

D_MODEL = 2048
BATCH = 1
SEQ = 8192
DEPTH = 4

GRID_W = 64
MEM_LEN = 256
EPS = 1e-6

NA_HEADS = 8
NA_HEAD_DIM = 128
NA_WIDTH = NA_HEADS * NA_HEAD_DIM
NA_ROWS_MAX = 8
NA_COLS = 16

MLA_HEADS = 8
MLA_Q_RANK = 512
MLA_KV_RANK = 256
MLA_NOPE_DIM = 128
MLA_ROPE_DIM = 64
MLA_V_DIM = 128
MLA_QK_DIM = MLA_NOPE_DIM + MLA_ROPE_DIM
MLA_WIDTH = MLA_HEADS * MLA_V_DIM
ROPE_THETA = 10000.0
Q_BLOCK = 128

D_MIX = NA_WIDTH + MLA_WIDTH
IN_WIDTH = 3 * NA_WIDTH + MLA_Q_RANK + MLA_KV_RANK + MLA_ROPE_DIM

X_HEADS = 4
X_HEAD_DIM = D_MODEL // X_HEADS

D_FF = ((8 * D_MODEL + 3 * 256 - 1) // (3 * 256)) * 256

kernel_name = "hybrid_natten_mla_encoder"


def rmsnorm(x, g):
    xf = x.astype(jnp.float32)
    y = xf * lax.rsqrt(jnp.mean(xf * xf, axis=-1, keepdims=True) + EPS)
    return (y * g.astype(jnp.float32)).astype(x.dtype)


def rope_tables(seq_len):
    inv = 1.0 / (ROPE_THETA ** (jnp.arange(0, MLA_ROPE_DIM, 2, dtype=jnp.float32) / MLA_ROPE_DIM))
    ang = jnp.arange(seq_len, dtype=jnp.float32)[:, None] * inv[None, :]
    return jnp.cos(ang), jnp.sin(ang)


def apply_rope(x, cos, sin):
    xf = x.astype(jnp.float32)
    x1, x2 = jnp.split(xf, 2, axis=-1)
    return jnp.concatenate([x1 * cos - x2 * sin, x1 * sin + x2 * cos], axis=-1).astype(x.dtype)


def neighbourhood_attention(q, k, v, rpb):
    B, S, H, dh = q.shape
    rows = S // GRID_W
    kr = min(NA_ROWS_MAX, rows)
    qg = q.reshape(B, rows, GRID_W, H, dh)
    kg = k.reshape(B, rows, GRID_W, H, dh)
    vg = v.reshape(B, rows, GRID_W, H, dh)
    row_start = jnp.clip(jnp.arange(rows) - kr // 2, 0, rows - kr)
    col_start = np.clip(np.arange(GRID_W) - NA_COLS // 2, 0, GRID_W - NA_COLS)
    col_idx = col_start[:, None] + np.arange(NA_COLS)[None, :]
    dc = col_idx - np.arange(GRID_W)[:, None] + (NA_COLS - 1)
    bias_c = rpb[:, :, dc]
    scale = dh ** -0.5

    def one_row(r):
        rs = row_start[r]
        kb = lax.dynamic_slice_in_dim(kg, rs, kr, axis=1)[:, :, col_idx]
        vb = lax.dynamic_slice_in_dim(vg, rs, kr, axis=1)[:, :, col_idx]
        qr = lax.dynamic_index_in_dim(qg, r, axis=1, keepdims=False)
        s = jnp.einsum('bqhd,brqkhd->bhqrk', qr, kb).astype(jnp.float32) * scale
        dr = rs + jnp.arange(kr) - r + (NA_ROWS_MAX - 1)
        bias = jnp.transpose(bias_c[:, dr], (0, 2, 1, 3)).astype(jnp.float32)
        s = s + bias[None]
        p = jax.nn.softmax(s.reshape(B, H, GRID_W, kr * NA_COLS), axis=-1)
        p = p.reshape(B, H, GRID_W, kr, NA_COLS).astype(v.dtype)
        return jnp.einsum('bhqrk,brqkhd->bqhd', p, vb)

    out = lax.map(one_row, jnp.arange(rows))
    return jnp.moveaxis(out, 0, 1).reshape(B, S, H * dh)


def latent_attention(c_q, c_kv, k_rope, q_norm, kv_norm, w_uq, w_ukv, cos, sin):
    B, S, _ = c_q.shape
    q = (rmsnorm(c_q, q_norm) @ w_uq).reshape(B, S, MLA_HEADS, MLA_QK_DIM)
    q_nope, q_rope = q[..., :MLA_NOPE_DIM], q[..., MLA_NOPE_DIM:]
    q_rope = apply_rope(q_rope, cos[:, None, :], sin[:, None, :])
    kv = (rmsnorm(c_kv, kv_norm) @ w_ukv).reshape(B, S, MLA_HEADS, MLA_NOPE_DIM + MLA_V_DIM)
    k_nope, v = kv[..., :MLA_NOPE_DIM], kv[..., MLA_NOPE_DIM:]
    k_r = apply_rope(k_rope, cos, sin)
    nb = S // Q_BLOCK
    qn_b = jnp.moveaxis(q_nope.reshape(B, nb, Q_BLOCK, MLA_HEADS, MLA_NOPE_DIM), 1, 0)
    qr_b = jnp.moveaxis(q_rope.reshape(B, nb, Q_BLOCK, MLA_HEADS, MLA_ROPE_DIM), 1, 0)
    scale = MLA_QK_DIM ** -0.5

    def block(args):
        qn, qr = args
        s = (jnp.einsum('bqhd,bkhd->bhqk', qn, k_nope)
             + jnp.einsum('bqhr,bkr->bhqk', qr, k_r)).astype(jnp.float32) * scale
        p = jax.nn.softmax(s, axis=-1).astype(v.dtype)
        return jnp.einsum('bhqk,bkhd->bqhd', p, v)

    out = lax.map(block, (qn_b, qr_b))
    return jnp.moveaxis(out, 0, 1).reshape(B, S, MLA_WIDTH)


def memory_attention(h, mem_n, w_q, w_k, w_v, w_o):
    B, S, _ = h.shape
    M = mem_n.shape[1]
    q = (h @ w_q).reshape(B, S, X_HEADS, X_HEAD_DIM)
    k = (mem_n @ w_k).reshape(B, M, X_HEADS, X_HEAD_DIM)
    v = (mem_n @ w_v).reshape(B, M, X_HEADS, X_HEAD_DIM)
    s = jnp.einsum('bqhd,bkhd->bhqk', q, k).astype(jnp.float32) * (X_HEAD_DIM ** -0.5)
    p = jax.nn.softmax(s, axis=-1).astype(v.dtype)
    o = jnp.einsum('bhqk,bkhd->bqhd', p, v).reshape(B, S, D_MODEL)
    return o @ w_o


def swiglu(h, w_gate, w_up, w_down):
    return (jax.nn.silu(h @ w_gate) * (h @ w_up)) @ w_down


def setup_inputs(seed: int = 0) -> dict:
    key = jax.random.key(seed)
    ks = jax.random.split(key, 24)

    def dense(k, shape, fan_in):
        return jax.random.normal(k, shape, jnp.float32) * (fan_in ** -0.5)

    def gain(k, shape):
        return 1.0 + 0.02 * jax.random.normal(k, shape, jnp.float32)

    L = DEPTH
    return {
        "x": jax.random.normal(ks[0], (BATCH, SEQ, D_MODEL), jnp.float32),
        "mem": jax.random.normal(ks[1], (BATCH, MEM_LEN, D_MODEL), jnp.float32),
        "ln_mix": gain(ks[2], (L, D_MODEL)),
        "w_in": dense(ks[3], (L, D_MODEL, IN_WIDTH), D_MODEL),
        "q_norm": gain(ks[4], (L, MLA_Q_RANK)),
        "kv_norm": gain(ks[5], (L, MLA_KV_RANK)),
        "w_uq": dense(ks[6], (L, MLA_Q_RANK, MLA_HEADS * MLA_QK_DIM), MLA_Q_RANK),
        "w_ukv": dense(ks[7], (L, MLA_KV_RANK, MLA_HEADS * (MLA_NOPE_DIM + MLA_V_DIM)), MLA_KV_RANK),
        "na_rpb": 0.1 * jax.random.normal(ks[8], (L, NA_HEADS, 2 * NA_ROWS_MAX - 1, 2 * NA_COLS - 1), jnp.float32),
        "na_out_norm": gain(ks[9], (L, NA_WIDTH)),
        "mla_out_norm": gain(ks[10], (L, MLA_WIDTH)),
        "w_out": dense(ks[11], (L, D_MIX, D_MODEL), D_MIX),
        "ln_mem": gain(ks[12], (L, D_MODEL)),
        "mem_norm": gain(ks[13], (L, D_MODEL)),
        "w_xq": dense(ks[14], (L, D_MODEL, D_MODEL), D_MODEL),
        "w_xk": dense(ks[15], (L, D_MODEL, D_MODEL), D_MODEL),
        "w_xv": dense(ks[16], (L, D_MODEL, D_MODEL), D_MODEL),
        "w_xo": dense(ks[17], (L, D_MODEL, D_MODEL), D_MODEL),
        "ln_ffn": gain(ks[18], (L, D_MODEL)),
        "w_gate": dense(ks[19], (L, D_MODEL, D_FF), D_MODEL),
        "w_up": dense(ks[20], (L, D_MODEL, D_FF), D_MODEL),
        "w_down": dense(ks[21], (L, D_FF, D_MODEL), D_FF),
        "final_norm": gain(ks[22], (D_MODEL,)),
    }


def reference(x, mem, ln_mix, w_in, q_norm, kv_norm, w_uq, w_ukv, na_rpb, na_out_norm,
              mla_out_norm, w_out, ln_mem, mem_norm, w_xq, w_xk, w_xv, w_xo, ln_ffn,
              w_gate, w_up, w_down, final_norm):
    B, S, _ = x.shape
    cos, sin = rope_tables(S)
    o1 = NA_WIDTH
    o2 = 2 * NA_WIDTH
    o3 = 3 * NA_WIDTH
    o4 = o3 + MLA_Q_RANK
    o5 = o4 + MLA_KV_RANK
    for l in range(DEPTH):
        h = rmsnorm(x, ln_mix[l])
        proj = h @ w_in[l]
        q_na = proj[..., :o1].reshape(B, S, NA_HEADS, NA_HEAD_DIM)
        k_na = proj[..., o1:o2].reshape(B, S, NA_HEADS, NA_HEAD_DIM)
        v_na = proj[..., o2:o3].reshape(B, S, NA_HEADS, NA_HEAD_DIM)
        c_q = proj[..., o3:o4]
        c_kv = proj[..., o4:o5]
        k_rope = proj[..., o5:]
        y_na = neighbourhood_attention(q_na, k_na, v_na, na_rpb[l])
        y_mla = latent_attention(c_q, c_kv, k_rope, q_norm[l], kv_norm[l], w_uq[l], w_ukv[l], cos, sin)
        y = jnp.concatenate([rmsnorm(y_na, na_out_norm[l]), rmsnorm(y_mla, mla_out_norm[l])], axis=-1)
        x = x + y @ w_out[l]
        h = rmsnorm(x, ln_mem[l])
        x = x + memory_attention(h, rmsnorm(mem, mem_norm[l]), w_xq[l], w_xk[l], w_xv[l], w_xo[l])
        h = rmsnorm(x, ln_ffn[l])
        x = x + swiglu(h, w_gate[l], w_up[l], w_down[l])
    return rmsnorm(x, final_norm)
```

```cpp
#include <hip/hip_runtime.h>
#include <cstdio>
#include <cstdint>
#include <cmath>
#define LAS __attribute__((address_space(3)))
#define GAS __attribute__((address_space(1)))
typedef unsigned short bf16_t;
typedef short bf16x8 __attribute__((ext_vector_type(8)));
typedef short s16x4 __attribute__((ext_vector_type(4)));
typedef float f32x2 __attribute__((ext_vector_type(2)));
typedef float f32x4 __attribute__((ext_vector_type(4)));
typedef float f32x16 __attribute__((ext_vector_type(16)));
typedef unsigned u32x2 __attribute__((ext_vector_type(2)));
typedef unsigned u32x4 __attribute__((ext_vector_type(4)));
typedef GAS unsigned gu32;

namespace fk {
constexpr int S = 8192, DM = 2048, NPROJ = 4096, DFF = 5632;
constexpr float EPS = 1e-6f;
constexpr float LOG2E = 1.4426950408889634f;
constexpr float QSC_NA = 0.08838834764831845f * LOG2E, QSC_MLA = 0.07216878364870323f * LOG2E, QSC_X = 0.04419417382415922f * LOG2E;

__device__ __forceinline__ int lane_id(int dep = 0) { unsigned z; asm volatile("s_mul_i32 %0, %1, 0" : "=s"(z) : "s"(dep)); return (int)__builtin_amdgcn_mbcnt_hi(~0u, __builtin_amdgcn_mbcnt_lo(~0u, z)); }
__device__ __forceinline__ float shi(float v, int src) { return __int_as_float(__builtin_amdgcn_ds_bpermute(src << 2, __float_as_int(v))); }
__device__ __forceinline__ float shx(float v, int mask, int lane) { return shi(v, lane ^ mask); }
typedef float f32x2_cv __attribute__((ext_vector_type(2))); typedef __bf16 bf16x2_cv __attribute__((ext_vector_type(2)));
__device__ __forceinline__ unsigned cvt_pk_bf16(float lo, float hi) { const f32x2_cv v = {lo, hi}; const bf16x2_cv b = __builtin_convertvector(v, bf16x2_cv); return __builtin_bit_cast(unsigned, b); }
__device__ __forceinline__ float bf_lo(unsigned w) { return __uint_as_float(w << 16); }
__device__ __forceinline__ float bf_hi(unsigned w) { return __uint_as_float(w & 0xffff0000u); }
__device__ __forceinline__ u32x4 pack8(f32x4 a, f32x4 b) { u32x4 w; w.x = cvt_pk_bf16(a[0], a[1]); w.y = cvt_pk_bf16(a[2], a[3]); w.z = cvt_pk_bf16(b[0], b[1]); w.w = cvt_pk_bf16(b[2], b[3]); return w; }

constexpr int BM = 256, BK = 64, HALF = 128, HTB = HALF * BK * 2, STAGE_BYTES = 8 * HTB, NXCD = 8, WGM = 8;
__host__ __device__ __forceinline__ int lds_byte(int r, int c) { const int st = (r >> 4) * 2 + (c >> 5), rr = r & 15, cc = c & 31, ob = rr * 64 + cc * 2; return st * 1024 + (ob ^ (((ob >> 9) & 1) << 5)); }
__host__ __device__ __forceinline__ void stage_rc(int b, int& R, int& C) { const int st = b / 1024, sb = b % 1024, swz = sb ^ (((sb >> 9) & 1) << 5); R = (st >> 1) * 16 + swz / 64; C = (st & 1) * 32 + (swz % 64) / 2; }
__host__ __device__ __forceinline__ int perm32(int rho) { const int n = rho >> 4, i = rho & 15; return 8 * (i >> 2) + 4 * n + (i & 3); }

struct Unit { int pm, pn, z; };
struct Gemm { const bf16_t* A; const bf16_t* Bt; int lda, ldb, K; long sAz, sBz; };

struct GridOrder {
    int nM, nN, nZ, nwg, G, c; int xm, xi;
    __device__ __forceinline__ void init(int nM_, int nN_, int nZ_, int G_, int c_) { nM = nM_; nN = nN_; nZ = nZ_; nwg = nM * nN * nZ; G = G_; c = c_; xm = 0; xi = 0; }
    __device__ __forceinline__ void init_x(int nN_, int xi_, int rank_, int nlim = 1 << 30) { nM = 32; nN = nN_; nZ = 1; nwg = 4 * nN_ < nlim ? 4 * nN_ : nlim; G = 32; c = rank_; xm = 1; xi = xi_; }
    __device__ __forceinline__ bool next(int i, Unit& u) const {
        const long L = (long)i * G + c; if (L >= nwg) return false;
        int wgid = (int)L, pm, pn, z;
        if (xm) { pm = 4 * xi + (wgid & 3); pn = wgid >> 2; z = 0; }
        else if (nZ == 1) {
            { const int q = nwg / NXCD, r = nwg % NXCD, xcd = wgid % NXCD, off = wgid / NXCD; wgid = (xcd < r ? xcd * (q + 1) : r * (q + 1) + (xcd - r) * q) + off; }
            const int nig = WGM * nN, gid = wgid / nig, fm = gid * WGM, gsz = (nM - fm) < WGM ? (nM - fm) : WGM;
            pm = fm + ((wgid % nig) % gsz); pn = (wgid % nig) / gsz; z = 0;
        } else { const int per = nM * nN; z = wgid / per; const int r = wgid % per; pm = r % nM; pn = r / nM; }
        u.pm = pm; u.pn = pn; u.z = z;
        return true;
    }
};

template <int NAI> using AccT = f32x4[NAI][2][4][2];
typedef AccT<2> Acc;

template <int NP4, int NAI = 2> __device__ __forceinline__ void wave_rstd(float (&rs)[2][4], const float* ssq, int ld, int row0, int lane, int fr, float inv_dim) {
    const GAS f32x4* pa = (const GAS f32x4*)(ssq + (size_t)(row0 + lane) * ld); const GAS f32x4* pb = (const GAS f32x4*)(ssq + (size_t)(row0 + (NAI == 2 ? 128 : 0) + lane) * ld);
    float a = 0.f, b = 0.f;
#pragma unroll
    for (int j = 0; j < NP4; ++j) { const f32x4 v = pa[j]; a += (v[0] + v[1]) + (v[2] + v[3]); if (NAI == 2) { const f32x4 w = pb[j]; b += (w[0] + w[1]) + (w[2] + w[3]); } }
    a = 1.0f / sqrtf(a * inv_dim + EPS); b = 1.0f / sqrtf(b * inv_dim + EPS);
#pragma unroll
    for (int m = 0; m < 4; ++m) { rs[0][m] = shi(a, m * 16 + fr); rs[1][m] = (NAI == 2) ? shi(b, m * 16 + fr) : 0.f; }
}
__device__ __forceinline__ float sumsq8(f32x4 a, f32x4 b) { return ((a[0] * a[0] + a[1] * a[1]) + (a[2] * a[2] + a[3] * a[3])) + ((b[0] * b[0] + b[1] * b[1]) + (b[2] * b[2] + b[3] * b[3])); }
__device__ __forceinline__ void rope8(f32x4& v0, f32x4& v1, f32x4 c, f32x4 s) {
    const f32x4 a = v0, b = v1;
    v0[0] = a[0] * c[0] - a[1] * s[0]; v0[1] = a[0] * s[0] + a[1] * c[0]; v0[2] = a[2] * c[1] - a[3] * s[1]; v0[3] = a[2] * s[1] + a[3] * c[1];
    v1[0] = b[0] * c[2] - b[1] * s[2]; v1[1] = b[0] * s[2] + b[1] * c[2]; v1[2] = b[2] * c[3] - b[3] * s[3]; v1[3] = b[2] * s[3] + b[3] * c[3];
}

template <int NP4> struct EpiRow {
    static constexpr bool HAS_MID = false, HAS_INIT = false;
    bf16_t* O; int ldc; long sOz;
    const float* ssq_in; int ld_in; float inv_dim;
    int rope_pn; int rope_full; const float* ctab; const float* stab;
    float* ssq_out; int ssq_pn0, ssq_pn1;
    __device__ __forceinline__ void mid(Acc&, const Unit&, int, int, int) const {}
    __device__ __forceinline__ void run(Acc& acc, const Unit& u, int wr, int wc, int fr, int fq, int lane, LAS unsigned char*) const {
        float rs[2][4];
        if constexpr (NP4 > 0) wave_rstd<NP4>(rs, ssq_in, ld_in, u.pm * BM + wr * 64, lane, fr, inv_dim);
        const bool do_ssq = (u.pn >= ssq_pn0 && u.pn < ssq_pn1);
        const bool rope_t = (u.pn >= rope_pn);
        bf16_t* base = O + (size_t)u.z * sOz;
        const int col0 = u.pn * BM + wc * 32 + 8 * fq;
#pragma unroll
        for (int ai = 0; ai < 2; ++ai)
#pragma unroll
            for (int m = 0; m < 4; ++m) {
                const int row = u.pm * BM + ai * HALF + wr * 64 + m * 16 + fr;
                const float s = (NP4 > 0) ? rs[ai][m] : 1.0f;
                float q = 0.f;
#pragma unroll
                for (int bj = 0; bj < 2; ++bj) {
                    f32x4 v0 = acc[ai][bj][m][0] * s, v1 = acc[ai][bj][m][1] * s;
                    if (rope_t && (rope_full || (bj == 0 && wc < 2))) {
                        const int j0 = 16 * (wc & 1) + 4 * fq;
                        const f32x4 c = *(const GAS f32x4*)(ctab + (size_t)row * 32 + j0), sn = *(const GAS f32x4*)(stab + (size_t)row * 32 + j0);
                        rope8(v0, v1, c, sn);
                    }
                    q += sumsq8(v0, v1);
                    *(GAS u32x4*)(base + (size_t)row * ldc + col0 + bj * HALF) = pack8(v0, v1);
                }
                if (do_ssq) { q += shx(q, 16, lane); q += shx(q, 32, lane); if (fq == 0) ((GAS float*)ssq_out)[(size_t)row * 16 + (u.pn - ssq_pn0) * 4 + wc] = q; }
            }
    }
};

template <bool MID> struct EpiRes {
    static constexpr bool HAS_MID = MID, HAS_INIT = true;
    const float* base32; bf16_t* xb; bf16_t* xo; float* ssq_x;
    const float* ssq_y;
    __device__ __forceinline__ void mid(Acc& acc, const Unit& u, int wr, int fr, int lane) const {
        if constexpr (MID) {
            const int row0 = u.pm * BM + wr * 64;
            float ra, rb;
            { const GAS f32x4* p = (const GAS f32x4*)(ssq_y + (size_t)(row0 + lane) * 16); const f32x4 a0 = p[0], a1 = p[1], b0 = p[2], b1 = p[3];
              const float na = ((a0[0] + a0[1]) + (a0[2] + a0[3])) + ((a1[0] + a1[1]) + (a1[2] + a1[3])), ml = ((b0[0] + b0[1]) + (b0[2] + b0[3])) + ((b1[0] + b1[1]) + (b1[2] + b1[3]));
              ra = sqrtf((ml * (1.0f / 1024.0f) + EPS) / (na * (1.0f / 1024.0f) + EPS)); }
            { const GAS f32x4* p = (const GAS f32x4*)(ssq_y + (size_t)(row0 + 128 + lane) * 16); const f32x4 a0 = p[0], a1 = p[1], b0 = p[2], b1 = p[3];
              const float na = ((a0[0] + a0[1]) + (a0[2] + a0[3])) + ((a1[0] + a1[1]) + (a1[2] + a1[3])), ml = ((b0[0] + b0[1]) + (b0[2] + b0[3])) + ((b1[0] + b1[1]) + (b1[2] + b1[3]));
              rb = sqrtf((ml * (1.0f / 1024.0f) + EPS) / (na * (1.0f / 1024.0f) + EPS)); }
#pragma unroll
            for (int m = 0; m < 4; ++m) { const float r0 = shi(ra, m * 16 + fr), r1 = shi(rb, m * 16 + fr);
#pragma unroll
                for (int bj = 0; bj < 2; ++bj)
#pragma unroll
                    for (int n = 0; n < 2; ++n) { acc[0][bj][m][n] *= r0; acc[1][bj][m][n] *= r1; } }
        }
    }
    __device__ __forceinline__ void init(Acc& acc, const Unit& u, int wr, int wc, int fr, int fq, int lane) const {
        float sc[2][4];
        if constexpr (MID) {
            const int row0 = u.pm * BM + wr * 64; float a, b;
            { const GAS f32x4* p = (const GAS f32x4*)(ssq_y + (size_t)(row0 + lane) * 16); const f32x4 a0 = p[0], a1 = p[1]; a = sqrtf((((a0[0] + a0[1]) + (a0[2] + a0[3])) + ((a1[0] + a1[1]) + (a1[2] + a1[3]))) * (1.0f / 1024.0f) + EPS); }
            { const GAS f32x4* p = (const GAS f32x4*)(ssq_y + (size_t)(row0 + 128 + lane) * 16); const f32x4 a0 = p[0], a1 = p[1]; b = sqrtf((((a0[0] + a0[1]) + (a0[2] + a0[3])) + ((a1[0] + a1[1]) + (a1[2] + a1[3]))) * (1.0f / 1024.0f) + EPS); }
#pragma unroll
            for (int m = 0; m < 4; ++m) { sc[0][m] = shi(a, m * 16 + fr); sc[1][m] = shi(b, m * 16 + fr); }
        }
        const int col0 = u.pn * BM + wc * 32 + 8 * fq;
        if (base32) {
#pragma unroll
            for (int ai = 0; ai < 2; ++ai)
#pragma unroll
                for (int m = 0; m < 4; ++m) {
                    const size_t off = (size_t)(u.pm * BM + ai * HALF + wr * 64 + m * 16 + fr) * DM + col0;
#pragma unroll
                    for (int bj = 0; bj < 2; ++bj) {
                        f32x4 b0 = *(const GAS f32x4*)(base32 + off + bj * HALF), b1 = *(const GAS f32x4*)(base32 + off + bj * HALF + 4);
                        if constexpr (MID) { b0 = b0 * sc[ai][m]; b1 = b1 * sc[ai][m]; }
                        acc[ai][bj][m][0] = b0; acc[ai][bj][m][1] = b1;
                    }
                }
        } else {
            u32x4 w[2][4][2];
#pragma unroll
            for (int ai = 0; ai < 2; ++ai)
#pragma unroll
                for (int m = 0; m < 4; ++m) {
                    const size_t off = (size_t)(u.pm * BM + ai * HALF + wr * 64 + m * 16 + fr) * DM + col0;
#pragma unroll
                    for (int bj = 0; bj < 2; ++bj) w[ai][m][bj] = *(const GAS u32x4*)(xb + off + bj * HALF);
                }
#pragma unroll
            for (int ai = 0; ai < 2; ++ai)
#pragma unroll
                for (int m = 0; m < 4; ++m)
#pragma unroll
                    for (int bj = 0; bj < 2; ++bj) {
                        const u32x4 v = w[ai][m][bj];
                        f32x4 b0 = (f32x4){bf_lo(v.x), bf_hi(v.x), bf_lo(v.y), bf_hi(v.y)}, b1 = (f32x4){bf_lo(v.z), bf_hi(v.z), bf_lo(v.w), bf_hi(v.w)};
                        if constexpr (MID) { b0 = b0 * sc[ai][m]; b1 = b1 * sc[ai][m]; }
                        acc[ai][bj][m][0] = b0; acc[ai][bj][m][1] = b1;
                    }
        }
    }
    __device__ __forceinline__ void run(Acc& acc, const Unit& u, int wr, int wc, int fr, int fq, int lane, LAS unsigned char*) const {
        float rs[2][4];
        if constexpr (MID) wave_rstd<2>(rs, ssq_y + 8, 16, u.pm * BM + wr * 64, lane, fr, 1.0f / 1024.0f);
        const int col0 = u.pn * BM + wc * 32 + 8 * fq;
#pragma unroll
        for (int ai = 0; ai < 2; ++ai)
#pragma unroll
            for (int m = 0; m < 4; ++m) {
                const int row = u.pm * BM + ai * HALF + wr * 64 + m * 16 + fr;
                const float s = MID ? rs[ai][m] : 1.0f;
                const size_t off = (size_t)row * DM + col0;
                float q = 0.f;
#pragma unroll
                for (int bj = 0; bj < 2; ++bj) {
                    const f32x4 v0 = acc[ai][bj][m][0] * s, v1 = acc[ai][bj][m][1] * s;
                    *(GAS u32x4*)(xo + off + bj * HALF) = pack8(v0, v1);
                    q += sumsq8(v0, v1);
                }
                q += shx(q, 16, lane); q += shx(q, 32, lane);
                if (fq == 0) ((GAS float*)ssq_x)[(size_t)row * 32 + u.pn * 4 + wc] = q;
            }
    }
};

template <int NAI> struct EpiSoftmaxT {
    static constexpr bool HAS_MID = false, HAS_INIT = false;
    bf16_t* P; const float* ssq_x;
    __device__ __forceinline__ void mid(AccT<NAI>&, const Unit&, int, int, int) const {}
    __device__ __forceinline__ void run(AccT<NAI>& acc, const Unit& u, int wr, int wc, int fr, int fq, int lane, LAS unsigned char* ex) const {
        float rs[2][4];
        wave_rstd<8, NAI>(rs, ssq_x, 32, u.pm * (HALF * NAI) + wr * 64, lane, fr, 1.0f / (float)DM);
        LAS f32x2* X = (LAS f32x2*)ex;
#pragma unroll
        for (int ai = 0; ai < NAI; ++ai)
#pragma unroll
            for (int m = 0; m < 4; ++m) {
                const float s = rs[ai][m]; float mx = -INFINITY;
#pragma unroll
                for (int bj = 0; bj < 2; ++bj)
#pragma unroll
                    for (int n = 0; n < 2; ++n) { f32x4 v = acc[ai][bj][m][n] * s; acc[ai][bj][m][n] = v; mx = fmaxf(mx, fmaxf(fmaxf(v[0], v[1]), fmaxf(v[2], v[3]))); }
                mx = fmaxf(mx, shx(mx, 16, lane)); mx = fmaxf(mx, shx(mx, 32, lane));
                float sm = 0.f;
#pragma unroll
                for (int bj = 0; bj < 2; ++bj)
#pragma unroll
                    for (int n = 0; n < 2; ++n) { f32x4 v = acc[ai][bj][m][n];
                        v[0] = __builtin_amdgcn_exp2f(v[0] - mx); v[1] = __builtin_amdgcn_exp2f(v[1] - mx); v[2] = __builtin_amdgcn_exp2f(v[2] - mx); v[3] = __builtin_amdgcn_exp2f(v[3] - mx);
                        acc[ai][bj][m][n] = v; sm += (v[0] + v[1]) + (v[2] + v[3]); }
                sm += shx(sm, 16, lane); sm += shx(sm, 32, lane);
                rs[ai][m] = mx;
                if (fq == 0) X[(ai * HALF + wr * 64 + m * 16 + fr) * 4 + wc] = (f32x2){mx, sm};
            }
        asm volatile("s_waitcnt lgkmcnt(0)" ::: "memory"); __builtin_amdgcn_s_barrier(); asm volatile("" ::: "memory");
        const int col0 = u.pn * BM + wc * 32 + 8 * fq;
#pragma unroll
        for (int ai = 0; ai < NAI; ++ai)
#pragma unroll
            for (int m = 0; m < 4; ++m) {
                const int rl = ai * HALF + wr * 64 + m * 16 + fr, row = u.pm * (HALF * NAI) + rl;
                const f32x2 a = X[rl * 4 + 0], b = X[rl * 4 + 1], c = X[rl * 4 + 2], d = X[rl * 4 + 3];
                const float M = fmaxf(fmaxf(a[0], b[0]), fmaxf(c[0], d[0]));
                const float tot = (a[1] * __builtin_amdgcn_exp2f(a[0] - M) + b[1] * __builtin_amdgcn_exp2f(b[0] - M)) + (c[1] * __builtin_amdgcn_exp2f(c[0] - M) + d[1] * __builtin_amdgcn_exp2f(d[0] - M));
                const float f = __builtin_amdgcn_exp2f(rs[ai][m] - M) / tot;
#pragma unroll
                for (int bj = 0; bj < 2; ++bj)
                    *(GAS u32x4*)(P + (size_t)row * 1024 + col0 + bj * HALF) = pack8(acc[ai][bj][m][0] * f, acc[ai][bj][m][1] * f);
            }
    }
};

template <int NAI> struct EpiSwigluT {
    static constexpr bool HAS_MID = false, HAS_INIT = false;
    bf16_t* H; const float* ssq_x;
    __device__ __forceinline__ void mid(AccT<NAI>&, const Unit&, int, int, int) const {}
    __device__ __forceinline__ void run(AccT<NAI>& acc, const Unit& u, int wr, int wc, int fr, int fq, int lane, LAS unsigned char*) const {
        float rs[2][4];
        wave_rstd<8, NAI>(rs, ssq_x, 32, u.pm * (HALF * NAI) + wr * 64, lane, fr, 1.0f / (float)DM);
        const int col0 = u.pn * HALF + wc * 32 + 8 * fq;
#pragma unroll
        for (int ai = 0; ai < NAI; ++ai)
#pragma unroll
            for (int m = 0; m < 4; ++m) {
                const int row = u.pm * (HALF * NAI) + ai * HALF + wr * 64 + m * 16 + fr; const float s = rs[ai][m];
                f32x4 o[2];
#pragma unroll
                for (int n = 0; n < 2; ++n) { const f32x4 g = acc[ai][0][m][n] * s, up = acc[ai][1][m][n] * s;
#pragma unroll
                    for (int e = 0; e < 4; ++e) o[n][e] = g[e] * up[e] * __builtin_amdgcn_rcpf(1.0f + __builtin_amdgcn_exp2f(-LOG2E * g[e])); }
                *(GAS u32x4*)(H + (size_t)row * DFF + col0) = pack8(o[0], o[1]);
            }
    }
};

typedef EpiSoftmaxT<2> EpiSoftmax; typedef EpiSwigluT<2> EpiSwiglu;

template <class Epi, class Sched>
__device__ __forceinline__ void gemm_phase(LAS unsigned char* lds, LAS unsigned char* ex, const Gemm g, const Sched& S_, const Epi& E, int wid_, bool skip_epi = false) {
    int wid = wid_; asm volatile("" : "+s"(wid));
    const int lane = lane_id(), tid = wid * 64 + lane, wr = wid >> 2, wc = wid & 3, fr = lane & 15, fq = lane >> 4;
    const int nt = g.K / BK;
    unsigned voffA[2], voffB[2];
#pragma unroll
    for (int i = 0; i < 2; ++i) { int R, C; stage_rc(tid * 16 + i * 8192, R, C); const int Rb = (R & ~31) + perm32(R & 31);
        voffA[i] = (unsigned)(R * g.lda + C) * 2u; voffB[i] = (unsigned)(Rb * g.ldb + C) * 2u; }
    const size_t kstep = (size_t)(BK * 2);
    const size_t hstepA = (size_t)HALF * g.lda * 2, hstepB = (size_t)HALF * g.ldb * 2;
    const unsigned ldsw = (unsigned)wid * 1024u;
    const int aoff = lds_byte(wr * 64 + fr, fq * 8), boff = lds_byte(wc * 32 + fr, fq * 8);
#define PG8_SA(b, h) (((b) * 2 + (h)) * HTB)
#define PG8_SB(b, h) ((4 + (b) * 2 + (h)) * HTB)
#define PG8_STAGE(bufoff, gbase, voff) do { _Pragma("unroll") for (int _i = 0; _i < 2; ++_i) \
        __builtin_amdgcn_global_load_lds((const unsigned*)((const char*)(gbase) + (voff)[_i]), (LAS unsigned*)(lds + (bufoff) + ldsw + _i * 8192), 16, 0, 0); } while (0)
#define PG8_LDA(dst, b, h) do { _Pragma("unroll") for (int m = 0; m < 4; ++m) _Pragma("unroll") for (int k = 0; k < 2; ++k) dst[m][k] = *(const LAS bf16x8*)(lds + PG8_SA(b, h) + aoff + m * 2048 + k * 1024); } while (0)
#define PG8_LDB(dst, b, h) do { _Pragma("unroll") for (int n = 0; n < 2; ++n) _Pragma("unroll") for (int k = 0; k < 2; ++k) dst[n][k] = *(const LAS bf16x8*)(lds + PG8_SB(b, h) + boff + n * 2048 + k * 1024); } while (0)
#define PG8_MMA(ai, bj, At, Bt) do { __builtin_amdgcn_s_setprio(1); _Pragma("unroll") for (int m = 0; m < 4; ++m) _Pragma("unroll") for (int n = 0; n < 2; ++n) _Pragma("unroll") for (int k = 0; k < 2; ++k) \
        acc[ai][bj][m][n] = __builtin_amdgcn_mfma_f32_16x16x32_bf16(Bt[n][k], At[m][k], acc[ai][bj][m][n], 0, 0, 0); __builtin_amdgcn_s_setprio(0); } while (0)
#define PG8_WAIT_V(n) asm volatile("s_waitcnt vmcnt(" #n ")" ::: "memory")
#define PG8_WAIT_L(n) asm volatile("s_waitcnt lgkmcnt(" #n ")" ::: "memory")
#define PG8_BAR __builtin_amdgcn_s_barrier()
#define PG8_SCHED __builtin_amdgcn_sched_barrier(0)
    Unit cur, nxt; int ui = 0;
    if (!S_.next(0, cur)) return;
    Acc acc;
    if constexpr (Epi::HAS_INIT) { const int ln = lane_id(); E.init(acc, cur, wr, wc, ln & 15, ln >> 4, ln); }
    else {
#pragma unroll
    for (int a = 0; a < 2; ++a)
#pragma unroll
        for (int b = 0; b < 2; ++b)
#pragma unroll
            for (int m = 0; m < 4; ++m)
#pragma unroll
                for (int n = 0; n < 2; ++n) acc[a][b][m][n] = (f32x4){0.f, 0.f, 0.f, 0.f};
    }
    bf16x8 At[4][2], B0[2][2], B1[2][2];
    const char* cA = (const char*)(g.A + (size_t)cur.z * g.sAz) + (size_t)cur.pm * 2 * hstepA; const char* cB = (const char*)(g.Bt + (size_t)cur.z * g.sBz) + (size_t)cur.pn * 2 * hstepB;
    PG8_STAGE(PG8_SB(0, 0), cB, voffB); PG8_STAGE(PG8_SB(0, 1), cB + hstepB, voffB); PG8_STAGE(PG8_SA(0, 0), cA, voffA); PG8_STAGE(PG8_SA(0, 1), cA + hstepA, voffA);
    if (wr == 1) PG8_BAR;
    PG8_WAIT_V(2); PG8_BAR;
    PG8_STAGE(PG8_SB(1, 0), cB + kstep, voffB); PG8_STAGE(PG8_SA(1, 0), cA + kstep, voffA); PG8_STAGE(PG8_SB(1, 1), cB + hstepB + kstep, voffB);
    PG8_WAIT_V(6); PG8_BAR;
    for (;;) {
        const bool has_next = S_.next(ui + 1, nxt);
        const char* nA = has_next ? (const char*)(g.A + (size_t)nxt.z * g.sAz) + (size_t)nxt.pm * 2 * hstepA : cA;
        const char* nB = has_next ? (const char*)(g.Bt + (size_t)nxt.z * g.sBz) + (size_t)nxt.pn * 2 * hstepB : cB;
        for (int t = 0; t < nt; t += 2) {
            const bool last = (t == nt - 2);
            if constexpr (Epi::HAS_MID) { if (t == (nt >> 1)) { const int ln = lane_id(t + ui); E.mid(acc, cur, wr, ln & 15, ln); } }
            const char* a1 = cA + (size_t)(t + 1) * kstep;
            const char* a2 = last ? nA : cA + (size_t)(t + 2) * kstep; const char* b2 = last ? nB : cB + (size_t)(t + 2) * kstep;
            const char* a3 = a2 + kstep; const char* b3 = b2 + kstep;
            PG8_LDB(B0, 0, 0); PG8_LDB(B1, 0, 1); PG8_SCHED; PG8_LDA(At, 0, 0); PG8_STAGE(PG8_SA(1, 1), a1 + hstepA, voffA);
            PG8_WAIT_V(8); PG8_WAIT_L(0); PG8_BAR; PG8_MMA(0, 0, At, B0); PG8_MMA(0, 1, At, B1); PG8_BAR; PG8_SCHED;
            PG8_LDA(At, 0, 1); PG8_STAGE(PG8_SB(0, 0), b2, voffB); PG8_STAGE(PG8_SB(0, 1), b2 + hstepB, voffB); PG8_STAGE(PG8_SA(0, 0), a2, voffA);
            PG8_WAIT_V(8); PG8_WAIT_L(0); PG8_BAR; PG8_MMA(1, 0, At, B0); PG8_MMA(1, 1, At, B1); PG8_BAR; PG8_SCHED;
            PG8_LDB(B0, 1, 0); PG8_LDB(B1, 1, 1); PG8_SCHED; PG8_LDA(At, 1, 0); PG8_STAGE(PG8_SA(0, 1), a2 + hstepA, voffA);
            PG8_WAIT_V(8); PG8_WAIT_L(0); PG8_BAR; PG8_MMA(0, 0, At, B0); PG8_MMA(0, 1, At, B1); PG8_BAR; PG8_SCHED;
            PG8_LDA(At, 1, 1); PG8_STAGE(PG8_SB(1, 0), b3, voffB); PG8_STAGE(PG8_SB(1, 1), b3 + hstepB, voffB); PG8_STAGE(PG8_SA(1, 0), a3, voffA);
            PG8_WAIT_V(8); PG8_WAIT_L(0); PG8_BAR; PG8_MMA(1, 0, At, B0); PG8_MMA(1, 1, At, B1); PG8_BAR; PG8_SCHED;
        }
        if (wr == 0) PG8_BAR;
        if (!skip_epi) { const int ln = lane_id(ui); E.run(acc, cur, wr, wc, ln & 15, ln >> 4, ln, ex); }
        if (!has_next) break;
        if constexpr (Epi::HAS_INIT) { const int ln = lane_id(ui + 1); E.init(acc, nxt, wr, wc, ln & 15, ln >> 4, ln); }
        else {
#pragma unroll
        for (int a = 0; a < 2; ++a)
#pragma unroll
            for (int b = 0; b < 2; ++b)
#pragma unroll
                for (int m = 0; m < 4; ++m)
#pragma unroll
                    for (int n = 0; n < 2; ++n) acc[a][b][m][n] = (f32x4){0.f, 0.f, 0.f, 0.f};
        }
        cur = nxt; cA = nA; cB = nB; ++ui;
        if (wr == 1) PG8_BAR;
    }
    PG8_WAIT_V(0);
    PG8_BAR;
#undef PG8_SA
#undef PG8_SB
#undef PG8_STAGE
#undef PG8_LDA
#undef PG8_LDB
#undef PG8_MMA
#undef PG8_WAIT_V
#undef PG8_WAIT_L
#undef PG8_BAR
#undef PG8_SCHED
}

struct OneUnit { int pm, pn, has;
    __device__ __forceinline__ bool next(int i, Unit& u) const { u.pm = pm; u.pn = pn; u.z = 0; return i == 0 && has != 0; } };

template <class Epi, class Sched>
__device__ __forceinline__ void gemm_phase128(LAS unsigned char* lds, LAS unsigned char* ex, const Gemm g, const Sched& S_, const Epi& E, int wid_) {
    int wid = wid_; asm volatile("" : "+s"(wid));
    const int lane = lane_id(), tid = wid * 64 + lane, wr = wid >> 2, wc = wid & 3, fr = lane & 15;
    const int nt = g.K / BK;
    unsigned voffA[2], voffB[2];
#pragma unroll
    for (int i = 0; i < 2; ++i) { int R, C; stage_rc(tid * 16 + i * 8192, R, C); const int Rb = (R & ~31) + perm32(R & 31);
        voffA[i] = (unsigned)(R * g.lda + C) * 2u; voffB[i] = (unsigned)(Rb * g.ldb + C) * 2u; }
    const size_t kstep = (size_t)(BK * 2);
    const size_t hstepA = (size_t)HALF * g.lda * 2, hstepB = (size_t)HALF * g.ldb * 2;
    const unsigned ldsw = (unsigned)wid * 1024u;
    const int aoff = lds_byte(wr * 64 + fr, (lane >> 4) * 8), boff = lds_byte(wc * 32 + fr, (lane >> 4) * 8);
    constexpr int SLOT = 3 * HTB;
#define P1_STG(off, gbase, voff) do { _Pragma("unroll") for (int _i = 0; _i < 2; ++_i) \
        __builtin_amdgcn_global_load_lds((const unsigned*)((const char*)(gbase) + (voff)[_i]), (LAS unsigned*)(lds + (off) + ldsw + _i * 8192), 16, 0, 0); } while (0)
#define P1_STAGE(slot, pA, pB) do { P1_STG((slot) * SLOT, pA, voffA); P1_STG((slot) * SLOT + HTB, pB, voffB); P1_STG((slot) * SLOT + 2 * HTB, (pB) + hstepB, voffB); } while (0)
#define P1_LDA(dst, slot) do { _Pragma("unroll") for (int m = 0; m < 4; ++m) _Pragma("unroll") for (int k = 0; k < 2; ++k) dst[m][k] = *(const LAS bf16x8*)(lds + (slot) * SLOT + aoff + m * 2048 + k * 1024); } while (0)
#define P1_LDB(dst, slot, h) do { _Pragma("unroll") for (int n = 0; n < 2; ++n) _Pragma("unroll") for (int k = 0; k < 2; ++k) dst[n][k] = *(const LAS bf16x8*)(lds + (slot) * SLOT + (1 + (h)) * HTB + boff + n * 2048 + k * 1024); } while (0)
#define P1_MMA(bj, At, Bt) do { __builtin_amdgcn_s_setprio(1); _Pragma("unroll") for (int m = 0; m < 4; ++m) _Pragma("unroll") for (int n = 0; n < 2; ++n) _Pragma("unroll") for (int k = 0; k < 2; ++k) \
        acc[0][bj][m][n] = __builtin_amdgcn_mfma_f32_16x16x32_bf16(Bt[n][k], At[m][k], acc[0][bj][m][n], 0, 0, 0); __builtin_amdgcn_s_setprio(0); } while (0)
#define P1_WAIT_V(n) asm volatile("s_waitcnt vmcnt(" #n ")" ::: "memory")
#define P1_WAIT_L(n) asm volatile("s_waitcnt lgkmcnt(" #n ")" ::: "memory")
#define P1_BAR __builtin_amdgcn_s_barrier()
#define P1_SCHED __builtin_amdgcn_sched_barrier(0)
    Unit cur, nxt; int ui = 0;
    if (!S_.next(0, cur)) return;
    AccT<1> acc;
#pragma unroll
    for (int b = 0; b < 2; ++b)
#pragma unroll
        for (int m = 0; m < 4; ++m)
#pragma unroll
            for (int n = 0; n < 2; ++n) acc[0][b][m][n] = (f32x4){0.f, 0.f, 0.f, 0.f};
    bf16x8 At[4][2], B0[2][2], B1[2][2];
    const char* cA = (const char*)g.A + (size_t)cur.pm * hstepA; const char* cB = (const char*)g.Bt + (size_t)cur.pn * 2 * hstepB;
    P1_STAGE(0, cA, cB); P1_STAGE(1, cA + kstep, cB + kstep);
    if (wr == 1) P1_BAR;
    P1_WAIT_V(6); P1_BAR; P1_BAR;
    int slot = 0;
    for (;;) {
        const bool has_next = S_.next(ui + 1, nxt);
        const char* nA = has_next ? (const char*)g.A + (size_t)nxt.pm * hstepA : cA;
        const char* nB = has_next ? (const char*)g.Bt + (size_t)nxt.pn * 2 * hstepB : cB;
        for (int t = 0; t < nt; ++t) {
            const int t2 = t + 2;
            const char* a2 = (t2 < nt) ? cA + (size_t)t2 * kstep : nA + (size_t)(t2 - nt) * kstep;
            const char* b2 = (t2 < nt) ? cB + (size_t)t2 * kstep : nB + (size_t)(t2 - nt) * kstep;
            const int s2 = (slot == 0) ? 2 : slot - 1;
            P1_LDB(B0, slot, 0); P1_LDB(B1, slot, 1); P1_SCHED; P1_LDA(At, slot); P1_STAGE(s2, a2, b2);
            P1_WAIT_V(6); P1_WAIT_L(0); P1_BAR; P1_MMA(0, At, B0); P1_MMA(1, At, B1); P1_BAR; P1_SCHED;
            slot = (slot == 2) ? 0 : slot + 1;
        }
        if (wr == 0) P1_BAR;
        { const int ln = lane_id(ui); E.run(acc, cur, wr, wc, ln & 15, ln >> 4, ln, ex); }
        if (!has_next) break;
#pragma unroll
        for (int b = 0; b < 2; ++b)
#pragma unroll
            for (int m = 0; m < 4; ++m)
#pragma unroll
                for (int n = 0; n < 2; ++n) acc[0][b][m][n] = (f32x4){0.f, 0.f, 0.f, 0.f};
        cur = nxt; cA = nA; cB = nB; ++ui;
        if (wr == 1) P1_BAR;
    }
    P1_WAIT_V(0);
    P1_BAR;
#undef P1_STG
#undef P1_STAGE
#undef P1_LDA
#undef P1_LDB
#undef P1_MMA
#undef P1_WAIT_V
#undef P1_WAIT_L
#undef P1_BAR
#undef P1_SCHED
}
}
#ifndef X_PRIO47
#define X_PRIO47 0
#endif
#ifndef X_LATE
#define X_LATE 0
#endif
namespace att {
using namespace fk;
constexpr int NW = 8, QBLK = 32, KVBLK = 64;
constexpr int SHM_V = KVBLK * 128 * 2;
template <int MODE> struct AttL { static constexpr int KSLOT = MODE ? 16384 : 24576, OFF_K = 0, OFF_V = 3 * KSLOT, OFF_WS = OFF_V + 4 * SHM_V, OFF_BIAS = OFF_WS + NW * 64 * 4, END = OFF_BIAS + 4096; };
constexpr int OSTG_PITCH = 272, OSTG_WAVE = 32 * OSTG_PITCH;
static_assert(NW * OSTG_WAVE <= AttL<0>::OFF_WS && NW * OSTG_WAVE <= AttL<1>::OFF_WS && AttL<0>::END <= 147456 && AttL<1>::END <= 147456, "attention LDS map");
constexpr float THR2 = 11.0f;
#define KSWZ(row, colB) ((row) * 256 + ((colB) ^ (((row) & 7) << 4)))
#define KRSWZ(row, colB) ((row) * 128 + ((colB) ^ (((row) & 7) << 4)))
#define SBAR() __builtin_amdgcn_sched_barrier(0)
__device__ __forceinline__ int crow(int r, int hi) { return (r & 3) + 8 * (r >> 2) + 4 * hi; }

__device__ __forceinline__ void partialSM(f32x16& p0, f32x16& p1, float& m_reg, float& mn, float& alpha) {
  float pmax = p0[0];
#pragma unroll
  for (int r = 1; r < 16; ++r) pmax = fmaxf(pmax, p0[r]);
#pragma unroll
  for (int r = 0; r < 16; ++r) pmax = fmaxf(pmax, p1[r]);
  { auto rr = __builtin_amdgcn_permlane32_swap(__float_as_uint(pmax), __float_as_uint(pmax), false, false);
    pmax = fmaxf(__uint_as_float(rr[0]), __uint_as_float(rr[1])); }
  if (__builtin_expect(__all(pmax - m_reg <= THR2), 1)) { mn = m_reg; alpha = 1.f; }
  else { mn = fmaxf(m_reg, pmax); alpha = __builtin_amdgcn_exp2f(m_reg - mn); m_reg = mn; }
#pragma unroll
  for (int r = 0; r < 16; ++r) p0[r] = p0[r] - mn;
#pragma unroll
  for (int r = 0; r < 16; ++r) p1[r] = p1[r] - mn;
#pragma unroll
  for (int r = 0; r < 16; ++r) p0[r] = __builtin_amdgcn_exp2f(p0[r]);
}
__device__ __forceinline__ void finishSM(f32x16& p0, f32x16& p1, float alpha, float& l_reg, bf16x8& pa0, bf16x8& pa1, bf16x8& pa2, bf16x8& pa3) {
#pragma unroll
  for (int r = 0; r < 16; ++r) p1[r] = __builtin_amdgcn_exp2f(p1[r]);
  float ps = 0;
#pragma unroll
  for (int r = 0; r < 16; ++r) ps += p0[r];
#pragma unroll
  for (int r = 0; r < 16; ++r) ps += p1[r];
  { auto rr = __builtin_amdgcn_permlane32_swap(__float_as_uint(ps), __float_as_uint(ps), false, false);
    ps = __uint_as_float(rr[0]) + __uint_as_float(rr[1]); }
  l_reg = l_reg * alpha + ps;
#define PK4(P, BASE, OUT) do { u32x4 w = {cvt_pk_bf16(P[BASE + 0], P[BASE + 1]), cvt_pk_bf16(P[BASE + 2], P[BASE + 3]), cvt_pk_bf16(P[BASE + 4], P[BASE + 5]), cvt_pk_bf16(P[BASE + 6], P[BASE + 7])}; \
    OUT = *reinterpret_cast<bf16x8*>(&w); } while (0)
  PK4(p0, 0, pa0); PK4(p0, 8, pa1); PK4(p1, 0, pa2); PK4(p1, 8, pa3);
#undef PK4
}
__device__ __forceinline__ void softmax_ref(f32x16& p0, f32x16& p1, f32x16& negm, bool& valid, float& alpha, bf16x8& pa0, bf16x8& pa1, bf16x8& pa2, bf16x8& pa3, float& l_reg) {
  float pmax;
  { float m0 = fmaxf(p0[0], p0[1]), m1 = fmaxf(p0[2], p0[3]), m2 = fmaxf(p1[0], p1[1]), m3 = fmaxf(p1[2], p1[3]);
#pragma unroll
    for (int r = 4; r < 16; r += 4) { m0 = fmaxf(fmaxf(m0, p0[r]), p0[r + 1]); m1 = fmaxf(fmaxf(m1, p0[r + 2]), p0[r + 3]); m2 = fmaxf(fmaxf(m2, p1[r]), p1[r + 1]); m3 = fmaxf(fmaxf(m3, p1[r + 2]), p1[r + 3]); }
    pmax = fmaxf(fmaxf(m0, m1), fmaxf(m2, m3)); }
  { auto rr = __builtin_amdgcn_permlane32_swap(__float_as_uint(pmax), __float_as_uint(pmax), false, false);
    pmax = fmaxf(__uint_as_float(rr[0]), __uint_as_float(rr[1])); }
  alpha = 1.f;
  if (!__builtin_expect(__all(valid && pmax <= THR2), 1)) {
    const bool fin = pmax > -INFINITY;
    const float d = valid ? fmaxf(pmax, 0.f) : (fin ? pmax : 0.f);
    alpha = valid ? __builtin_amdgcn_exp2f(-d) : 1.f;
    valid = valid || fin;
#pragma unroll
    for (int r = 0; r < 16; ++r) { p0[r] -= d; p1[r] -= d; negm[r] -= d; }
  }
#pragma unroll
  for (int r = 0; r < 16; ++r) p0[r] = __builtin_amdgcn_exp2f(p0[r]);
#pragma unroll
  for (int r = 0; r < 16; ++r) p1[r] = __builtin_amdgcn_exp2f(p1[r]);
  { float s0 = p0[0] + p1[0], s1 = p0[1] + p1[1], s2 = p0[2] + p1[2], s3 = p0[3] + p1[3];
#pragma unroll
    for (int r = 4; r < 16; r += 4) { s0 += p0[r] + p1[r]; s1 += p0[r + 1] + p1[r + 1]; s2 += p0[r + 2] + p1[r + 2]; s3 += p0[r + 3] + p1[r + 3]; }
    l_reg = l_reg * alpha + ((s0 + s1) + (s2 + s3)); }
#define PK4(P, BASE, OUT) do { u32x4 w = {cvt_pk_bf16(P[BASE + 0], P[BASE + 1]), cvt_pk_bf16(P[BASE + 2], P[BASE + 3]), cvt_pk_bf16(P[BASE + 4], P[BASE + 5]), cvt_pk_bf16(P[BASE + 6], P[BASE + 7])}; \
    OUT = *reinterpret_cast<bf16x8*>(&w); } while (0)
  PK4(p0, 0, pa0); PK4(p0, 8, pa1); PK4(p1, 0, pa2); PK4(p1, 8, pa3);
#undef PK4
}
template <int OFF> __device__ __forceinline__ bf16x8 lds_rd128(int addr) { bf16x8 r; asm volatile("ds_read_b128 %0, %1 offset:%2" : "=v"(r) : "v"(addr), "i"(OFF)); return r; }
template <int NP> __device__ __forceinline__ void qkt_pipe(f32x16& p0, f32x16& p1, const f32x16& cinit, const int (&an)[8], const int (&ar)[4], const bf16x8* qr) {
  bf16x8 ka[4], kb[4];
#define KRD(d0) do { constexpr int s_ = (d0) & 3; \
    if constexpr ((d0) < 8) { ka[s_] = lds_rd128<0>(an[(d0) & 7]); kb[s_] = lds_rd128<8192>(an[(d0) & 7]); } \
    else { ka[s_] = lds_rd128<16384>(ar[(d0) & 3]); kb[s_] = lds_rd128<16384 + 4096>(ar[(d0) & 3]); } } while (0)
#define KMM(d0) do { constexpr int s_ = (d0) & 3; constexpr int left_ = (NP - 1 - (d0)) < 2 ? (NP - 1 - (d0)) : 2; \
    if constexpr (left_ == 2) asm volatile("s_waitcnt lgkmcnt(4)" : "+v"(ka[s_]), "+v"(kb[s_])); else if constexpr (left_ == 1) asm volatile("s_waitcnt lgkmcnt(2)" : "+v"(ka[s_]), "+v"(kb[s_])); else asm volatile("s_waitcnt lgkmcnt(0)" : "+v"(ka[s_]), "+v"(kb[s_])); \
    if constexpr ((d0) == 0) { p0 = __builtin_amdgcn_mfma_f32_32x32x16_bf16(ka[s_], qr[d0], cinit, 0, 0, 0); p1 = __builtin_amdgcn_mfma_f32_32x32x16_bf16(kb[s_], qr[d0], cinit, 0, 0, 0); } \
    else { p0 = __builtin_amdgcn_mfma_f32_32x32x16_bf16(ka[s_], qr[d0], p0, 0, 0, 0); p1 = __builtin_amdgcn_mfma_f32_32x32x16_bf16(kb[s_], qr[d0], p1, 0, 0, 0); } \
    if constexpr ((d0) + 3 < NP) KRD((d0) + 3); } while (0)
  KRD(0); KRD(1); KRD(2);
  KMM(0); KMM(1); KMM(2); KMM(3); KMM(4); KMM(5); KMM(6); KMM(7);
  if constexpr (NP > 8) { KMM(8); KMM(9); KMM(10); KMM(11); }
#undef KRD
#undef KMM
}
__device__ __forceinline__ int v_st(int k, int c) { const int kk = (k & ~0xC) | ((k & 4) << 1) | ((k & 8) >> 1); return ((kk >> 3) * 4 + (c >> 5)) * 512 + ((kk & 7) * 32 + (c & 31)) * 2; }
__device__ __forceinline__ int v_rd_base(int lane) { return ((lane & 3) << 3) | (((lane >> 2) & 3) << 6) | (((lane >> 4) & 1) << 5) | (((lane >> 5) & 1) << 8); }
constexpr int v_rd_off(int d0, int ks, int half) { return d0 * 512 + ks * 4096 + half * 2048; }
template <int OFF> __device__ __forceinline__ s16x4 tr_read(int vb) {
  s16x4 r; asm volatile("ds_read_b64_tr_b16 %0, %1 offset:%2" : "=&v"(r) : "v"(vb), "i"(OFF) : "memory"); return r;
}
template <int D0> __device__ __forceinline__ void pv_one(f32x16& od, int vb, bf16x8 pa0, bf16x8 pa1, bf16x8 pa2, bf16x8 pa3) {
  const s16x4 l0 = tr_read<v_rd_off(D0, 0, 0)>(vb), h0 = tr_read<v_rd_off(D0, 0, 1)>(vb), l1 = tr_read<v_rd_off(D0, 1, 0)>(vb), h1 = tr_read<v_rd_off(D0, 1, 1)>(vb);
  const s16x4 l2 = tr_read<v_rd_off(D0, 2, 0)>(vb), h2 = tr_read<v_rd_off(D0, 2, 1)>(vb), l3 = tr_read<v_rd_off(D0, 3, 0)>(vb), h3 = tr_read<v_rd_off(D0, 3, 1)>(vb);
  asm volatile("s_waitcnt lgkmcnt(0)" ::: "memory"); SBAR();
#define PK(L, H) (bf16x8){L[0], L[1], L[2], L[3], H[0], H[1], H[2], H[3]}
  od = __builtin_amdgcn_mfma_f32_32x32x16_bf16(PK(l0, h0), pa0, od, 0, 0, 0);
  od = __builtin_amdgcn_mfma_f32_32x32x16_bf16(PK(l1, h1), pa1, od, 0, 0, 0);
  od = __builtin_amdgcn_mfma_f32_32x32x16_bf16(PK(l2, h2), pa2, od, 0, 0, 0);
  od = __builtin_amdgcn_mfma_f32_32x32x16_bf16(PK(l3, h3), pa3, od, 0, 0, 0);
#undef PK
}
__device__ __forceinline__ void pv_d0(f32x16* o, int vb, bf16x8 pa0, bf16x8 pa1, bf16x8 pa2, bf16x8 pa3) {
  pv_one<0>(o[0], vb, pa0, pa1, pa2, pa3); pv_one<1>(o[1], vb, pa0, pa1, pa2, pa3); pv_one<2>(o[2], vb, pa0, pa1, pa2, pa3); pv_one<3>(o[3], vb, pa0, pa1, pa2, pa3);
}
__device__ __forceinline__ void na_bias(f32x16& p0, f32x16& p1, const LAS float* bl, int kc_lo, bool inwin) {
#pragma unroll
  for (int r = 0; r < 16; ++r) { const int k0 = (r & 3) + 8 * (r >> 2);
    const bool v0 = inwin && ((unsigned)(k0 + kc_lo) < 16u), v1 = inwin && ((unsigned)(k0 + 32 + kc_lo) < 16u);
    const float b0 = bl[k0], b1 = bl[k0 + 32];
    p0[r] = v0 ? p0[r] + b0 : -INFINITY; p1[r] = v1 ? p1[r] + b1 : -INFINITY; }
}

struct AttnArgs {
  const bf16_t* Qn; const bf16_t* Qr;
  const bf16_t* Kn; const bf16_t* Kr; const bf16_t* Vh;
  bf16_t* Ob; float* ssq;
  int NT;
  int rq0, krow0; const float* rpb;
};

template <int MODE> __device__ __forceinline__ void attn_unit(const AttnArgs& a, LAS char* lds, int wid_) {
  int wid = wid_; asm volatile("" : "+s"(wid));
  constexpr int LDQ = MODE ? NPROJ : 1536, LDK = MODE ? NPROJ : 2048, LDKR = NPROJ, NQ = MODE ? 8 : 12, ND = MODE ? 4 : 5;
  constexpr int KSLOT = AttL<MODE>::KSLOT, OFF_K = AttL<MODE>::OFF_K, OFF_V = AttL<MODE>::OFF_V, OFF_WS = AttL<MODE>::OFF_WS, OFF_BIAS = AttL<MODE>::OFF_BIAS;
  const int lane = lane_id(a.NT + a.rq0), tid = wid * 64 + lane, r32 = lane & 31, hi = lane >> 5;
  LAS char* V_lds = lds + OFF_V; LAS char* K_lds = lds + OFF_K;

  LAS float* bias_l = (LAS float*)(lds + OFF_BIAS) + 128;
  f32x16 o[4] = {}; f32x16 negm = {}; bool valid = false; float l_reg = 0.f; bf16x8 qr[NQ];
  {
    const bf16_t* Qw = a.Qn + (size_t)(wid * QBLK + r32) * LDQ + hi * 8;
#pragma unroll
    for (int d0 = 0; d0 < 8; ++d0) qr[d0] = *(const GAS bf16x8*)(Qw + d0 * 16);
    if constexpr (MODE == 0) { const bf16_t* Qx = a.Qr + (size_t)(wid * QBLK + r32) * LDQ + hi * 8;
#pragma unroll
      for (int d0 = 0; d0 < 4; ++d0) qr[8 + d0] = *(const GAS bf16x8*)(Qx + d0 * 16); }
  }
  int rq = 0, rs = 0, kc_lo = 0, blane = 0;
  if constexpr (MODE == 1) {
    for (int i = tid; i < 15 * 32; i += NW * 64) { const int dr = i >> 5, dc = i & 31; bias_l[i] = dc < 31 ? ((const GAS float*)a.rpb)[dr * 31 + dc] * LOG2E : 0.f; }
    rq = a.rq0 + (wid >> 1); rs = rq - 4; rs = rs < 0 ? 0 : (rs > 120 ? 120 : rs);
    const int c = (wid & 1) * 32 + r32; int cs = c - 8; cs = cs < 0 ? 0 : (cs > 48 ? 48 : cs);
    kc_lo = 4 * hi - cs; blane = 4 * hi - c + 15;
  }
  unsigned kof[2], vof[2], krof = 0;
#pragma unroll
  for (int e = 0; e < 2; ++e) { const int q = 2 * wid + e;
    { const int row = 4 * q + (lane >> 4), ch = (lane & 15) ^ (row & 15); kof[e] = (unsigned)(row * LDK + ch * 8); }
    { const int sub = lane >> 5, kk = (q >> 1) * 8 + ((lane >> 2) & 7), k = kk, c = ((q & 1) * 2 + sub) * 32 + (lane & 3) * 8; vof[e] = (unsigned)(k * LDK + c); } }
  if constexpr (MODE == 0) { const int row = 8 * wid + (lane >> 3), ch = (lane & 7) ^ ((row >> 1) & 7); krof = (unsigned)(row * LDKR + ch * 8); }
  const int NT = a.NT;
#define GLDS(src, dst) __builtin_amdgcn_global_load_lds((const unsigned*)(src), (LAS unsigned*)(dst), 16, 0, 0)
#define DMA_K(t, slot) do { const int t_ = (t) < NT ? (t) : NT - 1; const bf16_t* kb_ = a.Kn + (size_t)t_ * KVBLK * LDK; LAS char* kd_ = K_lds + (slot) * KSLOT + wid * 2048; \
    GLDS(kb_ + kof[0], kd_); GLDS(kb_ + kof[1], kd_ + 1024); \
    if constexpr (MODE == 0) GLDS(a.Kr + (size_t)t_ * KVBLK * LDKR + krof, K_lds + (slot) * KSLOT + 16384 + wid * 1024); } while (0)
#define DMA_V(t, slot) do { const int t_ = (t) < NT ? (t) : NT - 1; const bf16_t* vb_ = a.Vh + (size_t)t_ * KVBLK * LDK; LAS char* vd_ = V_lds + (slot) * SHM_V + wid * 2048; \
    GLDS(vb_ + vof[0], vd_); GLDS(vb_ + vof[1], vd_ + 1024); } while (0)
#define WAITBAR() do { if constexpr (MODE == 0) asm volatile("s_waitcnt vmcnt(5) lgkmcnt(0)\n\ts_barrier" ::: "memory"); else asm volatile("s_waitcnt vmcnt(4) lgkmcnt(0)\n\ts_barrier" ::: "memory"); } while (0)
  const int vb0 = (int)(unsigned)(uintptr_t)V_lds + v_rd_base(lane);
  const int kl0 = (int)(unsigned)(uintptr_t)K_lds, kxn = ((r32 & 15) << 4) ^ (hi << 4), kxr = (((r32 >> 1) & 7) << 4) ^ (hi << 4);
#define RESC(al) do { if (__any((al) < 1.f)) { _Pragma("unroll") for (int d = 0; d < 4; ++d) _Pragma("unroll") for (int r = 0; r < 16; ++r) o[d][r] *= (al); } } while (0)
#define INW(t) (MODE == 0 || ((a.krow0 + (t)) >= rs && (a.krow0 + (t)) < rs + 8))
#define QK(slot, t) do { if (INW(t)) { int an_[8], ar_[4]; const int sb_ = kl0 + (slot) * KSLOT; \
      _Pragma("unroll") for (int q_ = 0; q_ < 4; ++q_) { an_[q_] = sb_ + r32 * 256 + ((q_ << 5) ^ kxn); an_[4 + q_] = an_[q_] ^ 128; ar_[q_] = sb_ + r32 * 128 + ((q_ << 5) ^ kxr); } \
      qkt_pipe<NQ>(P0, P1, negm, an_, ar_, qr); \
      if constexpr (MODE == 1) { int dr_ = a.krow0 + (t) - rq + 7; dr_ = dr_ < 0 ? 0 : (dr_ > 14 ? 14 : dr_); na_bias(P0, P1, bias_l + dr_ * 32 + blane, kc_lo, true); } } \
    else { _Pragma("unroll") for (int r_ = 0; r_ < 16; ++r_) { P0[r_] = -INFINITY; P1[r_] = -INFINITY; } } } while (0)
#define SMX() do { float al_; softmax_ref(P0, P1, negm, valid, al_, pa0, pa1, pa2, pa3, l_reg); RESC(al_); } while (0)
#define PV(slot, t) do { if (INW(t)) pv_d0(o, vb0 + (slot) * SHM_V, pa0, pa1, pa2, pa3); } while (0)
  f32x16 P0, P1; bf16x8 pa0, pa1, pa2, pa3;
  const bool late = X_LATE == 1 ? (wid >= 4) : (X_LATE == 2 ? ((wid & 1) != 0) : false);
  if (X_PRIO47 && wid >= 4) __builtin_amdgcn_s_setprio(1);
  int ks = 0, vs = 0;
  DMA_K(0, 0); DMA_V(0, 0); DMA_K(1, 1); DMA_V(1, 1);
#define STEP_HEAD(j) WAITBAR(); DMA_K((j) + 2, ks == 0 ? 2 : ks - 1); DMA_V((j) + 2, (vs + 2) & 3)
#define STEP_TAIL() ks = (ks == 2) ? 0 : ks + 1; vs = (vs + 1) & 3
  if (!late) {
    for (int j = 0; j < NT; ++j) { STEP_HEAD(j); QK(ks, j); SMX(); PV(vs, j); STEP_TAIL(); }
  } else {
    STEP_HEAD(0); QK(ks, 0); STEP_TAIL();
    for (int j = 1; j < NT; ++j) { STEP_HEAD(j); SMX(); PV((vs + 3) & 3, j - 1); QK(ks, j); STEP_TAIL(); }
    SMX(); PV((vs + 3) & 3, NT - 1);
  }
#undef STEP_HEAD
#undef STEP_TAIL
  if (X_PRIO47) __builtin_amdgcn_s_setprio(0);
  asm volatile("s_waitcnt vmcnt(0)" ::: "memory");
  float rl; { auto rr = __builtin_amdgcn_permlane32_swap(__float_as_uint(l_reg), __float_as_uint(l_reg), false, false); rl = __builtin_amdgcn_rcpf(__uint_as_float(rr[0]) + __uint_as_float(rr[1])); }
  __syncthreads();
  LAS char* stg = lds + wid * OSTG_WAVE;
#pragma unroll
  for (int d0 = 0; d0 < 4; ++d0)
#pragma unroll
    for (int g = 0; g < 4; ++g) { u32x2 w; w.x = cvt_pk_bf16(o[d0][4 * g] * rl, o[d0][4 * g + 1] * rl); w.y = cvt_pk_bf16(o[d0][4 * g + 2] * rl, o[d0][4 * g + 3] * rl);
      *(LAS u32x2*)(stg + r32 * OSTG_PITCH + (d0 * 32 + 8 * g + 4 * hi) * 2) = w; }
  asm volatile("s_waitcnt lgkmcnt(0)" ::: "memory");
#pragma unroll
  for (int i = 0; i < 8; ++i) { const int row = i * 4 + (lane >> 4), ch = lane & 15;
    const u32x4 v = *(const LAS u32x4*)(stg + row * OSTG_PITCH + ch * 16);
    *(GAS u32x4*)(a.Ob + (size_t)(wid * QBLK + row) * DM + ch * 8) = v;
    float q = (bf_lo(v.x) * bf_lo(v.x) + bf_hi(v.x) * bf_hi(v.x)) + (bf_lo(v.y) * bf_lo(v.y) + bf_hi(v.y) * bf_hi(v.y)) + (bf_lo(v.z) * bf_lo(v.z) + bf_hi(v.z) * bf_hi(v.z)) + (bf_lo(v.w) * bf_lo(v.w) + bf_hi(v.w) * bf_hi(v.w));
    q += shx(q, 1, lane); q += shx(q, 2, lane); q += shx(q, 4, lane); q += shx(q, 8, lane);
    if (ch == 0) ((GAS float*)a.ssq)[(size_t)(wid * QBLK + row) * 16] = q; }
  asm volatile("s_waitcnt lgkmcnt(0)" ::: "memory");
  __syncthreads();
#undef GLDS
#undef SMX
#undef DMA_K
#undef DMA_V
#undef WAITBAR
#undef RESC
#undef INW
#undef QK
#undef PV
}
#undef KSWZ
#undef KRSWZ
#undef SBAR
}
#ifndef X_REP0
#define X_REP0 0
#endif
#ifndef X_REPATT
#define X_REPATT 0
#endif
#ifndef X_REPG
#define X_REPG 0
#endif
#ifndef X_DUMMY_K
#define X_DUMMY_K 0
#endif
#ifndef X_DUMMY_NOEPI
#define X_DUMMY_NOEPI 0
#endif
#ifndef X_XCDLOCAL
#define X_XCDLOCAL 1
#endif
#ifndef X_REQUIRE_XMODE
#define X_REQUIRE_XMODE 0
#endif
#ifndef X_ATTLOCAL
#define X_ATTLOCAL 1
#endif
#ifndef X_BM128
#define X_BM128 1
#endif
#ifndef X_REPMASK
#define X_REPMASK 0
#endif
#define XREP(k) ((((X_REPMASK) >> (k)) & 1) ? 2 : 1)
namespace fk {
constexpr int NWAVES = 8;
constexpr size_t MiB = 1u << 20;
constexpr size_t WS_CTL = 0, CTL_ZERO_BYTES = 64 * 1024;
constexpr size_t WS_SSQX = 1 * MiB;
constexpr size_t WS_SSQC = 2 * MiB;
constexpr size_t WS_SSQY = 2 * MiB + 512 * 1024;
constexpr size_t WS_CTAB = 3 * MiB, WS_STAB = 4 * MiB;
constexpr size_t WS_W = 8 * MiB, W_LAYER = 101 * MiB;
constexpr size_t WL_IN = 0, WL_UQ = 16 * MiB, WL_UKV = 17 * MiB + 512 * 1024, WL_OUT = 18 * MiB + 512 * 1024, WL_QK = 26 * MiB + 512 * 1024, WL_VO = 30 * MiB + 512 * 1024,
                 WL_GU = 34 * MiB + 512 * 1024, WL_DN = 78 * MiB + 512 * 1024;
constexpr size_t WS_XB = 412 * MiB;
constexpr size_t WS_PROJ = 444 * MiB;
constexpr size_t WS_QM = 508 * MiB;
constexpr size_t WS_KNVM = 532 * MiB;
constexpr size_t WS_Y = 564 * MiB;
constexpr size_t WS_P = 596 * MiB;
constexpr size_t WS_TMP = 612 * MiB, T_LAYER = 35 * MiB;
constexpr size_t TL_XQ = 0, TL_XKV = 8 * MiB, TL_XO = 24 * MiB, TL_MEMN = 32 * MiB, TL_KVMEM = 33 * MiB;
constexpr size_t WS_H = 612 * MiB;
constexpr size_t WS_END = 752 * MiB;
static_assert(WS_W + 4 * W_LAYER <= WS_XB && WS_TMP + 4 * T_LAYER <= WS_END && WS_H + (size_t)S * DFF * 2 <= WS_END, "d_ws map");
constexpr int CW_BAR = 4096;
constexpr int RING_BYTES = 147456, EX_OFF = RING_BYTES, MISC_OFF = EX_OFF + 8192, LDS_BYTES = 159744;

#define RLX_AGENT __ATOMIC_RELAXED, __HIP_MEMORY_SCOPE_AGENT
#define LDS_WAIT() asm volatile("s_waitcnt lgkmcnt(0)" ::: "memory")
#define XB_TMO      128
#define XB_XCNT(j)  (256  + 64 * (j))
#define XB_XSUB(j)  (1280 + 64 * (j))
#define XB_XGEN(j)  (2304 + 64 * (j))
#define XB_TOP      3328
#define XB_TOPGEN   3392
#define XB_LSUB(j)  (3456 + 64 * (j))
#define XCD_BAR_WORDS 7552
#define XB_SPIN_CAP (1u << 18)
__device__ __forceinline__ unsigned xb_ld(unsigned* p)              { return __hip_atomic_load(p, __ATOMIC_RELAXED, __HIP_MEMORY_SCOPE_AGENT); }
__device__ __forceinline__ unsigned xb_add(unsigned* p, unsigned v) { return __hip_atomic_fetch_add(p, v, __ATOMIC_RELAXED, __HIP_MEMORY_SCOPE_AGENT); }
__device__ __forceinline__ unsigned xb_xcc_id() { return (unsigned)__builtin_amdgcn_s_getreg((3 << 11) | 20) & 0xFu; }
#define XB_SPIN(cond, bar) do { unsigned _sp = 0; while (cond) { __builtin_amdgcn_s_sleep(1); \
    if ((++_sp & 255u) == 0u) { if (xb_ld(&(bar)[XB_TMO])) break; if (_sp > XB_SPIN_CAP) { atomicAdd(&(bar)[XB_TMO], 1u); break; } } } } while (0)
struct XcdBarrier { unsigned* bar; unsigned x; volatile LAS unsigned* st; };
__device__ __forceinline__ XcdBarrier xcd_barrier_post(unsigned* bar, volatile LAS unsigned* st, int wave) {
    XcdBarrier b; b.bar = bar; b.x = xb_xcc_id(); b.st = st;
    if (wave == 0 && lane_id() == 0) st[2] = xb_add(&bar[XB_XCNT(b.x)], 1u);
    return b;
}
__device__ __forceinline__ void xcd_topology(const XcdBarrier& b, int wave) {
    if (wave == 0 && lane_id() == 0) {
        unsigned nx = 0u, ok = 1u, xi = 0u;
#pragma unroll
        for (unsigned j = 0; j < 16; ++j) { const unsigned c = xb_ld(&b.bar[XB_XCNT(j)]); if (c) { ++nx; if (c != 32u) ok = 0u; if (j < b.x) ++xi; } }
        if (nx != 8u || gridDim.x != 256u) ok = 0u;
        b.st[3] = ok; b.st[4] = xi;
    }
    __syncthreads();
}
__device__ __forceinline__ void xcd_local_barrier(const XcdBarrier& b, int wave, int grp) {
    asm volatile("s_waitcnt vmcnt(0)" ::: "memory");
    __syncthreads();
    if (wave == 0 && lane_id() == 0) {
        unsigned* c = &b.bar[XB_LSUB(4 * b.x + grp)];
        const unsigned old = xb_add(c, 1u);
        const unsigned target = (old / 8u + 1u) * 8u;
        XB_SPIN(xb_ld(c) < target, b.bar);
        __builtin_amdgcn_fence(__ATOMIC_ACQUIRE, "agent");
        asm volatile("s_waitcnt vmcnt(0)" ::: "memory");
    }
    __syncthreads();
}
__device__ __forceinline__ void xcd_barrier_complete(unsigned* bar, unsigned x, unsigned& nloc, unsigned& nx) {
    const unsigned G = gridDim.x * gridDim.y * gridDim.z;
    unsigned sum, cnt, mine, sp = 0u;
    for (;;) {
        sum = 0u; cnt = 0u; mine = 0u;
#pragma unroll
        for (unsigned j = 0; j < 16; ++j) { const unsigned c = xb_ld(&bar[XB_XCNT(j)]); sum += c; cnt += (c > 0u) ? 1u : 0u; mine = (j == x) ? c : mine; }
        if (sum == G) break;
        __builtin_amdgcn_s_sleep(1);
        if ((++sp & 255u) == 0u) { if (xb_ld(&bar[XB_TMO])) break; if (sp > XB_SPIN_CAP) { atomicAdd(&bar[XB_TMO], 1u); break; } }
    }
    nloc = mine > 0u ? mine : 1u; nx = cnt > 0u ? cnt : 1u;
}
__device__ __forceinline__ void xcd_barrier(const XcdBarrier& b, int wave) {
    asm volatile("s_waitcnt vmcnt(0)" ::: "memory");
    __syncthreads();
    if (wave == 0 && lane_id() == 0) {
        unsigned* bar = b.bar;
        __builtin_amdgcn_s_waitcnt(0);
        unsigned nloc = b.st[0], nx = b.st[1];
        if (nloc == 0u) { xcd_barrier_complete(bar, b.x, nloc, nx); b.st[0] = nloc; b.st[1] = nx; }
        const unsigned old = xb_add(&bar[XB_XSUB(b.x)], 1u);
        const unsigned gen = old / nloc;
        if (old + 1u == (gen + 1u) * nloc) {
            __builtin_amdgcn_fence(__ATOMIC_RELEASE, "agent");
            asm volatile("s_waitcnt vmcnt(0)" ::: "memory");
            const unsigned og = xb_add(&bar[XB_TOP], 1u);
            const unsigned tg = og / nx;
            if (og + 1u == (tg + 1u) * nx) xb_add(&bar[XB_TOPGEN], 1u);
            else XB_SPIN(xb_ld(&bar[XB_TOPGEN]) == tg, bar);
            __builtin_amdgcn_fence(__ATOMIC_ACQUIRE, "agent");
            xb_add(&bar[XB_XGEN(b.x)], 1u);
            asm volatile("s_waitcnt vmcnt(0)" ::: "memory");
        } else {
            XB_SPIN(xb_ld(&bar[XB_XGEN(b.x)]) == gen, bar);
            __builtin_amdgcn_fence(__ATOMIC_ACQUIRE, "agent");
            asm volatile("s_waitcnt vmcnt(0)" ::: "memory");
        }
    }
    __syncthreads();
}

__device__ __forceinline__ int tr_dloc(int kind, int c) { return kind == 1 ? (2 * (c & 31) + (c >> 5)) : c; }
__device__ __forceinline__ void tr_item64(const float* W, int ldw, int K, bf16_t* WT, int kind, const float* gain, float cscale, LAS unsigned char* scr, int kb, int s0, int dbase, int lane) {
    const int k0 = 64 * kb, nb = lane & 15, kq = lane >> 4;
    f32x4 v[4][4];
#pragma unroll
    for (int i = 0; i < 4; ++i)
#pragma unroll
        for (int j = 0; j < 4; ++j) v[i][j] = __builtin_nontemporal_load((const GAS f32x4*)(W + (size_t)(k0 + 4 * (kq + 4 * i) + j) * ldw + s0 + 4 * nb));
#pragma unroll
    for (int i = 0; i < 4; ++i) {
        const int kk = 4 * (kq + 4 * i);
        f32x4 g = (f32x4){cscale, cscale, cscale, cscale};
        if (gain) g = *(const GAS f32x4*)(gain + k0 + kk) * cscale;
#pragma unroll
        for (int e = 0; e < 4; ++e) {
            u32x2 w; w.x = cvt_pk_bf16(v[i][0][e] * g[0], v[i][1][e] * g[1]); w.y = cvt_pk_bf16(v[i][2][e] * g[2], v[i][3][e] * g[3]);
            *(LAS u32x2*)(scr + tr_dloc(kind, 4 * nb + e) * 144 + kk * 2) = w;
        }
    }
    LDS_WAIT(); asm volatile("" ::: "memory");
#pragma unroll
    for (int i = 0; i < 8; ++i) { const int n = (lane >> 3) + 8 * i, ch = lane & 7;
        const u32x4 o = *(const LAS u32x4*)(scr + n * 144 + ch * 16);
        *(GAS u32x4*)(WT + (size_t)(dbase + n) * K + k0 + 8 * ch) = o; }
    LDS_WAIT(); asm volatile("" ::: "memory");
}
__device__ __forceinline__ float wave_sum(float v, int lane) {
#pragma unroll
    for (int o = 1; o < 64; o <<= 1) v += shx(v, o, lane);
    return v;
}

struct Args { const float* in[23]; float* xres; float* out; unsigned char* ws; int ph_lo, ph_hi, nl, l_lo, l_hi, sub_lo, sub_hi, region; };

__global__ void __launch_bounds__(NWAVES * 64, 2) mk_fwd(Args args) {
    extern __shared__ __attribute__((aligned(16))) unsigned char lds_raw[];
    LAS unsigned char* lds = (LAS unsigned char*)lds_raw;
    LAS unsigned char* ex = lds + EX_OFF;
    volatile LAS unsigned* MISC = (volatile LAS unsigned*)(lds + MISC_OFF);
    const int wave = __builtin_amdgcn_readfirstlane(threadIdx.x >> 6);
    const int G = gridDim.x, bx = blockIdx.x;
    const int vcu = (G % 8 == 0) ? (bx % 8) * (G / 8) + bx / 8 : bx;
    gu32* ctl = (gu32*)(args.ws + WS_CTL);
    for (int u = wave * 64 + lane_id(); u < (LDS_BYTES - MISC_OFF) / 4; u += NWAVES * 64) ((LAS unsigned*)(lds + MISC_OFF))[u] = 0u;
    __syncthreads();
    XcdBarrier bar = xcd_barrier_post((unsigned*)(ctl + CW_BAR) + args.region * XCD_BAR_WORDS, MISC + 8, wave);
    const int lo = args.ph_lo, hi = args.ph_hi;
#define IN(k) (lo <= (k) && (k) < hi)
#define GRID_BAR() xcd_barrier(bar, wave)
#define SEAM(local_ok) do { if (xmode && (local_ok)) xcd_local_barrier(bar, wave, xrank & 3); else xcd_barrier(bar, wave); } while (0)
#define PHASE_PTRS() unsigned char* ws = args.ws; asm volatile("" : "+s"(ws)); \
    float* ssq_x = (float*)(ws + WS_SSQX); float* ssq_c = (float*)(ws + WS_SSQC); float* ssq_y = (float*)(ws + WS_SSQY); \
    float* ctab = (float*)(ws + WS_CTAB); float* stab = (float*)(ws + WS_STAB); \
    bf16_t* XB = (bf16_t*)(ws + WS_XB); bf16_t* PROJ = (bf16_t*)(ws + WS_PROJ); bf16_t* QM = (bf16_t*)(ws + WS_QM); bf16_t* KNVM = (bf16_t*)(ws + WS_KNVM); \
    bf16_t* Y = (bf16_t*)(ws + WS_Y); bf16_t* P = (bf16_t*)(ws + WS_P); bf16_t* H = (bf16_t*)(ws + WS_H); \
    (void)ssq_x; (void)ssq_c; (void)ssq_y; (void)ctab; (void)stab; (void)XB; (void)PROJ; (void)QM; (void)KNVM; (void)Y; (void)P; (void)H
#define LAYER_PTRS() PHASE_PTRS(); int l = l0; asm volatile("" : "+s"(l)); unsigned char* wl = ws + WS_W + (size_t)l * W_LAYER; (void)wl
    const int gw = vcu * NWAVES + wave, NGW = G * NWAVES;
    const int nl = args.nl;

    for (int rep0_ = 0; rep0_ < (X_REP0 ? 2 : 1); ++rep0_) {
    constexpr int I_IN = 32 * 61, I_UQ = 8 * 24, I_UKV = 4 * 32, I_SQ = 32 * 32, I_G = 32 * 88, I_DN = 88 * 32;
    constexpr int I_LAYER = I_IN + I_UQ + I_UKV + 4 * I_SQ + 2 * I_G + I_DN, I_XKV0 = I_IN + I_UQ + I_UKV + I_SQ;
    if (IN(0)) {
        PHASE_PTRS();
        const int lane = lane_id(), tid = wave * 64 + lane; (void)tid;
        LAS unsigned char* scr = lds + wave * 16384;
#define IT_W0 gw
#define IT_NW NGW
#define IT_N (2 * I_SQ)
#define IT_LO I_XKV0
        for (int it = IT_W0; it < nl * IT_N; it += IT_NW) {
            const int l = it / IT_N; int r = (it % IT_N) + IT_LO;
            unsigned char* wl = ws + WS_W + (size_t)l * W_LAYER; unsigned char* tl = ws + WS_TMP + (size_t)l * T_LAYER;
            if (r < I_IN) { const int kb = r / 61, sb = r % 61;
                tr_item64(args.in[3] + (size_t)l * DM * 3904, 3904, DM, (bf16_t*)(wl + WL_IN), sb == 60 ? 1 : 0, args.in[2] + l * DM, sb < 16 ? QSC_NA : 1.0f, scr, kb, 64 * sb, 64 * sb, lane); continue; } r -= I_IN;
            if (r < I_UQ) { const int kb = r / 24, sb = r % 24, h = sb / 3, p = sb % 3;
                tr_item64(args.in[6] + (size_t)l * 512 * 1536, 1536, 512, (bf16_t*)(wl + WL_UQ), p == 2 ? 1 : 0, args.in[4] + l * 512, QSC_MLA, scr, kb, 64 * sb, p == 2 ? 1024 + 64 * h : 128 * h + 64 * p, lane); continue; } r -= I_UQ;
            if (r < I_UKV) { const int kb = r / 32, sb = r % 32, h = sb >> 2, p = sb & 3;
                tr_item64(args.in[7] + (size_t)l * 256 * 2048, 2048, 256, (bf16_t*)(wl + WL_UKV), 0, args.in[5] + l * 256, 1.0f, scr, kb, 64 * sb, (p >> 1) * 1024 + 128 * h + 64 * (p & 1), lane); continue; } r -= I_UKV;
            if (r < I_SQ) { const int kb = r / 32, sb = r % 32;
                const float* gn = (kb < 16) ? (args.in[9] + l * 1024) : (args.in[10] + l * 1024 - 1024);
                tr_item64(args.in[11] + (size_t)l * DM * DM, DM, DM, (bf16_t*)(wl + WL_OUT), 0, gn, 1.0f, scr, kb, 64 * sb, 64 * sb, lane); continue; } r -= I_SQ;
            if (r < I_SQ) { tr_item64(args.in[15] + (size_t)l * DM * DM, DM, DM, (bf16_t*)(tl + TL_XKV), 0, nullptr, 1.0f, scr, r / 32, 64 * (r % 32), 64 * (r % 32), lane); continue; } r -= I_SQ;
            if (r < I_SQ) { tr_item64(args.in[16] + (size_t)l * DM * DM, DM, DM, (bf16_t*)(tl + TL_XKV) + (size_t)DM * DM, 0, nullptr, 1.0f, scr, r / 32, 64 * (r % 32), 64 * (r % 32), lane); continue; } r -= I_SQ;
            if (r < I_SQ) { tr_item64(args.in[17] + (size_t)l * DM * DM, DM, DM, (bf16_t*)(tl + TL_XO), 0, nullptr, 1.0f, scr, r / 32, 64 * (r % 32), 64 * (r % 32), lane); continue; } r -= I_SQ;
            if (r < 2 * I_G) {
                const int up = r >= I_G; const int q = up ? r - I_G : r; const int kb = q / 88, sb = q % 88;
                tr_item64((up ? args.in[20] : args.in[19]) + (size_t)l * DM * DFF, DFF, DM, (bf16_t*)(wl + WL_GU), 0, args.in[18] + l * DM, 1.0f, scr, kb, 64 * sb, 256 * (sb >> 1) + 128 * up + 64 * (sb & 1), lane); continue; } r -= 2 * I_G;
            tr_item64(args.in[21] + (size_t)l * DFF * DM, DM, DFF, (bf16_t*)(wl + WL_DN), 0, nullptr, 1.0f, scr, r / 32, 64 * (r % 32), 64 * (r % 32), lane);
        }

#undef IT_W0
#undef IT_NW
#undef IT_N
#undef IT_LO
        for (int m = gw; m < nl * 256; m += NGW) {
            const int l = m >> 8, row = m & 255;
            const GAS f32x4* xr = (const GAS f32x4*)(args.in[1] + (size_t)row * DM) + lane; const GAS f32x4* gr = (const GAS f32x4*)(args.in[13] + (size_t)l * DM) + lane;
            f32x4 v[8]; float q = 0.f;
#pragma unroll
            for (int j = 0; j < 8; ++j) { v[j] = xr[64 * j]; q += (v[j][0] * v[j][0] + v[j][1] * v[j][1]) + (v[j][2] * v[j][2] + v[j][3] * v[j][3]); }
            const float rstd = 1.0f / sqrtf(wave_sum(q, lane) * (1.0f / DM) + EPS);
            bf16_t* o = (bf16_t*)(ws + WS_TMP + (size_t)l * T_LAYER + TL_MEMN) + (size_t)row * DM;
#pragma unroll
            for (int j = 0; j < 8; ++j) { const f32x4 gv = gr[64 * j]; u32x2 w; w.x = cvt_pk_bf16(v[j][0] * rstd * gv[0], v[j][1] * rstd * gv[1]); w.y = cvt_pk_bf16(v[j][2] * rstd * gv[2], v[j][3] * rstd * gv[3]);
                *(GAS u32x2*)(o + j * 256 + lane * 4) = w; }
        }
        if (IN(1) || X_REP0) GRID_BAR();
    }
    if (IN(1)) {
        PHASE_PTRS();
        const int nP1 = 16 * nl, split = (G >= 2 * nP1);
        if (bx < nP1 || !split) {
            Gemm g{(const bf16_t*)(ws + WS_TMP + TL_MEMN), (const bf16_t*)(ws + WS_TMP + TL_XKV), DM, DM, DM, (long)(T_LAYER / 2), (long)(T_LAYER / 2)};
            GridOrder So; So.init(1, 16, nl, G, bx);
            EpiRow<0> E{(bf16_t*)(ws + WS_TMP + TL_KVMEM), 4096, (long)(T_LAYER / 2), nullptr, 0, 0.f, 1 << 30, 0, nullptr, nullptr, nullptr, 0, 0};
            gemm_phase<EpiRow<0>, GridOrder>(lds, ex, g, So, E, wave);
        }
        if (bx >= nP1 || !split) {
        const int lane = lane_id(), tid = wave * 64 + lane;
        LAS unsigned char* scr = lds + wave * 16384;
        const int cb = split ? bx - nP1 : bx, NCB = split ? G - nP1 : G;
        const int gwc = cb * NWAVES + wave, NGWC = NCB * NWAVES;
#define IT_W0 gwc
#define IT_NW NGWC
#define IT_N (I_LAYER - 2 * I_SQ)
#define IT_LO 0
        for (int it = IT_W0; it < nl * IT_N; it += IT_NW) {
            const int l = it / IT_N; int r = (it % IT_N) + IT_LO; if (r >= I_XKV0) r += 2 * I_SQ;
            unsigned char* wl = ws + WS_W + (size_t)l * W_LAYER; unsigned char* tl = ws + WS_TMP + (size_t)l * T_LAYER;
            if (r < I_IN) { const int kb = r / 61, sb = r % 61;
                tr_item64(args.in[3] + (size_t)l * DM * 3904, 3904, DM, (bf16_t*)(wl + WL_IN), sb == 60 ? 1 : 0, args.in[2] + l * DM, sb < 16 ? QSC_NA : 1.0f, scr, kb, 64 * sb, 64 * sb, lane); continue; } r -= I_IN;
            if (r < I_UQ) { const int kb = r / 24, sb = r % 24, h = sb / 3, p = sb % 3;
                tr_item64(args.in[6] + (size_t)l * 512 * 1536, 1536, 512, (bf16_t*)(wl + WL_UQ), p == 2 ? 1 : 0, args.in[4] + l * 512, QSC_MLA, scr, kb, 64 * sb, p == 2 ? 1024 + 64 * h : 128 * h + 64 * p, lane); continue; } r -= I_UQ;
            if (r < I_UKV) { const int kb = r / 32, sb = r % 32, h = sb >> 2, p = sb & 3;
                tr_item64(args.in[7] + (size_t)l * 256 * 2048, 2048, 256, (bf16_t*)(wl + WL_UKV), 0, args.in[5] + l * 256, 1.0f, scr, kb, 64 * sb, (p >> 1) * 1024 + 128 * h + 64 * (p & 1), lane); continue; } r -= I_UKV;
            if (r < I_SQ) { const int kb = r / 32, sb = r % 32;
                const float* gn = (kb < 16) ? (args.in[9] + l * 1024) : (args.in[10] + l * 1024 - 1024);
                tr_item64(args.in[11] + (size_t)l * DM * DM, DM, DM, (bf16_t*)(wl + WL_OUT), 0, gn, 1.0f, scr, kb, 64 * sb, 64 * sb, lane); continue; } r -= I_SQ;
            if (r < I_SQ) { tr_item64(args.in[15] + (size_t)l * DM * DM, DM, DM, (bf16_t*)(tl + TL_XKV), 0, nullptr, 1.0f, scr, r / 32, 64 * (r % 32), 64 * (r % 32), lane); continue; } r -= I_SQ;
            if (r < I_SQ) { tr_item64(args.in[16] + (size_t)l * DM * DM, DM, DM, (bf16_t*)(tl + TL_XKV) + (size_t)DM * DM, 0, nullptr, 1.0f, scr, r / 32, 64 * (r % 32), 64 * (r % 32), lane); continue; } r -= I_SQ;
            if (r < I_SQ) { tr_item64(args.in[17] + (size_t)l * DM * DM, DM, DM, (bf16_t*)(tl + TL_XO), 0, nullptr, 1.0f, scr, r / 32, 64 * (r % 32), 64 * (r % 32), lane); continue; } r -= I_SQ;
            if (r < 2 * I_G) {
                const int up = r >= I_G; const int q = up ? r - I_G : r; const int kb = q / 88, sb = q % 88;
                tr_item64((up ? args.in[20] : args.in[19]) + (size_t)l * DM * DFF, DFF, DM, (bf16_t*)(wl + WL_GU), 0, args.in[18] + l * DM, 1.0f, scr, kb, 64 * sb, 256 * (sb >> 1) + 128 * up + 64 * (sb & 1), lane); continue; } r -= 2 * I_G;
            tr_item64(args.in[21] + (size_t)l * DFF * DM, DM, DFF, (bf16_t*)(wl + WL_DN), 0, nullptr, 1.0f, scr, r / 32, 64 * (r % 32), 64 * (r % 32), lane);
        }

#undef IT_W0
#undef IT_NW
#undef IT_N
#undef IT_LO
        for (size_t i = (size_t)(cb * (NWAVES * 64) + tid); i < (size_t)nl * 192 * DM / 8; i += (size_t)NCB * NWAVES * 64) {
            const int l = (int)(i / (192 * DM / 8)); const size_t e = (i % (192 * DM / 8)) * 8;
            *(GAS u32x4*)((bf16_t*)(ws + WS_W + (size_t)l * W_LAYER + WL_IN) + (size_t)3904 * DM + e) = (u32x4){0u, 0u, 0u, 0u};
        }
        for (size_t i = (size_t)(cb * (NWAVES * 64) + tid); i < (size_t)nl * DM * DM / 8; i += (size_t)NCB * NWAVES * 64) {
            const int l = (int)(i / ((size_t)DM * DM / 8)); const size_t e = (i % ((size_t)DM * DM / 8)) * 8; const int k = (int)(e / DM);
            const float gsc = ((const GAS float*)args.in[12])[l * DM + k] * QSC_X;
            const f32x4 a = *(const GAS f32x4*)(args.in[14] + (size_t)l * DM * DM + e), b = *(const GAS f32x4*)(args.in[14] + (size_t)l * DM * DM + e + 4);
            *(GAS u32x4*)((bf16_t*)(ws + WS_TMP + (size_t)l * T_LAYER + TL_XQ) + e) = pack8(a * gsc, b * gsc);
        }
        for (int m = gwc; m < S; m += NGWC) {
            const GAS f32x4* xr = (const GAS f32x4*)(args.in[0] + (size_t)m * DM) + lane;
#pragma unroll
            for (int j = 0; j < 8; ++j) { const f32x4 v = xr[64 * j];
                float q = (v[0] * v[0] + v[1] * v[1]) + (v[2] * v[2] + v[3] * v[3]);
                q += shx(q, 1, lane); q += shx(q, 2, lane); q += shx(q, 4, lane); q += shx(q, 8, lane);
                if ((lane & 15) == 0) ((GAS float*)ssq_x)[(size_t)m * 32 + j * 4 + (lane >> 4)] = q;
                u32x2 w; w.x = cvt_pk_bf16(v[0], v[1]); w.y = cvt_pk_bf16(v[2], v[3]);
                *(GAS u32x2*)(XB + (size_t)m * DM + j * 256 + lane * 4) = w; }
        }
        for (int idx = cb * (NWAVES * 64) + tid; idx < S * 32; idx += NCB * NWAVES * 64) {
            const int pos = idx >> 5, j = idx & 31;
            const float inv = (float)exp2(-(double)j * (13.287712379549449 / 32.0));
            const float ang = (float)pos * inv;
            const double a = (double)ang;
            const double n = rint(a * 0.63661977236758134);
            const double r = fma(-n, 1.5707963267948966, a) - n * 6.123233995736766e-17;
            const int qd = (int)((long long)n & 3);
            const float rf = (float)r, z = rf * rf;
            const float sn = rf + rf * z * (-1.6666654611e-1f + z * (8.3321608736e-3f + z * -1.9515295891e-4f));
            const float cn = 1.0f - 0.5f * z + z * z * (4.166664568298827e-2f + z * (-1.388731625493765e-3f + z * 2.443315711809948e-5f));
            float c, s;
            if (qd == 0) { s = sn; c = cn; } else if (qd == 1) { s = cn; c = -sn; } else if (qd == 2) { s = -sn; c = -cn; } else { s = -cn; c = sn; }
            ((GAS float*)ctab)[idx] = c; ((GAS float*)stab)[idx] = s;
        }
        }
        if (IN(2)) GRID_BAR();
    }
    }
    if (IN(2)) {
        for (int l0 = 0; l0 < nl; ++l0) {
            LAYER_PTRS(); unsigned char* tl = ws + WS_TMP + (size_t)l * T_LAYER;
            { Gemm g{(const bf16_t*)(tl + TL_KVMEM), (const bf16_t*)(tl + TL_XQ), 4096, DM, 512, 512, 512};
              GridOrder So; So.init(1, 8, 4, G, (bx + G - ((l * 64) % G)) % G);
              EpiRow<0> E{(bf16_t*)(wl + WL_QK), DM, (long)256 * DM, nullptr, 0, 0.f, 1 << 30, 0, nullptr, nullptr, nullptr, 0, 0};
              gemm_phase<EpiRow<0>, GridOrder>(lds, ex, g, So, E, wave); }
            { Gemm g{(const bf16_t*)(tl + TL_XO), (const bf16_t*)(tl + TL_KVMEM) + 2048, DM, 4096, 512, 512, 512};
              GridOrder So; So.init(8, 1, 4, G, (bx + G - ((l * 64 + 32) % G)) % G);
              EpiRow<0> E{(bf16_t*)(wl + WL_VO), 1024, 256, nullptr, 0, 0.f, 1 << 30, 0, nullptr, nullptr, nullptr, 0, 0};
              gemm_phase<EpiRow<0>, GridOrder>(lds, ex, g, So, E, wave); }
        }
    }
    if (IN(3)) {
        const int slo = args.sub_lo, shi = args.sub_hi;
#define SUB(k) (slo <= (k) && (k) < shi)
        GRID_BAR();
        xcd_topology(bar, wave);
        const int xmode = X_XCDLOCAL ? (int)__builtin_amdgcn_readfirstlane((int)MISC[11]) : 0, xidx = (int)__builtin_amdgcn_readfirstlane((int)MISC[12]), xrank = (int)__builtin_amdgcn_readfirstlane((int)MISC[10]);
#if X_REQUIRE_XMODE
        if (!xmode) return;
#endif
#define ORDER(So, nN_) do { if (xmode) So.init_x(nN_, xidx, xrank); else So.init(S / BM, nN_, 1, G, bx); } while (0)
        for (int l0 = args.l_lo; l0 < args.l_hi; ++l0) {
            for (int rep_ = 0; rep_ < (X_REPG ? 2 : XREP(0)); ++rep_)
            if (SUB(0)) { LAYER_PTRS();
                Gemm g{XB, (const bf16_t*)(wl + WL_IN), DM, DM, DM, 0, 0};
                GridOrder So; ORDER(So, NPROJ / BM);
                EpiRow<8> E{PROJ, NPROJ, 0, ssq_x, 32, 1.0f / DM, 15, 0, ctab, stab, ssq_c, 12, 15};
                gemm_phase<EpiRow<8>, GridOrder>(lds, ex, g, So, E, wave);
                SEAM(true);
            }
            for (int rep_ = 0; rep_ < (X_REPG ? 2 : XREP(1)); ++rep_)
            if (SUB(1)) { LAYER_PTRS();
                { Gemm g{PROJ + 3072, (const bf16_t*)(wl + WL_UQ), NPROJ, 512, 512, 0, 0};
                  GridOrder So; ORDER(So, 6);
                  EpiRow<2> E{QM, 1536, 0, ssq_c, 16, 1.0f / 512.0f, 4, 1, ctab, stab, nullptr, 0, 0};
                  gemm_phase<EpiRow<2>, GridOrder>(lds, ex, g, So, E, wave); }
                { Gemm g{PROJ + 3584, (const bf16_t*)(wl + WL_UKV), NPROJ, 256, 256, 0, 0};
                  GridOrder So; if (xmode) So.init_x(8, xidx, (xrank + 8) & 31); else So.init(S / BM, 8, 1, G, (bx + G - (192 % G)) % G);
                  EpiRow<1> E{KNVM, 2048, 0, ssq_c + 8, 16, 1.0f / 256.0f, 1 << 30, 0, nullptr, nullptr, nullptr, 0, 0};
                  gemm_phase<EpiRow<1>, GridOrder>(lds, ex, g, So, E, wave); }
                GRID_BAR();
            }
            for (int rep_ = 0; rep_ < ((X_REPATT || (X_REPMASK & 0x304)) ? 2 : 1); ++rep_)
            if (SUB(2)) { LAYER_PTRS();
                if (!(X_REPMASK & 0x300) || rep_ == 1 || (X_REPMASK & 0x200))
                for (int u0 = bx; u0 < 256; u0 += G) {
                    const int u = (xmode && X_ATTLOCAL) ? ((4 * xidx + (xrank & 3)) * 8 + (xrank >> 2)) : u0;
                    const int h = u & 7, qb = u >> 3; const size_t row0 = (size_t)qb * 256;
                    att::AttnArgs a{QM + row0 * 1536 + h * 128, QM + row0 * 1536 + 1024 + h * 64, KNVM + h * 128, PROJ + 3840, KNVM + 1024 + h * 128,
                                    Y + row0 * DM + 1024 + h * 128, ssq_y + row0 * 16 + 8 + h, S / 64, 0, 0, nullptr};
                    att::attn_unit<0>(a, (LAS char*)lds, wave);
                }
                if (!(X_REPMASK & 0x300) || rep_ == 1 || (X_REPMASK & 0x100))
                for (int u0 = bx; u0 < 256; u0 += G) {
                    const int u = (xmode && X_ATTLOCAL) ? ((4 * xidx + (xrank & 3)) * 8 + (xrank >> 2)) : u0;
                    const int h = u & 7, rg = u >> 3, rq0 = 4 * rg; int t0 = rq0 - 4; t0 = t0 < 0 ? 0 : (t0 > 116 ? 116 : t0);
                    const size_t row0 = (size_t)rq0 * 64, key0 = (size_t)t0 * 64;
                    att::AttnArgs a{PROJ + row0 * NPROJ + h * 128, nullptr, PROJ + key0 * NPROJ + 1024 + h * 128, nullptr, PROJ + key0 * NPROJ + 2048 + h * 128,
                                    Y + row0 * DM + h * 128, ssq_y + row0 * 16 + h, 12, rq0, t0, args.in[8] + ((size_t)l * 8 + h) * 15 * 31};
                    att::attn_unit<1>(a, (LAS char*)lds, wave);
                }
                SEAM(X_ATTLOCAL);
            }
            for (int rep_ = 0; rep_ < XREP(3); ++rep_)
            if (SUB(3)) { LAYER_PTRS(); const bool dummy_ = (rep_ + 1 < XREP(3));
                Gemm g{Y, (const bf16_t*)(wl + WL_OUT), DM, DM, DM, 0, 0};
                GridOrder So; ORDER(So, DM / BM);
                EpiRes<true> E{(l == 0) ? args.in[0] : nullptr, XB, dummy_ ? QM : XB, dummy_ ? (float*)KNVM : ssq_x, ssq_y};
                gemm_phase<EpiRes<true>, GridOrder>(lds, ex, g, So, E, wave);
                SEAM(true);
            }
            for (int rep_ = 0; rep_ < (X_REPG ? 2 : XREP(4)); ++rep_)
            if (SUB(4)) { LAYER_PTRS();
                Gemm g{XB, (const bf16_t*)(wl + WL_QK), DM, DM, DM, 0, 0};
                if (xmode && X_BM128) {
                    OneUnit So{2 * (4 * xidx + (xrank & 3)) + ((xrank >> 2) & 1), xrank >> 3, 1};
                    EpiSoftmaxT<1> E{P, ssq_x};
                    gemm_phase128<EpiSoftmaxT<1>, OneUnit>(lds, ex, g, So, E, wave);
                } else {
                GridOrder So; ORDER(So, 4);
                EpiSoftmax E{P, ssq_x};
                gemm_phase<EpiSoftmax, GridOrder>(lds, ex, g, So, E, wave);
                }
                SEAM(true);
            }
            for (int rep_ = 0; rep_ < XREP(5); ++rep_)
            if (SUB(5)) { LAYER_PTRS(); const bool dummy_ = (rep_ + 1 < XREP(5));
                Gemm g{P, (const bf16_t*)(wl + WL_VO), 1024, 1024, (dummy_ && X_DUMMY_K) ? X_DUMMY_K : 1024, 0, 0};
                GridOrder So; ORDER(So, DM / BM);
                EpiRes<false> E{nullptr, XB, dummy_ ? QM : XB, dummy_ ? (float*)KNVM : ssq_x, nullptr};
                gemm_phase<EpiRes<false>, GridOrder>(lds, ex, g, So, E, wave, dummy_ && X_DUMMY_NOEPI);
                SEAM(true);
            }
            for (int rep_ = 0; rep_ < (X_REPG ? 2 : XREP(6)); ++rep_)
            if (SUB(6)) { LAYER_PTRS();
                Gemm g{XB, (const bf16_t*)(wl + WL_GU), DM, DM, DM, 0, 0};
                if (xmode && X_BM128) {
                    { GridOrder So; So.init_x(2 * DFF / BM, xidx, xrank, 160);
                      EpiSwiglu E{H, ssq_x};
                      gemm_phase<EpiSwiglu, GridOrder>(lds, ex, g, So, E, wave); }
                    { OneUnit So{2 * (4 * xidx + (xrank & 3)) + ((xrank >> 2) & 1), 40 + (xrank >> 3), 1};
                      EpiSwigluT<1> E{H, ssq_x};
                      gemm_phase128<EpiSwigluT<1>, OneUnit>(lds, ex, g, So, E, wave); }
                } else {
                GridOrder So; ORDER(So, 2 * DFF / BM);
                EpiSwiglu E{H, ssq_x};
                gemm_phase<EpiSwiglu, GridOrder>(lds, ex, g, So, E, wave);
                }
                SEAM(true);
            }
            for (int rep_ = 0; rep_ < XREP(7); ++rep_)
            if (SUB(7)) { LAYER_PTRS(); const bool dummy_ = (rep_ + 1 < XREP(7));
                Gemm g{H, (const bf16_t*)(wl + WL_DN), DFF, DFF, DFF, 0, 0};
                GridOrder So; ORDER(So, DM / BM);
                EpiRes<false> E{nullptr, XB, dummy_ ? QM : XB, dummy_ ? (float*)KNVM : ssq_x, nullptr};
                gemm_phase<EpiRes<false>, GridOrder>(lds, ex, g, So, E, wave);
                SEAM(l0 + 1 < args.l_hi && shi == 8 && slo == 0);
            }
        }
#undef SUB
    }
    if (IN(4)) {
        PHASE_PTRS();
        const int lane = lane_id();
        for (int m = gw; m < S; m += NGW) {
            const GAS u32x4* xr = (const GAS u32x4*)(XB + (size_t)m * DM) + lane; const GAS f32x4* gr = (const GAS f32x4*)(args.in[22]);
            f32x4 v[8]; float q = 0.f;
#pragma unroll
            for (int j = 0; j < 4; ++j) { const u32x4 w = xr[64 * j]; v[2 * j] = (f32x4){bf_lo(w.x), bf_hi(w.x), bf_lo(w.y), bf_hi(w.y)}; v[2 * j + 1] = (f32x4){bf_lo(w.z), bf_hi(w.z), bf_lo(w.w), bf_hi(w.w)}; }
#pragma unroll
            for (int j = 0; j < 8; ++j) q += (v[j][0] * v[j][0] + v[j][1] * v[j][1]) + (v[j][2] * v[j][2] + v[j][3] * v[j][3]);
            const float rstd = 1.0f / sqrtf(wave_sum(q, lane) * (1.0f / DM) + EPS);
            float* o = args.out + (size_t)m * DM;
#pragma unroll
            for (int j = 0; j < 4; ++j) { const int c = j * 512 + lane * 8;
                *(GAS f32x4*)(o + c) = v[2 * j] * rstd * gr[c / 4]; *(GAS f32x4*)(o + c + 4) = v[2 * j + 1] * rstd * gr[c / 4 + 1]; }
        }
    }
#undef IN
#undef GRID_BAR
}
}
#ifndef MK_DEBUG
#define MK_DEBUG 0
#endif
static int mk_setup(int& grid) {
    static int g = 0;
    if (g == 0) {
        int dev = 0, cus = 0, per_cu = 0;
        if (hipGetDevice(&dev) != hipSuccess || hipDeviceGetAttribute(&cus, hipDeviceAttributeMultiprocessorCount, dev) != hipSuccess) { fprintf(stderr, "kernel_launch: device query failed\n"); g = -1; return g; }
        if (hipFuncSetAttribute((const void*)fk::mk_fwd, hipFuncAttributeMaxDynamicSharedMemorySize, fk::LDS_BYTES) != hipSuccess) { fprintf(stderr, "kernel_launch: hipFuncSetAttribute failed\n"); g = -1; return g; }
        if (hipOccupancyMaxActiveBlocksPerMultiprocessor(&per_cu, (const void*)fk::mk_fwd, fk::NWAVES * 64, fk::LDS_BYTES) != hipSuccess || per_cu < 1) { fprintf(stderr, "kernel_launch: occupancy query says %d blocks per CU\n", per_cu); }
        (void)hipGetLastError();
        g = cus;
#ifdef X_FORCE_GRID
        g = X_FORCE_GRID;
#endif
    }
    grid = g; return g;
}
#if MK_DEBUG
namespace dbg {
using namespace fk;
__global__ void cmp_k(int kind, const void* fast, const float* orc, int c0, int c1, double* acc) {
    const int row = blockIdx.x; double e = 0.0, r = 0.0;
    const bf16_t* fb = (const bf16_t*)fast; const float* ff = (const float*)fast;
    const int ncol = kind == 0 ? 2048 : kind == 1 ? 3904 : kind == 2 ? 1536 : kind == 3 ? 2048 : (c1 - c0);
    for (int c = threadIdx.x; c < ncol; c += 256) {
        float f, o;
        if (kind == 0) { f = ff[(size_t)row * 2048 + c]; o = orc[(size_t)row * 2048 + c]; }
        else if (kind == 1) { o = orc[(size_t)row * 3904 + c]; int fc = c; float sc = 1.f;
            if (c < 1024) sc = 1.0f / QSC_NA; else if (c >= 3840) { const int j = c - 3840; fc = 3840 + 2 * (j & 31) + (j >> 5); }
            f = __uint_as_float((unsigned)fb[(size_t)row * 4096 + fc] << 16) * sc; }
        else if (kind == 2) { o = orc[(size_t)row * 1536 + c]; const int h = c / 192, d = c % 192; int fc;
            if (d < 128) fc = h * 128 + d; else { const int j = d - 128; fc = 1024 + h * 64 + 2 * (j & 31) + (j >> 5); }
            f = __uint_as_float((unsigned)fb[(size_t)row * 1536 + fc] << 16) * (1.0f / QSC_MLA); }
        else if (kind == 3) { o = orc[(size_t)row * 2048 + c]; const int h = c / 256, d = c % 256; const int fc = d < 128 ? h * 128 + d : 1024 + h * 128 + (d - 128);
            f = __uint_as_float((unsigned)fb[(size_t)row * 2048 + fc] << 16); }
        else { o = orc[(size_t)row * 2048 + c0 + c]; f = __uint_as_float((unsigned)fb[(size_t)row * 2048 + c0 + c] << 16); }
        const double d = (double)f - (double)o; e += (f == f) ? d * d : 1e30; r += (double)o * (double)o;
    }
    for (int o = 32; o > 0; o >>= 1) { e += __shfl_xor(e, o); r += __shfl_xor(r, o); }
    if ((threadIdx.x & 63) == 0) { atomicAdd(acc, e); atomicAdd(acc + 1, r); }
}
__global__ void fin_k(const double* acc, int nstage, float thr, float* out) {
    if (threadIdx.x == 0 && blockIdx.x == 0) {
        int code = -1;
        for (int s = 0; s < nstage; ++s) { const double e = acc[2 * s], r = acc[2 * s + 1]; if (!(e <= (double)thr * r)) { code = s; break; } }
        if (code >= 0) out[0] += 100.0f * (float)(10 + code);
    }
}
}
#endif

extern "C" void kernel_launch(void* const* d_in, const int* in_sizes, int n_in, void* d_out, int out_size, void* d_ws, size_t ws_size, hipStream_t stream) {
    using namespace fk;
    int grid = 0;
    if (mk_setup(grid) <= 0) return;
    const size_t need = MK_DEBUG ? 1010 * MiB : WS_END;
    if (n_in != 23 || out_size != S * DM || ws_size < need) { fprintf(stderr, "kernel_launch: unexpected shapes n_in %d out %d ws %zu (need %zu)\n", n_in, out_size, ws_size, need); return; }
    unsigned char* ws = (unsigned char*)d_ws;
    if (hipMemsetAsync(ws + WS_CTL, 0, CTL_ZERO_BYTES, stream) != hipSuccess) { fprintf(stderr, "kernel_launch: memset failed\n"); return; }
    Args a{};
    for (int i = 0; i < 23; ++i) a.in[i] = (const float*)d_in[i];
    a.ws = ws;
#if !MK_DEBUG
    a.xres = (float*)d_out; a.out = (float*)d_out;
    a.ph_lo = 0; a.ph_hi = 5; a.nl = 4; a.l_lo = 0; a.l_hi = 4; a.sub_lo = 0; a.sub_hi = 8; a.region = 0;
    hipLaunchKernelGGL(mk_fwd, dim3(grid), dim3(NWAVES * 64), LDS_BYTES, stream, a);
    const hipError_t le = hipPeekAtLastError();
    if (le != hipSuccess) fprintf(stderr, "kernel_launch: launch failed: %s\n", hipGetErrorName(le));
#else
    constexpr int NLD = MK_DEBUG_NL;
    ref::Bufs b;
    b.x = (float*)d_out;
    b.proj = (float*)(ws + 210 * MiB); b.q = (float*)(ws + 338 * MiB);
    b.memn = (float*)(ws + 386 * MiB); b.kmem = (float*)(ws + 388 * MiB); b.vmem = (float*)(ws + 390 * MiB);
    b.ctab = (float*)(ws + 392 * MiB); b.stab = (float*)(ws + 393 * MiB);
    b.kv = (float*)(ws + 752 * MiB); b.y = (float*)(ws + 816 * MiB); b.h = (float*)(ws + 880 * MiB); b.Sb = b.h;
    float* xfast = (float*)(ws + 944 * MiB);
    double* acc = (double*)(ws + 1008 * MiB);
    hipMemsetAsync(acc, 0, 4096, stream);
    a.xres = xfast; a.out = xfast; a.nl = NLD;
    int region = 0;
    auto fast = [&](int plo, int phi, int l, int slo, int shi) { a.ph_lo = plo; a.ph_hi = phi; a.l_lo = l; a.l_hi = l + 1; a.sub_lo = slo; a.sub_hi = shi; a.region = region++;
        hipLaunchKernelGGL(mk_fwd, dim3(grid), dim3(NWAVES * 64), LDS_BYTES, stream, a); };
    int stage = 0;
    auto cmp = [&](int kind, const void* f, const float* o, int c0, int c1) { hipLaunchKernelGGL(dbg::cmp_k, dim3(S), dim3(256), 0, stream, kind, f, o, c0, c1, acc + 2 * stage); ++stage; };
    fast(0, 3, 0, 0, 0);
    hipMemcpyAsync(b.x, d_in[0], (size_t)S * DM * 4, hipMemcpyDeviceToDevice, stream);
    hipLaunchKernelGGL(ref::rope_table_k, dim3(S * 32 / 256), dim3(256), 0, stream, b.ctab, b.stab);
    for (int l = 0; l < 4; ++l) {
        if (l < NLD) {
#if MK_DEBUG == 2
            fast(3, 4, l, 0, 4);
#else
            for (int s = 0; s < 4; ++s) fast(3, 4, l, s, s + 1);
#endif
        }
        ref::mixer(stream, d_in, l, b);
        if (l < NLD) { cmp(1, ws + WS_PROJ, b.proj, 0, 0); cmp(2, ws + WS_QM, b.q, 0, 0); cmp(3, ws + WS_KNVM, b.kv, 0, 0); cmp(4, ws + WS_Y, b.y, 0, 1024); cmp(4, ws + WS_Y, b.y, 1024, 2048); }
        ref::mixer_out(stream, d_in, l, b);
        if (l < NLD) { cmp(0, xfast, b.x, 0, 0);
#if MK_DEBUG == 2
            fast(3, 4, l, 4, 6);
#else
            fast(3, 4, l, 4, 5); fast(3, 4, l, 5, 6);
#endif
        }
        ref::cross(stream, d_in, l, b);
        if (l < NLD) { cmp(0, xfast, b.x, 0, 0);
#if MK_DEBUG == 2
            fast(3, 4, l, 6, 8);
#else
            fast(3, 4, l, 6, 7); fast(3, 4, l, 7, 8);
#endif
        }
        ref::ffn(stream, d_in, l, b);
        if (l < NLD) cmp(0, xfast, b.x, 0, 0);
    }
    hipLaunchKernelGGL(ref::rmsnorm_k, dim3(S), dim3(256), 0, stream, b.x, DM, (const float*)d_in[22], b.x, DM, DM);
    hipLaunchKernelGGL(dbg::fin_k, dim3(1), dim3(64), 0, stream, (const double*)acc, stage, (float)MK_DEBUG_THR, (float*)d_out);
#endif
}
```

```cpp
#include <hip/hip_runtime.h>
#include <cstdio>
#include <cstdint>
#include <cmath>
#define X_PRIO47 1
#define LAS __attribute__((address_space(3)))
#define GAS __attribute__((address_space(1)))
typedef unsigned short bf16_t;
typedef short bf16x8 __attribute__((ext_vector_type(8)));
#ifndef X_NODUMMY
#define X_NODUMMY 0
#endif
typedef short s16x4 __attribute__((ext_vector_type(4)));
typedef float f32x2 __attribute__((ext_vector_type(2)));
typedef float f32x4 __attribute__((ext_vector_type(4)));
typedef float f32x16 __attribute__((ext_vector_type(16)));
typedef unsigned u32x2 __attribute__((ext_vector_type(2)));
typedef unsigned u32x4 __attribute__((ext_vector_type(4)));
typedef GAS unsigned gu32;

namespace fk {
constexpr int S = 8192, DM = 2048, NPROJ = 4096, DFF = 5632;
constexpr float EPS = 1e-6f;
constexpr float LOG2E = 1.4426950408889634f;
constexpr float QSC_NA = 0.08838834764831845f * LOG2E, QSC_MLA = 0.07216878364870323f * LOG2E, QSC_X = 0.04419417382415922f * LOG2E;

__device__ __forceinline__ int lane_id(int dep = 0) { unsigned z; asm volatile("s_mul_i32 %0, %1, 0" : "=s"(z) : "s"(dep)); return (int)__builtin_amdgcn_mbcnt_hi(~0u, __builtin_amdgcn_mbcnt_lo(~0u, z)); }
__device__ __forceinline__ float shi(float v, int src) { return __int_as_float(__builtin_amdgcn_ds_bpermute(src << 2, __float_as_int(v))); }
__device__ __forceinline__ float shx(float v, int mask, int lane) { return shi(v, lane ^ mask); }
typedef float f32x2_cv __attribute__((ext_vector_type(2))); typedef __bf16 bf16x2_cv __attribute__((ext_vector_type(2)));
__device__ __forceinline__ unsigned cvt_pk_bf16(float lo, float hi) { const f32x2_cv v = {lo, hi}; const bf16x2_cv b = __builtin_convertvector(v, bf16x2_cv); return __builtin_bit_cast(unsigned, b); }
__device__ __forceinline__ float bf_lo(unsigned w) { return __uint_as_float(w << 16); }
__device__ __forceinline__ float bf_hi(unsigned w) { return __uint_as_float(w & 0xffff0000u); }
__device__ __forceinline__ u32x4 pack8(f32x4 a, f32x4 b) { u32x4 w; w.x = cvt_pk_bf16(a[0], a[1]); w.y = cvt_pk_bf16(a[2], a[3]); w.z = cvt_pk_bf16(b[0], b[1]); w.w = cvt_pk_bf16(b[2], b[3]); return w; }

constexpr int BM = 256, BK = 64, HALF = 128, HTB = HALF * BK * 2, STAGE_BYTES = 8 * HTB, NXCD = 8, WGM = 8;
__host__ __device__ __forceinline__ int lds_byte(int r, int c) { const int st = (r >> 4) * 2 + (c >> 5), rr = r & 15, cc = c & 31, ob = rr * 64 + cc * 2; return st * 1024 + (ob ^ (((ob >> 9) & 1) << 5)); }
__host__ __device__ __forceinline__ void stage_rc(int b, int& R, int& C) { const int st = b / 1024, sb = b % 1024, swz = sb ^ (((sb >> 9) & 1) << 5); R = (st >> 1) * 16 + swz / 64; C = (st & 1) * 32 + (swz % 64) / 2; }
__host__ __device__ __forceinline__ int perm32(int rho) { const int n = rho >> 4, i = rho & 15; return 8 * (i >> 2) + 4 * n + (i & 3); }

struct Unit { int pm, pn, z; };
struct Gemm { const bf16_t* A; const bf16_t* Bt; int lda, ldb, K; long sAz, sBz; };

struct GridOrder {
    int nM, nN, nZ, nwg, G, c; int xm, xi;
    __device__ __forceinline__ void init(int nM_, int nN_, int nZ_, int G_, int c_) { nM = nM_; nN = nN_; nZ = nZ_; nwg = nM * nN * nZ; G = G_; c = c_; xm = 0; xi = 0; }
    __device__ __forceinline__ void init_x(int nN_, int xi_, int rank_, int nlim = 1 << 30) { nM = 32; nN = nN_; nZ = 1; nwg = 4 * nN_ < nlim ? 4 * nN_ : nlim; G = 32; c = rank_; xm = 1; xi = xi_; }
    __device__ __forceinline__ bool next(int i, Unit& u) const {
        const long L = (long)i * G + c; if (L >= nwg) return false;
        int wgid = (int)L, pm, pn, z;
        if (xm) { pm = 4 * xi + (wgid & 3); pn = wgid >> 2; z = 0; }
        else if (nZ == 1) {
            { const int q = nwg / NXCD, r = nwg % NXCD, xcd = wgid % NXCD, off = wgid / NXCD; wgid = (xcd < r ? xcd * (q + 1) : r * (q + 1) + (xcd - r) * q) + off; }
            const int nig = WGM * nN, gid = wgid / nig, fm = gid * WGM, gsz = (nM - fm) < WGM ? (nM - fm) : WGM;
            pm = fm + ((wgid % nig) % gsz); pn = (wgid % nig) / gsz; z = 0;
        } else { const int per = nM * nN; z = wgid / per; const int r = wgid % per; pm = r % nM; pn = r / nM; }
        u.pm = pm; u.pn = pn; u.z = z;
        return true;
    }
};

template <int NAI> using AccT = f32x4[NAI][2][4][2];
typedef AccT<2> Acc;

template <int NP4, int NAI = 2> __device__ __forceinline__ void wave_rstd(float (&rs)[2][4], const float* ssq, int ld, int row0, int lane, int fr, float inv_dim) {
    const GAS f32x4* pa = (const GAS f32x4*)(ssq + (size_t)(row0 + lane) * ld); const GAS f32x4* pb = (const GAS f32x4*)(ssq + (size_t)(row0 + (NAI == 2 ? 128 : 0) + lane) * ld);
    float a = 0.f, b = 0.f;
#pragma unroll
    for (int j = 0; j < NP4; ++j) { const f32x4 v = pa[j]; a += (v[0] + v[1]) + (v[2] + v[3]); if (NAI == 2) { const f32x4 w = pb[j]; b += (w[0] + w[1]) + (w[2] + w[3]); } }
    a = 1.0f / sqrtf(a * inv_dim + EPS); b = 1.0f / sqrtf(b * inv_dim + EPS);
#pragma unroll
    for (int m = 0; m < 4; ++m) { rs[0][m] = shi(a, m * 16 + fr); rs[1][m] = (NAI == 2) ? shi(b, m * 16 + fr) : 0.f; }
}
__device__ __forceinline__ float dpp_add8(float v) {
    v += __int_as_float(__builtin_amdgcn_update_dpp(0, __float_as_int(v), 0xB1, 0xF, 0xF, true));
    v += __int_as_float(__builtin_amdgcn_update_dpp(0, __float_as_int(v), 0x4E, 0xF, 0xF, true));
    v += __int_as_float(__builtin_amdgcn_update_dpp(0, __float_as_int(v), 0x141, 0xF, 0xF, true));
    return v;
}
template <int NAI> struct RsRegs { f32x4 va[8], vb[NAI == 2 ? 8 : 1]; };
template <int NAI = 2> __device__ __forceinline__ void wave_rstd_issue8(RsRegs<NAI>& r, const float* ssq, int row0, int lane) {
    const GAS f32x4* pa = (const GAS f32x4*)(ssq + (size_t)row0 * 32) + lane; const GAS f32x4* pb = (const GAS f32x4*)(ssq + (size_t)(row0 + 128) * 32) + lane;
#pragma unroll
    for (int k = 0; k < 8; ++k) { r.va[k] = pa[64 * k]; if (NAI == 2) r.vb[k] = pb[64 * k]; }
}
template <int NAI = 2> __device__ __forceinline__ void wave_rstd_finish8(const RsRegs<NAI>& r, int lane, float inv_dim, LAS float* cache) {
    float sa[8], sb[8];
#pragma unroll
    for (int k = 0; k < 8; ++k) { const f32x4 v = r.va[k]; sa[k] = dpp_add8((v[0] + v[1]) + (v[2] + v[3])); if (NAI == 2) { const f32x4 w = r.vb[k]; sb[k] = dpp_add8((w[0] + w[1]) + (w[2] + w[3])); } }
    float xa = sa[0], xb = (NAI == 2) ? sb[0] : 0.f; const int kk = lane & 7;
#pragma unroll
    for (int k = 1; k < 8; ++k) { xa = (kk == k) ? sa[k] : xa; if (NAI == 2) xb = (kk == k) ? sb[k] : xb; }
    const int rr = 8 * kk + (lane >> 3);
    cache[rr] = 1.0f / sqrtf(xa * inv_dim + EPS); if (NAI == 2) cache[64 + rr] = 1.0f / sqrtf(xb * inv_dim + EPS);
}
template <int NAI = 2> __device__ __forceinline__ void wave_rstd_fill8(const float* ssq, int row0, int lane, float inv_dim, LAS float* cache) {
    RsRegs<NAI> r; wave_rstd_issue8<NAI>(r, ssq, row0, lane); wave_rstd_finish8<NAI>(r, lane, inv_dim, cache);
}
template <int NP4, int NAI = 2> __device__ __forceinline__ void wave_rstd_c(float (&rs)[2][4], const float* ssq, int ld, int row0, int lane, int fr, float inv_dim, LAS float* cache, int hit) {
    static_assert(NP4 == 8, "cached form: 32 partials per row");
    if (!hit) wave_rstd_fill8<NAI>(ssq, row0, lane, inv_dim, cache);
    const float a = cache[lane], b = (NAI == 2) ? cache[64 + lane] : 0.f;
#pragma unroll
    for (int m = 0; m < 4; ++m) { rs[0][m] = shi(a, m * 16 + fr); rs[1][m] = (NAI == 2) ? shi(b, m * 16 + fr) : 0.f; }
}
__device__ __forceinline__ float sumsq8(f32x4 a, f32x4 b) { return ((a[0] * a[0] + a[1] * a[1]) + (a[2] * a[2] + a[3] * a[3])) + ((b[0] * b[0] + b[1] * b[1]) + (b[2] * b[2] + b[3] * b[3])); }
__device__ __forceinline__ void rope8(f32x4& v0, f32x4& v1, f32x4 c, f32x4 s) {
    const f32x4 a = v0, b = v1;
    v0[0] = a[0] * c[0] - a[1] * s[0]; v0[1] = a[0] * s[0] + a[1] * c[0]; v0[2] = a[2] * c[1] - a[3] * s[1]; v0[3] = a[2] * s[1] + a[3] * c[1];
    v1[0] = b[0] * c[2] - b[1] * s[2]; v1[1] = b[0] * s[2] + b[1] * c[2]; v1[2] = b[2] * c[3] - b[3] * s[3]; v1[3] = b[2] * s[3] + b[3] * c[3];
}

template <int NP4> struct EpiRow {
    static constexpr bool HAS_MID = false, HAS_INIT = false;
    bf16_t* O; int ldc; long sOz;
    const float* ssq_in; int ld_in; float inv_dim;
    int rope_pn; int rope_full; const float* ctab; const float* stab;
    float* ssq_out; int ssq_pn0, ssq_pn1;
    __device__ __forceinline__ void mid(Acc&, const Unit&, int, int, int, int, LAS unsigned char*) const {}
    static constexpr bool RS_CACHE = (NP4 > 0);
    __device__ __forceinline__ void rs_issue(RsRegs<2>& r, const Unit& u, int wr, int lane) const {
        if constexpr (NP4 == 8) wave_rstd_issue8<2>(r, ssq_in, u.pm * BM + wr * 64, lane);
        else if constexpr (NP4 > 0) { const GAS f32x4* pa = (const GAS f32x4*)(ssq_in + (size_t)(u.pm * BM + wr * 64 + lane) * ld_in); const GAS f32x4* pb = (const GAS f32x4*)(ssq_in + (size_t)(u.pm * BM + wr * 64 + 128 + lane) * ld_in);
#pragma unroll
            for (int j = 0; j < NP4; ++j) { r.va[j] = pa[j]; r.vb[j] = pb[j]; } }
    }
    __device__ __forceinline__ void rs_finish(const RsRegs<2>& r, int wr, int wc, int lane, LAS unsigned char* ex) const {
        LAS float* cache = (LAS float*)(ex + (wr * 4 + wc) * 512);
        if constexpr (NP4 == 8) wave_rstd_finish8<2>(r, lane, inv_dim, cache);
        else if constexpr (NP4 > 0) { float a = 0.f, b = 0.f;
#pragma unroll
            for (int j = 0; j < NP4; ++j) { const f32x4 v = r.va[j], w = r.vb[j]; a += (v[0] + v[1]) + (v[2] + v[3]); b += (w[0] + w[1]) + (w[2] + w[3]); }
            cache[lane] = 1.0f / sqrtf(a * inv_dim + EPS); cache[64 + lane] = 1.0f / sqrtf(b * inv_dim + EPS); }
    }
    __device__ __forceinline__ void run(Acc& acc, const Unit& u, int wr, int wc, int fr, int fq, int lane, LAS unsigned char* ex, int hit = 0) const {
        float rs[2][4];
        if constexpr (NP4 > 0) {
            if (!hit) { RsRegs<2> r; rs_issue(r, u, wr, lane); rs_finish(r, wr, wc, lane, ex); }
            LAS float* cache = (LAS float*)(ex + (wr * 4 + wc) * 512); const float a = cache[lane], b = cache[64 + lane];
#pragma unroll
            for (int m = 0; m < 4; ++m) { rs[0][m] = shi(a, m * 16 + fr); rs[1][m] = shi(b, m * 16 + fr); }
        }
        const bool do_ssq = (u.pn >= ssq_pn0 && u.pn < ssq_pn1);
        const bool rope_t = (u.pn >= rope_pn);
        bf16_t* base = O + (size_t)u.z * sOz;
        const int col0 = u.pn * BM + wc * 32 + 8 * fq;
        f32x4 rc[2][4], rsn[2][4];
        if (rope_t) { const int j0 = 16 * (wc & 1) + 4 * fq;
#pragma unroll
            for (int ai = 0; ai < 2; ++ai)
#pragma unroll
                for (int m = 0; m < 4; ++m) { const int row = u.pm * BM + ai * HALF + wr * 64 + m * 16 + fr;
                    rc[ai][m] = *(const GAS f32x4*)(ctab + (size_t)row * 32 + j0); rsn[ai][m] = *(const GAS f32x4*)(stab + (size_t)row * 32 + j0); } }
#pragma unroll
        for (int ai = 0; ai < 2; ++ai)
#pragma unroll
            for (int m = 0; m < 4; ++m) {
                const int row = u.pm * BM + ai * HALF + wr * 64 + m * 16 + fr;
                const float s = (NP4 > 0) ? rs[ai][m] : 1.0f;
                float q = 0.f;
#pragma unroll
                for (int bj = 0; bj < 2; ++bj) {
                    f32x4 v0 = acc[ai][bj][m][0] * s, v1 = acc[ai][bj][m][1] * s;
                    if (rope_t && (rope_full || (bj == 0 && wc < 2))) rope8(v0, v1, rc[ai][m], rsn[ai][m]);
                    q += sumsq8(v0, v1);
                    *(GAS u32x4*)(base + (size_t)row * ldc + col0 + bj * HALF) = pack8(v0, v1);
                }
                if (do_ssq) { q += shx(q, 16, lane); q += shx(q, 32, lane); if (fq == 0) ((GAS float*)ssq_out)[(size_t)row * 16 + (u.pn - ssq_pn0) * 4 + wc] = q; }
            }
    }
};

template <bool MID> struct EpiRes {
    static constexpr bool HAS_MID = MID, HAS_INIT = true, RS_CACHE = false;
    const float* base32; bf16_t* xb; bf16_t* xo; float* ssq_x;
    const float* ssq_y;
    __device__ __forceinline__ void mid(Acc& acc, const Unit& u, int wr, int wc, int fr, int lane, LAS unsigned char* ex) const {
        if constexpr (MID) {
            const LAS float* cache = (const LAS float*)(ex + (wr * 4 + wc) * 1024);
            const float ra = cache[lane], rb = cache[64 + lane];
#pragma unroll
            for (int m = 0; m < 4; ++m) { const float r0 = shi(ra, m * 16 + fr), r1 = shi(rb, m * 16 + fr);
#pragma unroll
                for (int bj = 0; bj < 2; ++bj)
#pragma unroll
                    for (int n = 0; n < 2; ++n) { acc[0][bj][m][n] *= r0; acc[1][bj][m][n] *= r1; } }
        }
    }
    __device__ __forceinline__ void init(Acc& acc, const Unit& u, int wr, int wc, int fr, int fq, int lane, LAS unsigned char* ex) const {
        float sc[2][4];
        if constexpr (MID) {
            const int row0 = u.pm * BM + wr * 64; float a, b;
            LAS float* cache = (LAS float*)(ex + (wr * 4 + wc) * 1024);
            { const GAS f32x4* p = (const GAS f32x4*)(ssq_y + (size_t)(row0 + lane) * 16); const f32x4 a0 = p[0], a1 = p[1], b0 = p[2], b1 = p[3];
              const float na = (((a0[0] + a0[1]) + (a0[2] + a0[3])) + ((a1[0] + a1[1]) + (a1[2] + a1[3]))) * (1.0f / 1024.0f) + EPS, ml = (((b0[0] + b0[1]) + (b0[2] + b0[3])) + ((b1[0] + b1[1]) + (b1[2] + b1[3]))) * (1.0f / 1024.0f) + EPS;
              a = sqrtf(na); cache[lane] = sqrtf(ml / na); cache[128 + lane] = 1.0f / sqrtf(ml); }
            { const GAS f32x4* p = (const GAS f32x4*)(ssq_y + (size_t)(row0 + 128 + lane) * 16); const f32x4 a0 = p[0], a1 = p[1], b0 = p[2], b1 = p[3];
              const float na = (((a0[0] + a0[1]) + (a0[2] + a0[3])) + ((a1[0] + a1[1]) + (a1[2] + a1[3]))) * (1.0f / 1024.0f) + EPS, ml = (((b0[0] + b0[1]) + (b0[2] + b0[3])) + ((b1[0] + b1[1]) + (b1[2] + b1[3]))) * (1.0f / 1024.0f) + EPS;
              b = sqrtf(na); cache[64 + lane] = sqrtf(ml / na); cache[192 + lane] = 1.0f / sqrtf(ml); }
#pragma unroll
            for (int m = 0; m < 4; ++m) { sc[0][m] = shi(a, m * 16 + fr); sc[1][m] = shi(b, m * 16 + fr); }
        }
        const int col0 = u.pn * BM + wc * 32 + 8 * fq;
        if (base32) {
#pragma unroll
            for (int ai = 0; ai < 2; ++ai)
#pragma unroll
                for (int m = 0; m < 4; ++m) {
                    const size_t off = (size_t)(u.pm * BM + ai * HALF + wr * 64 + m * 16 + fr) * DM + col0;
#pragma unroll
                    for (int bj = 0; bj < 2; ++bj) {
                        f32x4 b0 = *(const GAS f32x4*)(base32 + off + bj * HALF), b1 = *(const GAS f32x4*)(base32 + off + bj * HALF + 4);
                        if constexpr (MID) { b0 = b0 * sc[ai][m]; b1 = b1 * sc[ai][m]; }
                        acc[ai][bj][m][0] = b0; acc[ai][bj][m][1] = b1;
                    }
                }
        } else {
            u32x4 w[2][4][2];
#pragma unroll
            for (int ai = 0; ai < 2; ++ai)
#pragma unroll
                for (int m = 0; m < 4; ++m) {
                    const size_t off = (size_t)(u.pm * BM + ai * HALF + wr * 64 + m * 16 + fr) * DM + col0;
#pragma unroll
                    for (int bj = 0; bj < 2; ++bj) w[ai][m][bj] = *(const GAS u32x4*)(xb + off + bj * HALF);
                }
#pragma unroll
            for (int ai = 0; ai < 2; ++ai)
#pragma unroll
                for (int m = 0; m < 4; ++m)
#pragma unroll
                    for (int bj = 0; bj < 2; ++bj) {
                        const u32x4 v = w[ai][m][bj];
                        f32x4 b0 = (f32x4){bf_lo(v.x), bf_hi(v.x), bf_lo(v.y), bf_hi(v.y)}, b1 = (f32x4){bf_lo(v.z), bf_hi(v.z), bf_lo(v.w), bf_hi(v.w)};
                        if constexpr (MID) { b0 = b0 * sc[ai][m]; b1 = b1 * sc[ai][m]; }
                        acc[ai][bj][m][0] = b0; acc[ai][bj][m][1] = b1;
                    }
        }
    }
    __device__ __forceinline__ void run(Acc& acc, const Unit& u, int wr, int wc, int fr, int fq, int lane, LAS unsigned char* ex) const {
        float rs[2][4];
        if constexpr (MID) { const LAS float* cache = (const LAS float*)(ex + (wr * 4 + wc) * 1024); const float ma = cache[128 + lane], mb = cache[192 + lane];
#pragma unroll
            for (int m = 0; m < 4; ++m) { rs[0][m] = shi(ma, m * 16 + fr); rs[1][m] = shi(mb, m * 16 + fr); } }
        const int col0 = u.pn * BM + wc * 32 + 8 * fq;
#pragma unroll
        for (int ai = 0; ai < 2; ++ai)
#pragma unroll
            for (int m = 0; m < 4; ++m) {
                const int row = u.pm * BM + ai * HALF + wr * 64 + m * 16 + fr;
                const float s = MID ? rs[ai][m] : 1.0f;
                const size_t off = (size_t)row * DM + col0;
                float q = 0.f;
#pragma unroll
                for (int bj = 0; bj < 2; ++bj) {
                    const f32x4 v0 = acc[ai][bj][m][0] * s, v1 = acc[ai][bj][m][1] * s;
                    *(GAS u32x4*)(xo + off + bj * HALF) = pack8(v0, v1);
                    q += sumsq8(v0, v1);
                }
                q += shx(q, 16, lane); q += shx(q, 32, lane);
                if (fq == 0) ((GAS float*)ssq_x)[(size_t)row * 32 + u.pn * 4 + wc] = q;
            }
    }
};

template <int NAI> struct EpiSoftmaxT {
    static constexpr bool HAS_MID = false, HAS_INIT = false, RS_CACHE = false;
    bf16_t* P; const float* ssq_x;
    __device__ __forceinline__ void mid(AccT<NAI>&, const Unit&, int, int, int, int, LAS unsigned char*) const {}
    static constexpr bool RS_PRE = (NAI == 1);
    __device__ __forceinline__ void rs_issue(RsRegs<1>& r, const Unit& u, int wr, int lane) const { wave_rstd_issue8<1>(r, ssq_x, u.pm * HALF + wr * 64, lane); }
    __device__ __forceinline__ void rs_finish(const RsRegs<1>& r, float (&keep)[4], int lane, int fr) const {
        float sa[8];
#pragma unroll
        for (int k = 0; k < 8; ++k) { const f32x4 v = r.va[k]; sa[k] = dpp_add8((v[0] + v[1]) + (v[2] + v[3])); }
#pragma unroll
        for (int m = 0; m < 4; ++m) { float lo_ = sa[2 * m], hi_ = sa[2 * m + 1]; asm("" : "+v"(lo_), "+v"(hi_));
            const float v = shi((fr & 8) ? hi_ : lo_, 8 * (fr & 7)); keep[m] = 1.0f / sqrtf(v * (1.0f / (float)DM) + EPS); }
    }
    __device__ __forceinline__ void run(AccT<NAI>& acc, const Unit& u, int wr, int wc, int fr, int fq, int lane, LAS unsigned char* ex) const {
        float rs[2][4];
        wave_rstd<8, NAI>(rs, ssq_x, 32, u.pm * (HALF * NAI) + wr * 64, lane, fr, 1.0f / (float)DM);
        run_rs(acc, u, wr, wc, fr, fq, lane, ex, rs);
    }
    __device__ __forceinline__ void run_keep(AccT<NAI>& acc, const Unit& u, int wr, int wc, int fr, int fq, int lane, LAS unsigned char* ex, const float (&keep)[4]) const {
        float rs[2][4];
#pragma unroll
        for (int m = 0; m < 4; ++m) { rs[0][m] = keep[m]; rs[1][m] = 0.f; }
        run_rs(acc, u, wr, wc, fr, fq, lane, ex, rs);
    }
    __device__ __forceinline__ void run_rs(AccT<NAI>& acc, const Unit& u, int wr, int wc, int fr, int fq, int lane, LAS unsigned char* ex, float (&rs)[2][4]) const {
        LAS f32x2* X = (LAS f32x2*)ex;
#pragma unroll
        for (int ai = 0; ai < NAI; ++ai)
#pragma unroll
            for (int m = 0; m < 4; ++m) {
                const float s = rs[ai][m]; float mx = -INFINITY;
#pragma unroll
                for (int bj = 0; bj < 2; ++bj)
#pragma unroll
                    for (int n = 0; n < 2; ++n) { f32x4 v = acc[ai][bj][m][n] * s; acc[ai][bj][m][n] = v; mx = fmaxf(mx, fmaxf(fmaxf(v[0], v[1]), fmaxf(v[2], v[3]))); }
                mx = fmaxf(mx, shx(mx, 16, lane)); mx = fmaxf(mx, shx(mx, 32, lane));
                float sm = 0.f;
#pragma unroll
                for (int bj = 0; bj < 2; ++bj)
#pragma unroll
                    for (int n = 0; n < 2; ++n) { f32x4 v = acc[ai][bj][m][n];
                        v[0] = __builtin_amdgcn_exp2f(v[0] - mx); v[1] = __builtin_amdgcn_exp2f(v[1] - mx); v[2] = __builtin_amdgcn_exp2f(v[2] - mx); v[3] = __builtin_amdgcn_exp2f(v[3] - mx);
                        acc[ai][bj][m][n] = v; sm += (v[0] + v[1]) + (v[2] + v[3]); }
                sm += shx(sm, 16, lane); sm += shx(sm, 32, lane);
                rs[ai][m] = mx;
                if (fq == 0) X[(ai * HALF + wr * 64 + m * 16 + fr) * 4 + wc] = (f32x2){mx, sm};
            }
        asm volatile("s_waitcnt lgkmcnt(0)" ::: "memory"); __builtin_amdgcn_s_barrier(); asm volatile("" ::: "memory");
        const int col0 = u.pn * BM + wc * 32 + 8 * fq;
#pragma unroll
        for (int ai = 0; ai < NAI; ++ai)
#pragma unroll
            for (int m = 0; m < 4; ++m) {
                const int rl = ai * HALF + wr * 64 + m * 16 + fr, row = u.pm * (HALF * NAI) + rl;
                const f32x2 a = X[rl * 4 + 0], b = X[rl * 4 + 1], c = X[rl * 4 + 2], d = X[rl * 4 + 3];
                const float M = fmaxf(fmaxf(a[0], b[0]), fmaxf(c[0], d[0]));
                const float tot = (a[1] * __builtin_amdgcn_exp2f(a[0] - M) + b[1] * __builtin_amdgcn_exp2f(b[0] - M)) + (c[1] * __builtin_amdgcn_exp2f(c[0] - M) + d[1] * __builtin_amdgcn_exp2f(d[0] - M));
                const float f = __builtin_amdgcn_exp2f(rs[ai][m] - M) / tot;
#pragma unroll
                for (int bj = 0; bj < 2; ++bj)
                    *(GAS u32x4*)(P + (size_t)row * 1024 + col0 + bj * HALF) = pack8(acc[ai][bj][m][0] * f, acc[ai][bj][m][1] * f);
            }
    }
};

template <int NAI> struct EpiSwigluT {
    static constexpr bool HAS_MID = false, HAS_INIT = false;
    bf16_t* H; const float* ssq_x; int reuse = 0;
    __device__ __forceinline__ void mid(AccT<NAI>&, const Unit&, int, int, int, int, LAS unsigned char*) const {}
    static constexpr bool RS_CACHE = true, RS_PRE = false;
    __device__ __forceinline__ void rs_issue(RsRegs<NAI>& r, const Unit& u, int wr, int lane) const { wave_rstd_issue8<NAI>(r, ssq_x, u.pm * (HALF * NAI) + wr * 64, lane); }
    __device__ __forceinline__ void rs_finish(const RsRegs<NAI>& r, int wr, int wc, int lane, LAS unsigned char* ex) const { wave_rstd_finish8<NAI>(r, lane, 1.0f / (float)DM, (LAS float*)(ex + (wr * 4 + wc) * 512)); }
    __device__ __forceinline__ void run(AccT<NAI>& acc, const Unit& u, int wr, int wc, int fr, int fq, int lane, LAS unsigned char* ex, int hit = 0) const {
        float rs[2][4];
        wave_rstd_c<8, NAI>(rs, ssq_x, 32, u.pm * (HALF * NAI) + wr * 64, lane, fr, 1.0f / (float)DM, (LAS float*)(ex + (wr * 4 + wc) * 512) + ((NAI == 1 && reuse) ? (u.pm & 1) * 64 : 0), hit | reuse);
        const int col0 = u.pn * HALF + wc * 32 + 8 * fq;
#pragma unroll
        for (int ai = 0; ai < NAI; ++ai)
#pragma unroll
            for (int m = 0; m < 4; ++m) {
                const int row = u.pm * (HALF * NAI) + ai * HALF + wr * 64 + m * 16 + fr; const float s = rs[ai][m];
                f32x4 o[2];
#pragma unroll
                for (int n = 0; n < 2; ++n) { const f32x4 g = acc[ai][0][m][n] * s, up = acc[ai][1][m][n] * s;
                    f32x4 t = g * (-LOG2E);
                    t = (f32x4){__builtin_amdgcn_exp2f(t[0]), __builtin_amdgcn_exp2f(t[1]), __builtin_amdgcn_exp2f(t[2]), __builtin_amdgcn_exp2f(t[3])};
                    t = t + 1.0f;
                    t = (f32x4){__builtin_amdgcn_rcpf(t[0]), __builtin_amdgcn_rcpf(t[1]), __builtin_amdgcn_rcpf(t[2]), __builtin_amdgcn_rcpf(t[3])};
                    o[n] = (g * up) * t; }
                *(GAS u32x4*)(H + (size_t)row * DFF + col0) = pack8(o[0], o[1]);
            }
    }
};

typedef EpiSoftmaxT<2> EpiSoftmax; typedef EpiSwigluT<2> EpiSwiglu;

template <class Epi, class Sched>
__device__ __forceinline__ void gemm_phase(LAS unsigned char* lds, LAS unsigned char* ex, const Gemm g, const Sched& S_, const Epi& E, int wid_, bool skip_epi = false) {
    int wid = wid_; asm volatile("" : "+s"(wid));
    const int lane = lane_id(), tid = wid * 64 + lane, wr = wid >> 2, wc = wid & 3, fr = lane & 15, fq = lane >> 4;
    int nt = g.K / BK; asm volatile("" : "+s"(nt));
    unsigned voffA[2], voffB[2];
#pragma unroll
    for (int i = 0; i < 2; ++i) { int R, C; stage_rc(tid * 16 + i * 8192, R, C); const int Rb = (R & ~31) + perm32(R & 31);
        voffA[i] = (unsigned)(R * g.lda + C) * 2u; voffB[i] = (unsigned)(Rb * g.ldb + C) * 2u; }
    const size_t kstep = (size_t)(BK * 2);
    const size_t hstepA = (size_t)HALF * g.lda * 2, hstepB = (size_t)HALF * g.ldb * 2;
    const unsigned ldsw = (unsigned)wid * 1024u;
    const int aoff = lds_byte(wr * 64 + fr, fq * 8), boff = lds_byte(wc * 32 + fr, fq * 8);
#define PG8_SA(b, h) (((b) * 2 + (h)) * HTB)
#define PG8_SB(b, h) ((4 + (b) * 2 + (h)) * HTB)
#define PG8_STAGE(bufoff, gbase, voff) do { _Pragma("unroll") for (int _i = 0; _i < 2; ++_i) \
        __builtin_amdgcn_global_load_lds((const unsigned*)((const char*)(gbase) + (voff)[_i]), (LAS unsigned*)(lds + (bufoff) + ldsw + _i * 8192), 16, 0, 0); } while (0)
#define PG8_LDA(dst, b, h) do { _Pragma("unroll") for (int m = 0; m < 4; ++m) _Pragma("unroll") for (int k = 0; k < 2; ++k) dst[m][k] = *(const LAS bf16x8*)(lds + PG8_SA(b, h) + aoff + m * 2048 + k * 1024); } while (0)
#define PG8_LDB(dst, b, h) do { _Pragma("unroll") for (int n = 0; n < 2; ++n) _Pragma("unroll") for (int k = 0; k < 2; ++k) dst[n][k] = *(const LAS bf16x8*)(lds + PG8_SB(b, h) + boff + n * 2048 + k * 1024); } while (0)
#define PG8_MMA(ai, bj, At, Bt) do { __builtin_amdgcn_s_setprio(1); _Pragma("unroll") for (int m = 0; m < 4; ++m) _Pragma("unroll") for (int n = 0; n < 2; ++n) _Pragma("unroll") for (int k = 0; k < 2; ++k) \
        acc[ai][bj][m][n] = __builtin_amdgcn_mfma_f32_16x16x32_bf16(Bt[n][k], At[m][k], acc[ai][bj][m][n], 0, 0, 0); __builtin_amdgcn_s_setprio(0); } while (0)
#define PG8_WAIT_V(n) asm volatile("s_waitcnt vmcnt(" #n ")" ::: "memory")
#define PG8_WAIT_L(n) asm volatile("s_waitcnt lgkmcnt(" #n ")" ::: "memory")
#define PG8_BAR __builtin_amdgcn_s_barrier()
#define PG8_SCHED __builtin_amdgcn_sched_barrier(0)
    Unit cur, nxt; int ui = 0; int prev_pm = -1; (void)prev_pm;
    if (!S_.next(0, cur)) return;
    Acc acc;
    if constexpr (!Epi::HAS_INIT) {
#pragma unroll
    for (int a = 0; a < 2; ++a)
#pragma unroll
        for (int b = 0; b < 2; ++b)
#pragma unroll
            for (int m = 0; m < 4; ++m)
#pragma unroll
                for (int n = 0; n < 2; ++n) acc[a][b][m][n] = (f32x4){0.f, 0.f, 0.f, 0.f};
    }
    bf16x8 At[4][2], B0[2][2], B1[2][2];
    const char* cA = (const char*)(g.A + (size_t)cur.z * g.sAz) + (size_t)cur.pm * 2 * hstepA; const char* cB = (const char*)(g.Bt + (size_t)cur.z * g.sBz) + (size_t)cur.pn * 2 * hstepB;
    RsRegs<2> rsr; (void)rsr; int rs_lane = 0; (void)rs_lane;
    if constexpr (Epi::RS_CACHE) { rs_lane = lane_id(2); E.rs_issue(rsr, cur, wr, rs_lane); }
    PG8_STAGE(PG8_SB(0, 0), cB, voffB); PG8_STAGE(PG8_SB(0, 1), cB + hstepB, voffB); PG8_STAGE(PG8_SA(0, 0), cA, voffA); PG8_STAGE(PG8_SA(0, 1), cA + hstepA, voffA);
    if constexpr (Epi::RS_CACHE) { E.rs_finish(rsr, wr, wc, rs_lane, ex); prev_pm = cur.pm; }
    if constexpr (Epi::HAS_INIT) { const int ln = lane_id(); E.init(acc, cur, wr, wc, ln & 15, ln >> 4, ln, ex); }
    if (wr == 1) PG8_BAR;
    PG8_WAIT_V(2); PG8_BAR;
    PG8_STAGE(PG8_SB(1, 0), cB + kstep, voffB); PG8_STAGE(PG8_SA(1, 0), cA + kstep, voffA); PG8_STAGE(PG8_SB(1, 1), cB + hstepB + kstep, voffB);
    PG8_WAIT_V(6); PG8_BAR;
    for (;;) {
        const bool has_next = S_.next(ui + 1, nxt);
        const char* nA = has_next ? (const char*)(g.A + (size_t)nxt.z * g.sAz) + (size_t)nxt.pm * 2 * hstepA : cA;
        const char* nB = has_next ? (const char*)(g.Bt + (size_t)nxt.z * g.sBz) + (size_t)nxt.pn * 2 * hstepB : cB;
#pragma nounroll
        for (int t = 0; t < nt; t += 2) {
            const bool last = (t == nt - 2);
            if constexpr (Epi::HAS_MID) { if (t == (nt >> 1)) { const int ln = lane_id(t + ui); E.mid(acc, cur, wr, wc, ln & 15, ln, ex); } }
            const char* a1 = cA + (size_t)(t + 1) * kstep;
            const char* a2 = last ? nA : cA + (size_t)(t + 2) * kstep; const char* b2 = last ? nB : cB + (size_t)(t + 2) * kstep;
            const char* a3 = a2 + kstep; const char* b3 = b2 + kstep;
            PG8_LDB(B0, 0, 0); PG8_LDB(B1, 0, 1); PG8_SCHED; PG8_LDA(At, 0, 0); PG8_STAGE(PG8_SA(1, 1), a1 + hstepA, voffA);
            PG8_WAIT_V(8); PG8_WAIT_L(0); PG8_BAR; PG8_MMA(0, 0, At, B0); PG8_MMA(0, 1, At, B1); PG8_BAR; PG8_SCHED;
            const bool nostage = X_NODUMMY && last && !has_next;
            PG8_LDA(At, 0, 1); if (!nostage) { PG8_STAGE(PG8_SB(0, 0), b2, voffB); PG8_STAGE(PG8_SB(0, 1), b2 + hstepB, voffB); PG8_STAGE(PG8_SA(0, 0), a2, voffA); }
            if (nostage) PG8_WAIT_V(2); else PG8_WAIT_V(8); PG8_WAIT_L(0); PG8_BAR; PG8_MMA(1, 0, At, B0); PG8_MMA(1, 1, At, B1); PG8_BAR; PG8_SCHED;
            PG8_LDB(B0, 1, 0); PG8_LDB(B1, 1, 1); PG8_SCHED; PG8_LDA(At, 1, 0); if (!nostage) PG8_STAGE(PG8_SA(0, 1), a2 + hstepA, voffA);
            if (nostage) PG8_WAIT_V(0); else PG8_WAIT_V(8); PG8_WAIT_L(0); PG8_BAR; PG8_MMA(0, 0, At, B0); PG8_MMA(0, 1, At, B1); PG8_BAR; PG8_SCHED;
            PG8_LDA(At, 1, 1); if (!nostage) { PG8_STAGE(PG8_SB(1, 0), b3, voffB); PG8_STAGE(PG8_SB(1, 1), b3 + hstepB, voffB); PG8_STAGE(PG8_SA(1, 0), a3, voffA); }
            if (!nostage) PG8_WAIT_V(8); PG8_WAIT_L(0); PG8_BAR; PG8_MMA(1, 0, At, B0); PG8_MMA(1, 1, At, B1); PG8_BAR; PG8_SCHED;
        }
        if (wr == 0) PG8_BAR;
        if (!skip_epi) { const int ln = lane_id(ui);
            if constexpr (Epi::RS_CACHE) { const int hit = (cur.pm == prev_pm) ? 1 : 0; prev_pm = cur.pm; E.run(acc, cur, wr, wc, ln & 15, ln >> 4, ln, ex, hit); }
            else E.run(acc, cur, wr, wc, ln & 15, ln >> 4, ln, ex); }
        if (!has_next) break;
        if constexpr (Epi::HAS_INIT) { const int ln = lane_id(ui + 1); E.init(acc, nxt, wr, wc, ln & 15, ln >> 4, ln, ex); }
        else {
#pragma unroll
        for (int a = 0; a < 2; ++a)
#pragma unroll
            for (int b = 0; b < 2; ++b)
#pragma unroll
                for (int m = 0; m < 4; ++m)
#pragma unroll
                    for (int n = 0; n < 2; ++n) acc[a][b][m][n] = (f32x4){0.f, 0.f, 0.f, 0.f};
        }
        cur = nxt; cA = nA; cB = nB; ++ui;
        if (wr == 1) PG8_BAR;
    }
    PG8_WAIT_V(0);
    PG8_BAR;
#undef PG8_SA
#undef PG8_SB
#undef PG8_STAGE
#undef PG8_LDA
#undef PG8_LDB
#undef PG8_MMA
#undef PG8_WAIT_V
#undef PG8_WAIT_L
#undef PG8_BAR
#undef PG8_SCHED
}

struct OneUnit { int pm, pn, has;
    __device__ __forceinline__ bool next(int i, Unit& u) const { u.pm = pm; u.pn = pn; u.z = 0; return i == 0 && has != 0; } };

template <class Epi, class Sched>
__device__ __forceinline__ void gemm_phase128(LAS unsigned char* lds, LAS unsigned char* ex, const Gemm g, const Sched& S_, const Epi& E, int wid_) {
    int wid = wid_; asm volatile("" : "+s"(wid));
    const int lane = lane_id(), tid = wid * 64 + lane, wr = wid >> 2, wc = wid & 3, fr = lane & 15;
    const int nt = g.K / BK;
    unsigned voffA[2], voffB[2];
#pragma unroll
    for (int i = 0; i < 2; ++i) { int R, C; stage_rc(tid * 16 + i * 8192, R, C); const int Rb = (R & ~31) + perm32(R & 31);
        voffA[i] = (unsigned)(R * g.lda + C) * 2u; voffB[i] = (unsigned)(Rb * g.ldb + C) * 2u; }
    const size_t kstep = (size_t)(BK * 2);
    const size_t hstepA = (size_t)HALF * g.lda * 2, hstepB = (size_t)HALF * g.ldb * 2;
    const unsigned ldsw = (unsigned)wid * 1024u;
    const int aoff = lds_byte(wr * 64 + fr, (lane >> 4) * 8), boff = lds_byte(wc * 32 + fr, (lane >> 4) * 8);
    constexpr int SLOT = 3 * HTB;
#define P1_STG(off, gbase, voff) do { _Pragma("unroll") for (int _i = 0; _i < 2; ++_i) \
        __builtin_amdgcn_global_load_lds((const unsigned*)((const char*)(gbase) + (voff)[_i]), (LAS unsigned*)(lds + (off) + ldsw + _i * 8192), 16, 0, 0); } while (0)
#define P1_STAGE(slot, pA, pB) do { P1_STG((slot) * SLOT, pA, voffA); P1_STG((slot) * SLOT + HTB, pB, voffB); P1_STG((slot) * SLOT + 2 * HTB, (pB) + hstepB, voffB); } while (0)
#define P1_LDA(dst, slot) do { _Pragma("unroll") for (int m = 0; m < 4; ++m) _Pragma("unroll") for (int k = 0; k < 2; ++k) dst[m][k] = *(const LAS bf16x8*)(lds + (slot) * SLOT + aoff + m * 2048 + k * 1024); } while (0)
#define P1_LDB(dst, slot, h) do { _Pragma("unroll") for (int n = 0; n < 2; ++n) _Pragma("unroll") for (int k = 0; k < 2; ++k) dst[n][k] = *(const LAS bf16x8*)(lds + (slot) * SLOT + (1 + (h)) * HTB + boff + n * 2048 + k * 1024); } while (0)
#define P1_MMA(bj, At, Bt) do { __builtin_amdgcn_s_setprio(1); _Pragma("unroll") for (int m = 0; m < 4; ++m) _Pragma("unroll") for (int n = 0; n < 2; ++n) _Pragma("unroll") for (int k = 0; k < 2; ++k) \
        acc[0][bj][m][n] = __builtin_amdgcn_mfma_f32_16x16x32_bf16(Bt[n][k], At[m][k], acc[0][bj][m][n], 0, 0, 0); __builtin_amdgcn_s_setprio(0); } while (0)
#define P1_WAIT_V(n) asm volatile("s_waitcnt vmcnt(" #n ")" ::: "memory")
#define P1_WAIT_L(n) asm volatile("s_waitcnt lgkmcnt(" #n ")" ::: "memory")
#define P1_BAR __builtin_amdgcn_s_barrier()
#define P1_SCHED __builtin_amdgcn_sched_barrier(0)
    Unit cur, nxt; int ui = 0;
    if (!S_.next(0, cur)) return;
    AccT<1> acc;
#pragma unroll
    for (int b = 0; b < 2; ++b)
#pragma unroll
        for (int m = 0; m < 4; ++m)
#pragma unroll
            for (int n = 0; n < 2; ++n) acc[0][b][m][n] = (f32x4){0.f, 0.f, 0.f, 0.f};
    bf16x8 At[4][2], B0[2][2], B1[2][2];
    const char* cA = (const char*)g.A + (size_t)cur.pm * hstepA; const char* cB = (const char*)g.Bt + (size_t)cur.pn * 2 * hstepB;
    RsRegs<1> rsr; (void)rsr; float rs_keep[4] = {0.f, 0.f, 0.f, 0.f}; (void)rs_keep; int rs_lane = 0; (void)rs_lane;
    if constexpr (Epi::RS_PRE) { rs_lane = lane_id(3); E.rs_issue(rsr, cur, wr, rs_lane); }
    P1_STAGE(0, cA, cB); P1_STAGE(1, cA + kstep, cB + kstep);
    if constexpr (Epi::RS_PRE) E.rs_finish(rsr, rs_keep, rs_lane, rs_lane & 15);
    if (wr == 1) P1_BAR;
    P1_WAIT_V(6); P1_BAR; P1_BAR;
    int slot = 0;
    for (;;) {
        const bool has_next = S_.next(ui + 1, nxt);
        const char* nA = has_next ? (const char*)g.A + (size_t)nxt.pm * hstepA : cA;
        const char* nB = has_next ? (const char*)g.Bt + (size_t)nxt.pn * 2 * hstepB : cB;
        for (int t = 0; t < nt; ++t) {
            const int t2 = t + 2;
            const char* a2 = (t2 < nt) ? cA + (size_t)t2 * kstep : nA + (size_t)(t2 - nt) * kstep;
            const char* b2 = (t2 < nt) ? cB + (size_t)t2 * kstep : nB + (size_t)(t2 - nt) * kstep;
            const int s2 = (slot == 0) ? 2 : slot - 1;
            P1_LDB(B0, slot, 0); P1_LDB(B1, slot, 1); P1_SCHED; P1_LDA(At, slot); P1_STAGE(s2, a2, b2);
            P1_WAIT_V(6); P1_WAIT_L(0); P1_BAR; P1_MMA(0, At, B0); P1_MMA(1, At, B1); P1_BAR; P1_SCHED;
            slot = (slot == 2) ? 0 : slot + 1;
        }
        if (wr == 0) P1_BAR;
        { const int ln = lane_id(ui); if constexpr (Epi::RS_PRE) E.run_keep(acc, cur, wr, wc, ln & 15, ln >> 4, ln, ex, rs_keep);
          else E.run(acc, cur, wr, wc, ln & 15, ln >> 4, ln, ex); }
        if (!has_next) break;
#pragma unroll
        for (int b = 0; b < 2; ++b)
#pragma unroll
            for (int m = 0; m < 4; ++m)
#pragma unroll
                for (int n = 0; n < 2; ++n) acc[0][b][m][n] = (f32x4){0.f, 0.f, 0.f, 0.f};
        cur = nxt; cA = nA; cB = nB; ++ui;
        if (wr == 1) P1_BAR;
    }
    P1_WAIT_V(0);
    P1_BAR;
#undef P1_STG
#undef P1_STAGE
#undef P1_LDA
#undef P1_LDB
#undef P1_MMA
#undef P1_WAIT_V
#undef P1_WAIT_L
#undef P1_BAR
#undef P1_SCHED
}
}
#ifndef X_PRIO47
#define X_PRIO47 0
#endif
#ifndef X_LATE
#define X_LATE 0
#endif
namespace att {
using namespace fk;
constexpr int NW = 8, QBLK = 32, KVBLK = 64;
constexpr int SHM_V = KVBLK * 128 * 2;
template <int MODE> struct AttL { static constexpr int KSLOT = MODE ? 16384 : 24576, OFF_K = 0, OFF_V = 3 * KSLOT, OFF_WS = OFF_V + 4 * SHM_V, OFF_BIAS = OFF_WS + NW * 64 * 4, END = OFF_BIAS + 4096; };
constexpr int OSTG_PITCH = 272, OSTG_WAVE = 32 * OSTG_PITCH;
static_assert(NW * OSTG_WAVE <= AttL<0>::OFF_WS && NW * OSTG_WAVE <= AttL<1>::OFF_WS && AttL<0>::END <= 147456 && AttL<1>::END <= 147456, "attention LDS map");
constexpr float THR2 = 11.0f;
#define KSWZ(row, colB) ((row) * 256 + ((colB) ^ (((row) & 7) << 4)))
#define KRSWZ(row, colB) ((row) * 128 + ((colB) ^ (((row) & 7) << 4)))
#define SBAR() __builtin_amdgcn_sched_barrier(0)
__device__ __forceinline__ int crow(int r, int hi) { return (r & 3) + 8 * (r >> 2) + 4 * hi; }

#define F2(P, I) ((f32x2){P[I], P[(I) + 1]})
__device__ __forceinline__ float vmax3(float a, float b, float c) { float r; asm("v_max3_f32 %0, %1, %2, %3" : "=v"(r) : "v"(a), "v"(b), "v"(c)); return r; }
__device__ __forceinline__ float vmax3g(float a, float b, float c, float after) { float r; asm("v_max3_f32 %0, %1, %2, %3" : "=v"(r) : "v"(a), "v"(b), "v"(c), "v"(after)); return r; }
__device__ __forceinline__ float vmax2(float a, float b) { float r; asm("v_max_f32 %0, %1, %2" : "=v"(r) : "v"(a), "v"(b)); return r; }
__device__ __forceinline__ void softmax_ref(f32x16& p0, f32x16& p1, f32x16& negm, bool& valid, float& alpha, bf16x8& pa0, bf16x8& pa1, bf16x8& pa2, bf16x8& pa3, float& l_reg) {
  float pmax;
  {
    const float g = fmaxf(p0[15], p1[15]);
    float m0 = vmax3g(p0[0], p0[1], p0[2], g), m1 = vmax3g(p0[8], p0[9], p0[10], g), m2 = vmax3g(p1[0], p1[1], p1[2], g), m3 = vmax3g(p1[8], p1[9], p1[10], g);
    m0 = vmax3(m0, p0[3], p0[4]); m1 = vmax3(m1, p0[11], p0[12]); m2 = vmax3(m2, p1[3], p1[4]); m3 = vmax3(m3, p1[11], p1[12]);
    m0 = vmax3(m0, p0[5], p0[6]); m1 = vmax3(m1, p0[13], p0[14]); m2 = vmax3(m2, p1[5], p1[6]); m3 = vmax3(m3, p1[13], p1[14]);
    m0 = vmax3(m0, m1, p0[7]); m2 = vmax3(m2, m3, p1[7]);
    pmax = vmax3(m0, m2, g); }
  { auto rr = __builtin_amdgcn_permlane32_swap(__float_as_uint(pmax), __float_as_uint(pmax), false, false);
    pmax = vmax2(__uint_as_float(rr[0]), __uint_as_float(rr[1])); }
  alpha = 1.f;
  if (!__builtin_expect(__all(valid && pmax <= THR2), 1)) {
    const bool fin = pmax > -INFINITY;
    const float d = valid ? fmaxf(pmax, 0.f) : (fin ? pmax : 0.f);
    alpha = valid ? __builtin_amdgcn_exp2f(-d) : 1.f;
    valid = valid || fin;
#pragma unroll
    for (int r = 0; r < 16; ++r) { p0[r] -= d; p1[r] -= d; negm[r] -= d; }
  }
#pragma unroll
  for (int r = 0; r < 16; ++r) p0[r] = __builtin_amdgcn_exp2f(p0[r]);
#pragma unroll
  for (int r = 0; r < 16; ++r) p1[r] = __builtin_amdgcn_exp2f(p1[r]);
#define PK4(P, BASE, OUT) do { u32x4 w = {cvt_pk_bf16(P[BASE + 0], P[BASE + 1]), cvt_pk_bf16(P[BASE + 2], P[BASE + 3]), cvt_pk_bf16(P[BASE + 4], P[BASE + 5]), cvt_pk_bf16(P[BASE + 6], P[BASE + 7])}; \
    OUT = *reinterpret_cast<bf16x8*>(&w); } while (0)
  PK4(p0, 0, pa0); PK4(p0, 8, pa1); PK4(p1, 0, pa2); PK4(p1, 8, pa3);
#undef PK4
  {
    f32x2 t0 = F2(p0, 0) + F2(p1, 0), t1 = F2(p0, 2) + F2(p1, 2), t2 = F2(p0, 4) + F2(p1, 4), t3 = F2(p0, 6) + F2(p1, 6);
    f32x2 t4 = F2(p0, 8) + F2(p1, 8), t5 = F2(p0, 10) + F2(p1, 10), t6 = F2(p0, 12) + F2(p1, 12), t7 = F2(p0, 14) + F2(p1, 14);
    t0 += t4; t1 += t5; t2 += t6; t3 += t7; t0 += t2; t1 += t3; t0 += t1;
    l_reg = l_reg * alpha + (t0[0] + t0[1]); }
}
template <int OFF> __device__ __forceinline__ bf16x8 lds_rd128(int addr) { bf16x8 r; asm volatile("ds_read_b128 %0, %1 offset:%2" : "=v"(r) : "v"(addr), "i"(OFF)); return r; }
template <int NP> __device__ __forceinline__ void qkt_pipe(f32x16& p0, f32x16& p1, const f32x16& cinit, const int (&an)[8], const int (&ar)[4], const bf16x8* qr) {
  bf16x8 ka[4], kb[4];
#define KRD(d0) do { constexpr int s_ = (d0) & 3; \
    if constexpr ((d0) < 8) { ka[s_] = lds_rd128<0>(an[(d0) & 7]); kb[s_] = lds_rd128<8192>(an[(d0) & 7]); } \
    else { ka[s_] = lds_rd128<16384>(ar[(d0) & 3]); kb[s_] = lds_rd128<16384 + 4096>(ar[(d0) & 3]); } } while (0)
#define KMM(d0) do { constexpr int s_ = (d0) & 3; constexpr int left_ = (NP - 1 - (d0)) < 2 ? (NP - 1 - (d0)) : 2; \
    if constexpr (left_ == 2) asm volatile("s_waitcnt lgkmcnt(4)" : "+v"(ka[s_]), "+v"(kb[s_])); else if constexpr (left_ == 1) asm volatile("s_waitcnt lgkmcnt(2)" : "+v"(ka[s_]), "+v"(kb[s_])); else asm volatile("s_waitcnt lgkmcnt(0)" : "+v"(ka[s_]), "+v"(kb[s_])); \
    if constexpr ((d0) == 0) { p0 = __builtin_amdgcn_mfma_f32_32x32x16_bf16(ka[s_], qr[d0], cinit, 0, 0, 0); p1 = __builtin_amdgcn_mfma_f32_32x32x16_bf16(kb[s_], qr[d0], cinit, 0, 0, 0); } \
    else { p0 = __builtin_amdgcn_mfma_f32_32x32x16_bf16(ka[s_], qr[d0], p0, 0, 0, 0); p1 = __builtin_amdgcn_mfma_f32_32x32x16_bf16(kb[s_], qr[d0], p1, 0, 0, 0); } \
    if constexpr ((d0) + 3 < NP) KRD((d0) + 3); } while (0)
  KRD(0); KRD(1); KRD(2);
  KMM(0); KMM(1); KMM(2); KMM(3); KMM(4); KMM(5); KMM(6); KMM(7);
  if constexpr (NP > 8) { KMM(8); KMM(9); KMM(10); KMM(11); }
#undef KRD
#undef KMM
}
__device__ __forceinline__ int v_st(int k, int c) { const int kk = (k & ~0xC) | ((k & 4) << 1) | ((k & 8) >> 1); return ((kk >> 3) * 4 + (c >> 5)) * 512 + ((kk & 7) * 32 + (c & 31)) * 2; }
__device__ __forceinline__ int v_rd_base(int lane) { return ((lane & 3) << 3) | (((lane >> 2) & 3) << 6) | (((lane >> 4) & 1) << 5) | (((lane >> 5) & 1) << 8); }
constexpr int v_rd_off(int d0, int ks, int half) { return d0 * 512 + ks * 4096 + half * 2048; }
template <int OFF> __device__ __forceinline__ s16x4 tr_read(int vb) {
  s16x4 r; asm volatile("ds_read_b64_tr_b16 %0, %1 offset:%2" : "=&v"(r) : "v"(vb), "i"(OFF) : "memory"); return r;
}
struct VSet { s16x4 l[4], h[4]; };
template <int KS> __device__ __forceinline__ void v_rd_set(VSet& f, int vb) {
  f.l[0] = tr_read<v_rd_off(0, KS, 0)>(vb); f.h[0] = tr_read<v_rd_off(0, KS, 1)>(vb); f.l[1] = tr_read<v_rd_off(1, KS, 0)>(vb); f.h[1] = tr_read<v_rd_off(1, KS, 1)>(vb);
  f.l[2] = tr_read<v_rd_off(2, KS, 0)>(vb); f.h[2] = tr_read<v_rd_off(2, KS, 1)>(vb); f.l[3] = tr_read<v_rd_off(3, KS, 0)>(vb); f.h[3] = tr_read<v_rd_off(3, KS, 1)>(vb);
}
#define VWAIT(n, f) asm volatile("s_waitcnt lgkmcnt(" #n ")" : "+v"(f.l[0]), "+v"(f.h[0]), "+v"(f.l[1]), "+v"(f.h[1]), "+v"(f.l[2]), "+v"(f.h[2]), "+v"(f.l[3]), "+v"(f.h[3]))
__device__ __forceinline__ void v_mm_set(f32x16* o, const VSet& f, bf16x8 pa) {
#define PK(L, H) (bf16x8){L[0], L[1], L[2], L[3], H[0], H[1], H[2], H[3]}
  o[0] = __builtin_amdgcn_mfma_f32_32x32x16_bf16(PK(f.l[0], f.h[0]), pa, o[0], 0, 0, 0);
  o[1] = __builtin_amdgcn_mfma_f32_32x32x16_bf16(PK(f.l[1], f.h[1]), pa, o[1], 0, 0, 0);
  o[2] = __builtin_amdgcn_mfma_f32_32x32x16_bf16(PK(f.l[2], f.h[2]), pa, o[2], 0, 0, 0);
  o[3] = __builtin_amdgcn_mfma_f32_32x32x16_bf16(PK(f.l[3], f.h[3]), pa, o[3], 0, 0, 0);
#undef PK
}
__device__ __forceinline__ void pv_d0(f32x16* o, int vb, bf16x8 pa0, bf16x8 pa1, bf16x8 pa2, bf16x8 pa3) {
  VSet A, B;
  v_rd_set<0>(A, vb); v_rd_set<1>(B, vb);
  VWAIT(8, A); SBAR(); v_mm_set(o, A, pa0); SBAR(); v_rd_set<2>(A, vb);
  VWAIT(8, B); SBAR(); v_mm_set(o, B, pa1); SBAR(); v_rd_set<3>(B, vb);
  VWAIT(8, A); SBAR(); v_mm_set(o, A, pa2); SBAR();
  VWAIT(0, B); SBAR(); v_mm_set(o, B, pa3);
}
#undef VWAIT
__device__ __forceinline__ void na_bias(f32x16& p0, f32x16& p1, const LAS float* bl, int kc_lo, bool inwin) {
#pragma unroll
  for (int r = 0; r < 16; ++r) { const int k0 = (r & 3) + 8 * (r >> 2);
    const bool v0 = inwin && ((unsigned)(k0 + kc_lo) < 16u), v1 = inwin && ((unsigned)(k0 + 32 + kc_lo) < 16u);
    const float b0 = bl[k0], b1 = bl[k0 + 32];
    p0[r] = v0 ? p0[r] + b0 : -INFINITY; p1[r] = v1 ? p1[r] + b1 : -INFINITY; }
}

struct AttnArgs {
  const bf16_t* Qn; const bf16_t* Qr;
  const bf16_t* Kn; const bf16_t* Kr; const bf16_t* Vh;
  bf16_t* Ob; float* ssq;
  int NT;
  int rq0, krow0; const float* rpb;
};

template <int MODE> __device__ __forceinline__ void attn_unit(const AttnArgs& a, LAS char* lds, int wid_) {
  int wid = wid_; asm volatile("" : "+s"(wid));
  constexpr int LDQ = MODE ? NPROJ : 1536, LDK = MODE ? NPROJ : 2048, LDKR = NPROJ, NQ = MODE ? 8 : 12, ND = MODE ? 4 : 5;
  constexpr int KSLOT = AttL<MODE>::KSLOT, OFF_K = AttL<MODE>::OFF_K, OFF_V = AttL<MODE>::OFF_V, OFF_WS = AttL<MODE>::OFF_WS, OFF_BIAS = AttL<MODE>::OFF_BIAS;
  const int lane = lane_id(a.NT + a.rq0), tid = wid * 64 + lane, r32 = lane & 31, hi = lane >> 5;
  LAS char* V_lds = lds + OFF_V; LAS char* K_lds = lds + OFF_K;

  LAS float* bias_l = (LAS float*)(lds + OFF_BIAS) + 128;
  f32x16 o[4] = {}; f32x16 negm = {}; bool valid = false; float l_reg = 0.f; bf16x8 qr[NQ];
  {
    const bf16_t* Qw = a.Qn + (size_t)(wid * QBLK + r32) * LDQ + hi * 8;
#pragma unroll
    for (int d0 = 0; d0 < 8; ++d0) qr[d0] = *(const GAS bf16x8*)(Qw + d0 * 16);
    if constexpr (MODE == 0) { const bf16_t* Qx = a.Qr + (size_t)(wid * QBLK + r32) * LDQ + hi * 8;
#pragma unroll
      for (int d0 = 0; d0 < 4; ++d0) qr[8 + d0] = *(const GAS bf16x8*)(Qx + d0 * 16); }
  }
  int rq = 0, rs = 0, kc_lo = 0, blane = 0;
  if constexpr (MODE == 1) {
    for (int i = tid; i < 15 * 32; i += NW * 64) { const int dr = i >> 5, dc = i & 31; bias_l[i] = dc < 31 ? ((const GAS float*)a.rpb)[dr * 31 + dc] * LOG2E : 0.f; }
    rq = a.rq0 + (wid >> 1); rs = rq - 4; rs = rs < 0 ? 0 : (rs > 120 ? 120 : rs);
    const int c = (wid & 1) * 32 + r32; int cs = c - 8; cs = cs < 0 ? 0 : (cs > 48 ? 48 : cs);
    kc_lo = 4 * hi - cs; blane = 4 * hi - c + 15;
  }
  unsigned kof[2], vof[2], krof = 0;
#pragma unroll
  for (int e = 0; e < 2; ++e) { const int q = 2 * wid + e;
    { const int row = 4 * q + (lane >> 4), ch = (lane & 15) ^ (row & 15); kof[e] = (unsigned)(row * LDK + ch * 8); }
    { const int sub = lane >> 5, kk = (q >> 1) * 8 + ((lane >> 2) & 7), k = kk, c = ((q & 1) * 2 + sub) * 32 + (lane & 3) * 8; vof[e] = (unsigned)(k * LDK + c); } }
  if constexpr (MODE == 0) { const int row = 8 * wid + (lane >> 3), ch = (lane & 7) ^ ((row >> 1) & 7); krof = (unsigned)(row * LDKR + ch * 8); }
  const int NT = a.NT;
#define GLDS(src, dst) __builtin_amdgcn_global_load_lds((const unsigned*)(src), (LAS unsigned*)(dst), 16, 0, 0)
#define DMA_K(t, slot) do { const int t_ = (t) < NT ? (t) : NT - 1; const bf16_t* kb_ = a.Kn + (size_t)t_ * KVBLK * LDK; LAS char* kd_ = K_lds + (slot) * KSLOT + wid * 2048; \
    GLDS(kb_ + kof[0], kd_); GLDS(kb_ + kof[1], kd_ + 1024); \
    if constexpr (MODE == 0) GLDS(a.Kr + (size_t)t_ * KVBLK * LDKR + krof, K_lds + (slot) * KSLOT + 16384 + wid * 1024); } while (0)
#define DMA_V(t, slot) do { const int t_ = (t) < NT ? (t) : NT - 1; const bf16_t* vb_ = a.Vh + (size_t)t_ * KVBLK * LDK; LAS char* vd_ = V_lds + (slot) * SHM_V + wid * 2048; \
    GLDS(vb_ + vof[0], vd_); GLDS(vb_ + vof[1], vd_ + 1024); } while (0)
#define WAITBAR() do { if constexpr (MODE == 0) asm volatile("s_waitcnt vmcnt(5) lgkmcnt(0)\n\ts_barrier" ::: "memory"); else asm volatile("s_waitcnt vmcnt(4) lgkmcnt(0)\n\ts_barrier" ::: "memory"); } while (0)
  const int vb0 = (int)(unsigned)(uintptr_t)V_lds + v_rd_base(lane);
  const int kl0 = (int)(unsigned)(uintptr_t)K_lds, kxn = ((r32 & 15) << 4) ^ (hi << 4), kxr = (((r32 >> 1) & 7) << 4) ^ (hi << 4);
#define RESC(al) do { if (__any((al) < 1.f)) { _Pragma("unroll") for (int d = 0; d < 4; ++d) _Pragma("unroll") for (int r = 0; r < 16; ++r) o[d][r] *= (al); } } while (0)
#define INW(t) (MODE == 0 || ((a.krow0 + (t)) >= rs && (a.krow0 + (t)) < rs + 8))
#define QK(slot, t) do { if (INW(t)) { int an_[8], ar_[4]; const int sb_ = kl0 + (slot) * KSLOT; \
      _Pragma("unroll") for (int q_ = 0; q_ < 4; ++q_) { an_[q_] = sb_ + r32 * 256 + ((q_ << 5) ^ kxn); an_[4 + q_] = an_[q_] ^ 128; ar_[q_] = sb_ + r32 * 128 + ((q_ << 5) ^ kxr); } \
      qkt_pipe<NQ>(P0, P1, negm, an_, ar_, qr); \
      if constexpr (MODE == 1) { int dr_ = a.krow0 + (t) - rq + 7; dr_ = dr_ < 0 ? 0 : (dr_ > 14 ? 14 : dr_); na_bias(P0, P1, bias_l + dr_ * 32 + blane, kc_lo, true); } } \
    else { _Pragma("unroll") for (int r_ = 0; r_ < 16; ++r_) { P0[r_] = -INFINITY; P1[r_] = -INFINITY; } } } while (0)
#define SMX() do { float al_; softmax_ref(P0, P1, negm, valid, al_, pa0, pa1, pa2, pa3, l_reg); RESC(al_); } while (0)
#define PV(slot, t) do { if (INW(t)) pv_d0(o, vb0 + (slot) * SHM_V, pa0, pa1, pa2, pa3); } while (0)
  f32x16 P0, P1; bf16x8 pa0, pa1, pa2, pa3;
  const bool late = X_LATE == 1 ? (wid >= 4) : (X_LATE == 2 ? ((wid & 1) != 0) : false);
  if (X_PRIO47 && wid >= 4) __builtin_amdgcn_s_setprio(1);
  int ks = 0, vs = 0;
  DMA_K(0, 0); DMA_V(0, 0); DMA_K(1, 1); DMA_V(1, 1);
#define STEP_HEAD(j) WAITBAR(); DMA_K((j) + 2, ks == 0 ? 2 : ks - 1); DMA_V((j) + 2, (vs + 2) & 3)
#define STEP_TAIL() ks = (ks == 2) ? 0 : ks + 1; vs = (vs + 1) & 3
  if (!late) {
    for (int j = 0; j < NT; ++j) { STEP_HEAD(j); QK(ks, j); if (INW(j)) { SMX(); } PV(vs, j); STEP_TAIL(); }
  } else {
    STEP_HEAD(0); QK(ks, 0); STEP_TAIL();
    for (int j = 1; j < NT; ++j) { STEP_HEAD(j); SMX(); PV((vs + 3) & 3, j - 1); QK(ks, j); STEP_TAIL(); }
    SMX(); PV((vs + 3) & 3, NT - 1);
  }
#undef STEP_HEAD
#undef STEP_TAIL
  if (X_PRIO47) __builtin_amdgcn_s_setprio(0);
  asm volatile("s_waitcnt vmcnt(0)" ::: "memory");
  float rl; { auto rr = __builtin_amdgcn_permlane32_swap(__float_as_uint(l_reg), __float_as_uint(l_reg), false, false); rl = __builtin_amdgcn_rcpf(__uint_as_float(rr[0]) + __uint_as_float(rr[1])); }
  __syncthreads();
  LAS char* stg = lds + wid * OSTG_WAVE;
#pragma unroll
  for (int d0 = 0; d0 < 4; ++d0)
#pragma unroll
    for (int g = 0; g < 4; ++g) { u32x2 w; w.x = cvt_pk_bf16(o[d0][4 * g] * rl, o[d0][4 * g + 1] * rl); w.y = cvt_pk_bf16(o[d0][4 * g + 2] * rl, o[d0][4 * g + 3] * rl);
      *(LAS u32x2*)(stg + r32 * OSTG_PITCH + (d0 * 32 + 8 * g + 4 * hi) * 2) = w; }
  asm volatile("s_waitcnt lgkmcnt(0)" ::: "memory");
#pragma unroll
  for (int i = 0; i < 8; ++i) { const int row = i * 4 + (lane >> 4), ch = lane & 15;
    const u32x4 v = *(const LAS u32x4*)(stg + row * OSTG_PITCH + ch * 16);
    *(GAS u32x4*)(a.Ob + (size_t)(wid * QBLK + row) * DM + ch * 8) = v;
    float q = (bf_lo(v.x) * bf_lo(v.x) + bf_hi(v.x) * bf_hi(v.x)) + (bf_lo(v.y) * bf_lo(v.y) + bf_hi(v.y) * bf_hi(v.y)) + (bf_lo(v.z) * bf_lo(v.z) + bf_hi(v.z) * bf_hi(v.z)) + (bf_lo(v.w) * bf_lo(v.w) + bf_hi(v.w) * bf_hi(v.w));
    q += shx(q, 1, lane); q += shx(q, 2, lane); q += shx(q, 4, lane); q += shx(q, 8, lane);
    if (ch == 0) ((GAS float*)a.ssq)[(size_t)(wid * QBLK + row) * 16] = q; }
  asm volatile("s_waitcnt lgkmcnt(0)" ::: "memory");
  __syncthreads();
#undef GLDS
#undef SMX
#undef DMA_K
#undef DMA_V
#undef WAITBAR
#undef RESC
#undef INW
#undef QK
#undef PV
}
#undef KSWZ
#undef KRSWZ
#undef SBAR
}
namespace att {
#define SBAR() __builtin_amdgcn_sched_barrier(0)
template <int N> __device__ __forceinline__ void lgk_wait_tied(bf16x8& f) { asm volatile("s_waitcnt lgkmcnt(%1)" : "+v"(f) : "n"(N)); }
struct VSet16 { s16x4 l[4], h[4]; };
template <int N> struct IC16 { static constexpr int value = N; };
__device__ __forceinline__ float vmax3gu(float a, float b, float c, unsigned after) { float r; asm("v_max3_f32 %0, %1, %2, %3" : "=v"(r) : "v"(a), "v"(b), "v"(c), "v"(after)); return r; }

template <int MODE, int PARW> __device__ __forceinline__ void attn_unit16(const AttnArgs& a, LAS char* lds, int wid_) {
  int wid = wid_; asm volatile("" : "+s"(wid));
  constexpr int LDQ = MODE ? NPROJ : 1536, LDK = MODE ? NPROJ : 2048, LDKR = NPROJ, NDC = MODE ? 4 : 6, NI = 4 * NDC;
  constexpr int KSLOT = AttL<MODE>::KSLOT, OFF_K = AttL<MODE>::OFF_K, OFF_V = AttL<MODE>::OFF_V, OFF_BIAS = AttL<MODE>::OFF_BIAS;
  const int lane = lane_id(a.NT + a.rq0), tid = wid * 64 + lane, c16 = lane & 15, g = lane >> 4;
  LAS char* V_lds = lds + OFF_V; LAS char* K_lds = lds + OFF_K;
  LAS float* bias_l = (LAS float*)(lds + OFF_BIAS) + 128;
  f32x4 o[8][2]; f32x4 cinit[2]; bool valid0 = false, valid1 = false; float l0 = 0.f, l1 = 0.f; bf16x8 qf[2][NDC];
#pragma unroll
  for (int db = 0; db < 8; ++db) { o[db][0] = (f32x4){0.f, 0.f, 0.f, 0.f}; o[db][1] = (f32x4){0.f, 0.f, 0.f, 0.f}; }
  cinit[0] = (f32x4){0.f, 0.f, 0.f, 0.f}; cinit[1] = (f32x4){0.f, 0.f, 0.f, 0.f};
#pragma unroll
  for (int qb = 0; qb < 2; ++qb) {
    const bf16_t* Qw = a.Qn + (size_t)(wid * QBLK + 16 * qb + c16) * LDQ + g * 8;
#pragma unroll
    for (int dc = 0; dc < 4; ++dc) qf[qb][dc] = *(const GAS bf16x8*)(Qw + dc * 32);
    if constexpr (MODE == 0) { const bf16_t* Qx = a.Qr + (size_t)(wid * QBLK + 16 * qb + c16) * LDQ + g * 8;
#pragma unroll
      for (int dc = 0; dc < 2; ++dc) qf[qb][4 + dc] = *(const GAS bf16x8*)(Qx + dc * 32); }
  }
  int rq = 0, rs = 0, klo0 = 0, klo1 = 0, bof0 = 0, bof1 = 0;
  if constexpr (MODE == 1) {
    for (int i = tid; i < 15 * 32; i += NW * 64) { const int dr = i >> 5, dc = i & 31; bias_l[i] = dc < 31 ? ((const GAS float*)a.rpb)[dr * 31 + dc] * LOG2E : 0.f; }
    rq = a.rq0 + (wid >> 1); rs = rq - 4; rs = rs < 0 ? 0 : (rs > 120 ? 120 : rs);
    const int c0 = (wid & 1) * 32 + c16, c1 = c0 + 16; int cs0 = c0 - 8, cs1 = c1 - 8; cs0 = cs0 < 0 ? 0 : (cs0 > 48 ? 48 : cs0); cs1 = cs1 < 0 ? 0 : (cs1 > 48 ? 48 : cs1);
    klo0 = 4 * g - cs0; klo1 = 4 * g - cs1; bof0 = 4 * g - c0 + 15; bof1 = 4 * g - c1 + 15;
  }
  unsigned kof[2], vof[2], krof = 0;
#pragma unroll
  for (int e = 0; e < 2; ++e) { const int q = 2 * wid + e, row = 4 * q + (lane >> 4);
    { const int ch = (lane & 15) ^ (row & 15); kof[e] = (unsigned)(row * LDK + ch * 8); }
    { const int ch = (lane & 15) ^ (2 * (row & 7)); vof[e] = (unsigned)(row * LDK + ch * 8); } }
  if constexpr (MODE == 0) { const int row = 8 * wid + (lane >> 3), ch = (lane & 7) ^ ((row >> 1) & 7); krof = (unsigned)(row * LDKR + ch * 8); }
  const int NT = a.NT;
#define GLDS(src, dst) __builtin_amdgcn_global_load_lds((const unsigned*)(src), (LAS unsigned*)(dst), 16, 0, 0)
#define DMA_K(t, slot) do { const int t_ = (t) < NT ? (t) : NT - 1; const bf16_t* kb_ = a.Kn + (size_t)t_ * KVBLK * LDK; LAS char* kd_ = K_lds + (slot) * KSLOT + wid * 2048; \
    GLDS(kb_ + kof[0], kd_); GLDS(kb_ + kof[1], kd_ + 1024); \
    if constexpr (MODE == 0) GLDS(a.Kr + (size_t)t_ * KVBLK * LDKR + krof, K_lds + (slot) * KSLOT + 16384 + wid * 1024); } while (0)
#define DMA_V(t, slot) do { const int t_ = (t) < NT ? (t) : NT - 1; const bf16_t* vb_ = a.Vh + (size_t)t_ * KVBLK * LDK; LAS char* vd_ = V_lds + (slot) * SHM_V + wid * 2048; \
    GLDS(vb_ + vof[0], vd_); GLDS(vb_ + vof[1], vd_ + 1024); } while (0)
#define WAITBAR() do { if constexpr (MODE == 0) asm volatile("s_waitcnt vmcnt(5) lgkmcnt(0)\n\ts_barrier" ::: "memory"); else asm volatile("s_waitcnt vmcnt(4) lgkmcnt(0)\n\ts_barrier" ::: "memory"); } while (0)
#define INW(t) (MODE == 0 || ((a.krow0 + (t)) >= rs && (a.krow0 + (t)) < rs + 8))
  const int kl0 = (int)(unsigned)(uintptr_t)K_lds;
  const int vX = ((c16 >> 1) & 1) ^ (8 * (g & 1) + 2 * (c16 >> 2));
  const int vb0 = (int)(unsigned)(uintptr_t)V_lds + 256 * (4 * g + (c16 >> 2)) + 16 * vX + 8 * (c16 & 1);
  int ks = 0, vs = 0;
  if (X_PRIO47 && wid >= 4) __builtin_amdgcn_s_setprio(1);
  DMA_K(0, 0); DMA_V(0, 0); DMA_K(1, 1); DMA_V(1, 1);
#define STEP_HEAD(j) WAITBAR(); DMA_K((j) + 2, ks == 0 ? 2 : ks - 1); DMA_V((j) + 2, (vs + 2) & 3)
#define STEP_TAIL() ks = (ks == 2) ? 0 : ks + 1; vs = (vs + 1) & 3
  auto step = [&](auto par_, const int j) __attribute__((always_inline)) {
      constexpr int PAR = decltype(par_)::value;
#define LIVE(kb, qb) (PAR < 0 || (PAR == 0 ? !(((qb) == 0 && (kb) >= 2) || ((qb) == 1 && (kb) == 3)) : !(((qb) == 0 && (kb) == 0) || ((qb) == 1 && (kb) <= 1))))
#define CLIVE(c, qb) (LIVE(2 * (c), qb) || LIVE(2 * (c) + 1, qb))
      f32x4 S[4][2];
      { const int sb_ = kl0 + ks * KSLOT;
        int an_[4], ar_[2];
#pragma unroll
        for (int dc = 0; dc < 4; ++dc) an_[dc] = sb_ + c16 * 256 + (((4 * dc + g) ^ c16) << 4);
#pragma unroll
        for (int dc = 0; dc < 2; ++dc) ar_[dc] = sb_ + 16384 + c16 * 128 + (((4 * dc + g) ^ ((c16 >> 1) & 7)) << 4);
        (void)ar_;
        bf16x8 kf[8];
#define KRD16(idx) do { constexpr int dc_ = (idx) >> 2, kb_ = (idx) & 3; \
          if constexpr (dc_ < 4) kf[(idx) & 7] = lds_rd128<kb_ * 4096>(an_[dc_ & 3]); else kf[(idx) & 7] = lds_rd128<kb_ * 2048>(ar_[dc_ & 1]); } while (0)
#define KMM16(idx) do { constexpr int dc_ = (idx) >> 2, kb_ = (idx) & 3; constexpr int left_ = (NI - 1 - (idx)) < 7 ? (NI - 1 - (idx)) : 7; \
          lgk_wait_tied<left_>(kf[(idx) & 7]); \
          if constexpr (dc_ == 0) { if constexpr (LIVE(kb_, 0)) S[kb_][0] = __builtin_amdgcn_mfma_f32_16x16x32_bf16(kf[(idx) & 7], qf[0][0], cinit[0], 0, 0, 0); \
                                    if constexpr (LIVE(kb_, 1)) S[kb_][1] = __builtin_amdgcn_mfma_f32_16x16x32_bf16(kf[(idx) & 7], qf[1][0], cinit[1], 0, 0, 0); } \
          else { if constexpr (LIVE(kb_, 0)) S[kb_][0] = __builtin_amdgcn_mfma_f32_16x16x32_bf16(kf[(idx) & 7], qf[0][dc_], S[kb_][0], 0, 0, 0); \
                 if constexpr (LIVE(kb_, 1)) S[kb_][1] = __builtin_amdgcn_mfma_f32_16x16x32_bf16(kf[(idx) & 7], qf[1][dc_], S[kb_][1], 0, 0, 0); } \
          if constexpr ((idx) + 8 < NI) KRD16((idx) + 8); } while (0)
        KRD16(0); KRD16(1); KRD16(2); KRD16(3); KRD16(4); KRD16(5); KRD16(6); KRD16(7);
        KMM16(0); KMM16(1); KMM16(2); KMM16(3); KMM16(4); KMM16(5); KMM16(6); KMM16(7);
        KMM16(8); KMM16(9); KMM16(10); KMM16(11); KMM16(12); KMM16(13); KMM16(14); KMM16(15);
        if constexpr (NDC > 4) { KMM16(16); KMM16(17); KMM16(18); KMM16(19); KMM16(20); KMM16(21); KMM16(22); KMM16(23); }
#undef KRD16
#undef KMM16
      }
      float pm0, pm1;
      if constexpr (MODE == 1) {
        int dr_ = a.krow0 + j - rq + 7; dr_ = dr_ < 0 ? 0 : (dr_ > 14 ? 14 : dr_);
        const LAS float* bl0 = bias_l + dr_ * 32 + bof0; const LAS float* bl1 = bias_l + dr_ * 32 + bof1;
        pm0 = -INFINITY; pm1 = -INFINITY;
#pragma unroll
        for (int kb = 0; kb < 4; ++kb) {
          if (LIVE(kb, 0)) {
#pragma unroll
            for (int i = 0; i < 4; ++i) { const int k0 = 16 * kb + i; const float b0 = bl0[k0]; const bool v0 = (unsigned)(k0 + klo0) < 16u; S[kb][0][i] = v0 ? S[kb][0][i] + b0 : -INFINITY; }
            pm0 = vmax3(pm0, S[kb][0][0], S[kb][0][1]); pm0 = vmax3(pm0, S[kb][0][2], S[kb][0][3]); }
          if (LIVE(kb, 1)) {
#pragma unroll
            for (int i = 0; i < 4; ++i) { const int k0 = 16 * kb + i; const float b1 = bl1[k0]; const bool v1 = (unsigned)(k0 + klo1) < 16u; S[kb][1][i] = v1 ? S[kb][1][i] + b1 : -INFINITY; }
            pm1 = vmax3(pm1, S[kb][1][0], S[kb][1][1]); pm1 = vmax3(pm1, S[kb][1][2], S[kb][1][3]); }
        }
      } else {
      {
        const unsigned gd = (__float_as_uint(S[0][0][3]) | __float_as_uint(S[1][0][3]) | __float_as_uint(S[2][0][3])) | (__float_as_uint(S[3][0][3]) | __float_as_uint(S[0][1][3]) | __float_as_uint(S[1][1][3])) | (__float_as_uint(S[2][1][3]) | __float_as_uint(S[3][1][3]));
        float a0 = vmax3gu(S[0][0][0], S[0][0][1], S[0][0][2], gd), b0 = vmax3gu(S[2][0][0], S[2][0][1], S[2][0][2], gd), a1 = vmax3gu(S[0][1][0], S[0][1][1], S[0][1][2], gd), b1 = vmax3gu(S[2][1][0], S[2][1][1], S[2][1][2], gd);
        a0 = vmax3(a0, S[0][0][3], S[1][0][0]); b0 = vmax3(b0, S[2][0][3], S[3][0][0]); a1 = vmax3(a1, S[0][1][3], S[1][1][0]); b1 = vmax3(b1, S[2][1][3], S[3][1][0]);
        a0 = vmax3(a0, S[1][0][1], S[1][0][2]); b0 = vmax3(b0, S[3][0][1], S[3][0][2]); a1 = vmax3(a1, S[1][1][1], S[1][1][2]); b1 = vmax3(b1, S[3][1][1], S[3][1][2]);
        a0 = vmax3(a0, b0, S[1][0][3]); a1 = vmax3(a1, b1, S[1][1][3]);
        pm0 = vmax2(a0, S[3][0][3]); pm1 = vmax2(a1, S[3][1][3]); }
      }
      { auto r0 = __builtin_amdgcn_permlane16_swap(__float_as_uint(pm0), __float_as_uint(pm0), false, false); pm0 = vmax2(__uint_as_float(r0[0]), __uint_as_float(r0[1]));
        auto r1 = __builtin_amdgcn_permlane16_swap(__float_as_uint(pm1), __float_as_uint(pm1), false, false); pm1 = vmax2(__uint_as_float(r1[0]), __uint_as_float(r1[1]));
        auto s0 = __builtin_amdgcn_permlane32_swap(__float_as_uint(pm0), __float_as_uint(pm0), false, false); pm0 = vmax2(__uint_as_float(s0[0]), __uint_as_float(s0[1]));
        auto s1 = __builtin_amdgcn_permlane32_swap(__float_as_uint(pm1), __float_as_uint(pm1), false, false); pm1 = vmax2(__uint_as_float(s1[0]), __uint_as_float(s1[1])); }
      if (!__builtin_expect(__all(valid0 && valid1 && pm0 <= THR2 && pm1 <= THR2), 1)) {
        { const bool fin = pm0 > -INFINITY; const float d = valid0 ? fmaxf(pm0, 0.f) : (fin ? pm0 : 0.f); const float al = valid0 ? __builtin_amdgcn_exp2f(-d) : 1.f; valid0 = valid0 || fin;
#pragma unroll
          for (int kb = 0; kb < 4; ++kb) if (LIVE(kb, 0)) S[kb][0] -= d;
          cinit[0] -= d; l0 *= al;
          if (__any(al < 1.f)) {
#pragma unroll
            for (int db = 0; db < 8; ++db) o[db][0] *= al; } }
        { const bool fin = pm1 > -INFINITY; const float d = valid1 ? fmaxf(pm1, 0.f) : (fin ? pm1 : 0.f); const float al = valid1 ? __builtin_amdgcn_exp2f(-d) : 1.f; valid1 = valid1 || fin;
#pragma unroll
          for (int kb = 0; kb < 4; ++kb) if (LIVE(kb, 1)) S[kb][1] -= d;
          cinit[1] -= d; l1 *= al;
          if (__any(al < 1.f)) {
#pragma unroll
            for (int db = 0; db < 8; ++db) o[db][1] *= al; } }
      }
#pragma unroll
      for (int kb = 0; kb < 4; ++kb)
#pragma unroll
        for (int qb = 0; qb < 2; ++qb)
          if (LIVE(kb, qb)) {
#pragma unroll
            for (int i = 0; i < 4; ++i) S[kb][qb][i] = __builtin_amdgcn_exp2f(S[kb][qb][i]); }
      bf16x8 pa[2][2];
      const f32x4 zero4 = {0.f, 0.f, 0.f, 0.f};
#pragma unroll
      for (int qb = 0; qb < 2; ++qb)
#pragma unroll
        for (int c = 0; c < 2; ++c) if (CLIVE(c, qb)) { const u32x4 w = pack8(LIVE(2 * c, qb) ? S[2 * c][qb] : zero4, LIVE(2 * c + 1, qb) ? S[2 * c + 1][qb] : zero4); pa[qb][c] = *reinterpret_cast<const bf16x8*>(&w); }
      { f32x4 t0 = zero4, t1 = zero4;
        if constexpr (PAR < 0) { t0 = (S[0][0] + S[1][0]) + (S[2][0] + S[3][0]); t1 = (S[0][1] + S[1][1]) + (S[2][1] + S[3][1]); }
        else {
#pragma unroll
          for (int kb = 0; kb < 4; ++kb) { if (LIVE(kb, 0)) t0 += S[kb][0]; if (LIVE(kb, 1)) t1 += S[kb][1]; } }
        l0 += (t0[0] + t0[1]) + (t0[2] + t0[3]); l1 += (t1[0] + t1[1]) + (t1[2] + t1[3]); }
      { const int vb = vb0 + vs * SHM_V;
        int va[8];
#pragma unroll
        for (int db = 0; db < 8; ++db) va[db] = vb ^ (32 * db);
        VSet16 A, B;
#define VRD16(f, c_, dbh_) do { _Pragma("unroll") for (int n_ = 0; n_ < 4; ++n_) { f.l[n_] = tr_read<(c_) * 8192>(va[4 * (dbh_) + n_]); f.h[n_] = tr_read<(c_) * 8192 + 4096>(va[4 * (dbh_) + n_]); } } while (0)
#define VWAIT16(n, f) asm volatile("s_waitcnt lgkmcnt(" #n ")" : "+v"(f.l[0]), "+v"(f.h[0]), "+v"(f.l[1]), "+v"(f.h[1]), "+v"(f.l[2]), "+v"(f.h[2]), "+v"(f.l[3]), "+v"(f.h[3]))
#define PKV(L, H) (bf16x8){L[0], L[1], L[2], L[3], H[0], H[1], H[2], H[3]}
#define VMM16(f, c_, dbh_) do { _Pragma("unroll") for (int n_ = 0; n_ < 4; ++n_) { const bf16x8 vf_ = PKV(f.l[n_], f.h[n_]); \
            if constexpr (CLIVE(c_, 0)) o[4 * (dbh_) + n_][0] = __builtin_amdgcn_mfma_f32_16x16x32_bf16(vf_, pa[0][c_], o[4 * (dbh_) + n_][0], 0, 0, 0); \
            if constexpr (CLIVE(c_, 1)) o[4 * (dbh_) + n_][1] = __builtin_amdgcn_mfma_f32_16x16x32_bf16(vf_, pa[1][c_], o[4 * (dbh_) + n_][1], 0, 0, 0); } } while (0)
        VRD16(A, 0, 0); VRD16(B, 0, 1);
        VWAIT16(8, A); SBAR(); VMM16(A, 0, 0); SBAR(); VRD16(A, 1, 0);
        VWAIT16(8, B); SBAR(); VMM16(B, 0, 1); SBAR(); VRD16(B, 1, 1);
        VWAIT16(8, A); SBAR(); VMM16(A, 1, 0); SBAR();
        VWAIT16(0, B); SBAR(); VMM16(B, 1, 1);
#undef VRD16
#undef VWAIT16
#undef VMM16
#undef PKV
      }
#undef LIVE
#undef CLIVE
  };
  for (int j = 0; j < NT; ++j) { STEP_HEAD(j); if (INW(j)) step(IC16<PARW>{}, j); STEP_TAIL(); }
#undef STEP_HEAD
#undef STEP_TAIL
  if (X_PRIO47) __builtin_amdgcn_s_setprio(0);
  asm volatile("s_waitcnt vmcnt(0)" ::: "memory");
  float rl0, rl1;
  { auto r0 = __builtin_amdgcn_permlane16_swap(__float_as_uint(l0), __float_as_uint(l0), false, false); l0 = __uint_as_float(r0[0]) + __uint_as_float(r0[1]);
    auto r1 = __builtin_amdgcn_permlane16_swap(__float_as_uint(l1), __float_as_uint(l1), false, false); l1 = __uint_as_float(r1[0]) + __uint_as_float(r1[1]);
    auto s0 = __builtin_amdgcn_permlane32_swap(__float_as_uint(l0), __float_as_uint(l0), false, false); rl0 = __builtin_amdgcn_rcpf(__uint_as_float(s0[0]) + __uint_as_float(s0[1]));
    auto s1 = __builtin_amdgcn_permlane32_swap(__float_as_uint(l1), __float_as_uint(l1), false, false); rl1 = __builtin_amdgcn_rcpf(__uint_as_float(s1[0]) + __uint_as_float(s1[1])); }
  __syncthreads();
  LAS char* stg = lds + wid * OSTG_WAVE;
#pragma unroll
  for (int db = 0; db < 8; ++db) {
    { u32x2 w; w.x = cvt_pk_bf16(o[db][0][0] * rl0, o[db][0][1] * rl0); w.y = cvt_pk_bf16(o[db][0][2] * rl0, o[db][0][3] * rl0); *(LAS u32x2*)(stg + c16 * OSTG_PITCH + (16 * db + 4 * g) * 2) = w; }
    { u32x2 w; w.x = cvt_pk_bf16(o[db][1][0] * rl1, o[db][1][1] * rl1); w.y = cvt_pk_bf16(o[db][1][2] * rl1, o[db][1][3] * rl1); *(LAS u32x2*)(stg + (16 + c16) * OSTG_PITCH + (16 * db + 4 * g) * 2) = w; }
  }
  asm volatile("s_waitcnt lgkmcnt(0)" ::: "memory");
#pragma unroll
  for (int i = 0; i < 8; ++i) { const int row = i * 4 + (lane >> 4), ch = lane & 15;
    const u32x4 v = *(const LAS u32x4*)(stg + row * OSTG_PITCH + ch * 16);
    *(GAS u32x4*)(a.Ob + (size_t)(wid * QBLK + row) * DM + ch * 8) = v;
    float q = (bf_lo(v.x) * bf_lo(v.x) + bf_hi(v.x) * bf_hi(v.x)) + (bf_lo(v.y) * bf_lo(v.y) + bf_hi(v.y) * bf_hi(v.y)) + (bf_lo(v.z) * bf_lo(v.z) + bf_hi(v.z) * bf_hi(v.z)) + (bf_lo(v.w) * bf_lo(v.w) + bf_hi(v.w) * bf_hi(v.w));
    q += shx(q, 1, lane); q += shx(q, 2, lane); q += shx(q, 4, lane); q += shx(q, 8, lane);
    if (ch == 0) ((GAS float*)a.ssq)[(size_t)(wid * QBLK + row) * 16] = q; }
  asm volatile("s_waitcnt lgkmcnt(0)" ::: "memory");
  __syncthreads();
#undef GLDS
#undef DMA_K
#undef DMA_V
#undef WAITBAR
#undef INW
}
#undef SBAR
}
#ifndef X_LOCALFINAL
#define X_LOCALFINAL 1
#endif
#ifndef X_EARLYINV
#define X_EARLYINV 1
#endif
#ifndef X_REP0
#define X_REP0 0
#endif
#ifndef X_REPATT
#define X_REPATT 0
#endif
#ifndef X_REPG
#define X_REPG 0
#endif
#ifndef X_DUMMY_K
#define X_DUMMY_K 0
#endif
#ifndef X_DUMMY_NOEPI
#define X_DUMMY_NOEPI 0
#endif
#ifndef X_XCDLOCAL
#define X_XCDLOCAL 1
#endif
#ifndef X_REQUIRE_XMODE
#define X_REQUIRE_XMODE 0
#endif
#ifndef X_ATTLOCAL
#define X_ATTLOCAL 1
#endif
#ifndef X_BM128
#define X_BM128 1
#endif
#ifndef X_REPMASK
#define X_REPMASK 0
#endif
#define XREP(k) ((((X_REPMASK) >> (k)) & 1) ? 2 : 1)
namespace fk {
constexpr int NWAVES = 8;
constexpr size_t MiB = 1u << 20;
constexpr size_t WS_CTL = 0, CTL_ZERO_BYTES = 64 * 1024;
constexpr size_t WS_SSQX = 1 * MiB;
constexpr size_t WS_SSQC = 2 * MiB;
constexpr size_t WS_SSQY = 2 * MiB + 512 * 1024;
constexpr size_t WS_CTAB = 3 * MiB, WS_STAB = 4 * MiB;
constexpr size_t WS_W = 8 * MiB, W_LAYER = 101 * MiB;
constexpr size_t WL_IN = 0, WL_UQ = 16 * MiB, WL_UKV = 17 * MiB + 512 * 1024, WL_OUT = 18 * MiB + 512 * 1024, WL_QK = 26 * MiB + 512 * 1024, WL_VO = 30 * MiB + 512 * 1024,
                 WL_GU = 34 * MiB + 512 * 1024, WL_DN = 78 * MiB + 512 * 1024;
constexpr size_t WS_XB = 412 * MiB;
constexpr size_t WS_PROJ = 444 * MiB;
constexpr size_t WS_QM = 508 * MiB;
constexpr size_t WS_KNVM = 532 * MiB;
constexpr size_t WS_Y = 564 * MiB;
constexpr size_t WS_P = 596 * MiB;
constexpr size_t WS_TMP = 612 * MiB, T_LAYER = 35 * MiB;
constexpr size_t TL_XQ = 0, TL_XKV = 8 * MiB, TL_XO = 24 * MiB, TL_MEMN = 32 * MiB, TL_KVMEM = 33 * MiB;
constexpr size_t WS_H = 612 * MiB;
constexpr size_t WS_END = 752 * MiB;
static_assert(WS_W + 4 * W_LAYER <= WS_XB && WS_TMP + 4 * T_LAYER <= WS_END && WS_H + (size_t)S * DFF * 2 <= WS_END, "d_ws map");
constexpr int CW_BAR = 4096;
constexpr int RING_BYTES = 147456, EX_OFF = RING_BYTES, MISC_OFF = EX_OFF + 8192, LDS_BYTES = 159744;

#define RLX_AGENT __ATOMIC_RELAXED, __HIP_MEMORY_SCOPE_AGENT
#define LDS_WAIT() asm volatile("s_waitcnt lgkmcnt(0)" ::: "memory")
#define XB_TMO      128
#define XB_XCNT(j)  (256  + 64 * (j))
#define XB_XSUB(j)  (1280 + 64 * (j))
#define XB_XGEN(j)  (2304 + 64 * (j))
#define XB_TOP      3328
#define XB_TOPGEN   3392
#define XB_LSUB(j)  (3456 + 64 * (j))
#define XCD_BAR_WORDS 7552
#define XB_SPIN_CAP (1u << 18)
__device__ __forceinline__ unsigned xb_ld(unsigned* p)              { return __hip_atomic_load(p, __ATOMIC_RELAXED, __HIP_MEMORY_SCOPE_AGENT); }
__device__ __forceinline__ unsigned xb_add(unsigned* p, unsigned v) { return __hip_atomic_fetch_add(p, v, __ATOMIC_RELAXED, __HIP_MEMORY_SCOPE_AGENT); }
__device__ __forceinline__ unsigned xb_xcc_id() { return (unsigned)__builtin_amdgcn_s_getreg((3 << 11) | 20) & 0xFu; }
#define XB_SPIN(cond, bar) do { unsigned _sp = 0; while (cond) { __builtin_amdgcn_s_sleep(1); \
    if ((++_sp & 255u) == 0u) { if (xb_ld(&(bar)[XB_TMO])) break; if (_sp > XB_SPIN_CAP) { atomicAdd(&(bar)[XB_TMO], 1u); break; } } } } while (0)
struct XcdBarrier { unsigned* bar; unsigned x; volatile LAS unsigned* st; };
__device__ __forceinline__ XcdBarrier xcd_barrier_post(unsigned* bar, volatile LAS unsigned* st, int wave) {
    XcdBarrier b; b.bar = bar; b.x = xb_xcc_id(); b.st = st;
    if (wave == 0 && lane_id() == 0) st[2] = xb_add(&bar[XB_XCNT(b.x)], 1u);
    return b;
}
__device__ __forceinline__ void xcd_topology(const XcdBarrier& b, int wave) {
    if (wave == 0 && lane_id() == 0) {
        unsigned nx = 0u, ok = 1u, xi = 0u;
#pragma unroll
        for (unsigned j = 0; j < 16; ++j) { const unsigned c = xb_ld(&b.bar[XB_XCNT(j)]); if (c) { ++nx; if (c != 32u) ok = 0u; if (j < b.x) ++xi; } }
        if (nx != 8u || gridDim.x != 256u) ok = 0u;
        b.st[3] = ok; b.st[4] = xi;
    }
    __syncthreads();
}
__device__ __forceinline__ void xcd_local_barrier(const XcdBarrier& b, int wave, int grp) {
    asm volatile("s_waitcnt vmcnt(0)" ::: "memory");
    __syncthreads();
    if (wave == 0 && lane_id() == 0) {
        unsigned* c = &b.bar[XB_LSUB(4 * b.x + grp)];
        const unsigned target = b.st[6] + 8u; b.st[6] = target;
        (void)xb_add(c, 1u);
#if X_EARLYINV
        asm volatile("buffer_inv sc1" ::: "memory");
        XB_SPIN(xb_ld(c) < target, b.bar);
#else
        XB_SPIN(xb_ld(c) < target, b.bar);
        __builtin_amdgcn_fence(__ATOMIC_ACQUIRE, "agent");
#endif
        asm volatile("s_waitcnt vmcnt(0)" ::: "memory");
    }
    __syncthreads();
}
__device__ __forceinline__ void xcd_barrier_complete(unsigned* bar, unsigned x, unsigned& nloc, unsigned& nx) {
    const unsigned G = gridDim.x * gridDim.y * gridDim.z;
    unsigned sum, cnt, mine, sp = 0u;
    for (;;) {
        sum = 0u; cnt = 0u; mine = 0u;
#pragma unroll
        for (unsigned j = 0; j < 16; ++j) { const unsigned c = xb_ld(&bar[XB_XCNT(j)]); sum += c; cnt += (c > 0u) ? 1u : 0u; mine = (j == x) ? c : mine; }
        if (sum == G) break;
        __builtin_amdgcn_s_sleep(1);
        if ((++sp & 255u) == 0u) { if (xb_ld(&bar[XB_TMO])) break; if (sp > XB_SPIN_CAP) { atomicAdd(&bar[XB_TMO], 1u); break; } }
    }
    nloc = mine > 0u ? mine : 1u; nx = cnt > 0u ? cnt : 1u;
}
__device__ __forceinline__ void xcd_barrier(const XcdBarrier& b, int wave) {
    asm volatile("s_waitcnt vmcnt(0)" ::: "memory");
    __syncthreads();
    if (wave == 0 && lane_id() == 0) {
        unsigned* bar = b.bar;
        __builtin_amdgcn_s_waitcnt(0);
        unsigned nloc = b.st[0], nx = b.st[1];
        if (nloc == 0u) { xcd_barrier_complete(bar, b.x, nloc, nx); b.st[0] = nloc; b.st[1] = nx; }
        const unsigned old = xb_add(&bar[XB_XSUB(b.x)], 1u);
        const unsigned gen = old / nloc;
        if (old + 1u == (gen + 1u) * nloc) {
            __builtin_amdgcn_fence(__ATOMIC_RELEASE, "agent");
            asm volatile("s_waitcnt vmcnt(0)" ::: "memory");
            const unsigned og = xb_add(&bar[XB_TOP], 1u);
            const unsigned tg = og / nx;
            if (og + 1u == (tg + 1u) * nx) xb_add(&bar[XB_TOPGEN], 1u);
            else XB_SPIN(xb_ld(&bar[XB_TOPGEN]) == tg, bar);
            __builtin_amdgcn_fence(__ATOMIC_ACQUIRE, "agent");
            xb_add(&bar[XB_XGEN(b.x)], 1u);
            asm volatile("s_waitcnt vmcnt(0)" ::: "memory");
        } else {
            XB_SPIN(xb_ld(&bar[XB_XGEN(b.x)]) == gen, bar);
            __builtin_amdgcn_fence(__ATOMIC_ACQUIRE, "agent");
            asm volatile("s_waitcnt vmcnt(0)" ::: "memory");
        }
    }
    __syncthreads();
}

__device__ __forceinline__ int tr_dloc(int kind, int c) { return kind == 1 ? (2 * (c & 31) + (c >> 5)) : c; }
__device__ __forceinline__ void tr_item64(const float* W, int ldw, int K, bf16_t* WT, int kind, const float* gain, float cscale, LAS unsigned char* scr, int kb, int s0, int dbase, int lane) {
    const int k0 = 64 * kb, nb = lane & 15, kq = lane >> 4;
    f32x4 v[4][4];
#pragma unroll
    for (int i = 0; i < 4; ++i)
#pragma unroll
        for (int j = 0; j < 4; ++j) v[i][j] = __builtin_nontemporal_load((const GAS f32x4*)(W + (size_t)(k0 + 4 * (kq + 4 * i) + j) * ldw + s0 + 4 * nb));
#pragma unroll
    for (int i = 0; i < 4; ++i) {
        const int kk = 4 * (kq + 4 * i);
        f32x4 g = (f32x4){cscale, cscale, cscale, cscale};
        if (gain) g = *(const GAS f32x4*)(gain + k0 + kk) * cscale;
#pragma unroll
        for (int e = 0; e < 4; ++e) {
            u32x2 w; w.x = cvt_pk_bf16(v[i][0][e] * g[0], v[i][1][e] * g[1]); w.y = cvt_pk_bf16(v[i][2][e] * g[2], v[i][3][e] * g[3]);
            *(LAS u32x2*)(scr + tr_dloc(kind, 4 * nb + e) * 144 + kk * 2) = w;
        }
    }
    LDS_WAIT(); asm volatile("" ::: "memory");
#pragma unroll
    for (int i = 0; i < 8; ++i) { const int n = (lane >> 3) + 8 * i, ch = lane & 7;
        const u32x4 o = *(const LAS u32x4*)(scr + n * 144 + ch * 16);
        *(GAS u32x4*)(WT + (size_t)(dbase + n) * K + k0 + 8 * ch) = o; }
    LDS_WAIT(); asm volatile("" ::: "memory");
}
__device__ __forceinline__ float wave_sum(float v, int lane) {
#pragma unroll
    for (int o = 1; o < 64; o <<= 1) v += shx(v, o, lane);
    return v;
}

#ifndef X_NADEAD
#define X_NADEAD 1
#endif
#ifndef X_REVL
#define X_REVL 0
#endif
#ifndef X_ATT16
#define X_ATT16 3
#endif
#ifndef X_CLKPROBE
#define X_CLKPROBE 0
#endif
#ifndef X_CLKQ
#define X_CLKQ 250.0f
#endif
#ifndef X_CLKUS
#define X_CLKUS 0
#endif
#ifndef X_CLKBLK
#define X_CLKBLK 0
#endif
struct Args { const float* in[23]; float* xres; float* out; unsigned char* ws; int ph_lo, ph_hi, nl, l_lo, l_hi, sub_lo, sub_hi, region; };

__global__ void __launch_bounds__(NWAVES * 64, 2) mk_fwd(Args args_unused) {
    (void)args_unused;
    typedef const __attribute__((address_space(4))) Args* KArgP;
    const KArgP ka0 = (KArgP)__builtin_amdgcn_kernarg_segment_ptr();
#define KA() ({ KArgP k_ = ka0; asm volatile("" : "+s"(k_)); k_; })

    extern __shared__ __attribute__((aligned(16))) unsigned char lds_raw[];
    LAS unsigned char* lds = (LAS unsigned char*)lds_raw;
    LAS unsigned char* ex = lds + EX_OFF;
    volatile LAS unsigned* MISC = (volatile LAS unsigned*)(lds + MISC_OFF);
    const int wave = __builtin_amdgcn_readfirstlane(threadIdx.x >> 6);
    const int G = gridDim.x, bx = blockIdx.x;
    const int vcu = (G % 8 == 0) ? (bx % 8) * (G / 8) + bx / 8 : bx;
    gu32* ctl = (gu32*)(KA()->ws + WS_CTL);
    for (int u = wave * 64 + lane_id(); u < (LDS_BYTES - MISC_OFF) / 4; u += NWAVES * 64) ((LAS unsigned*)(lds + MISC_OFF))[u] = 0u;
    __syncthreads();
    XcdBarrier bar = xcd_barrier_post((unsigned*)(ctl + CW_BAR) + KA()->region * XCD_BAR_WORDS, MISC + 8, wave);
    const int lo = KA()->ph_lo, hi = KA()->ph_hi;
#define IN(k) (lo <= (k) && (k) < hi)
#define GRID_BAR() xcd_barrier(bar, wave)
#define SEAM(local_ok) do { if (xmode && (local_ok)) xcd_local_barrier(bar, wave, xrank & 3); else xcd_barrier(bar, wave); } while (0)
#define PHASE_PTRS() unsigned char* ws = KA()->ws; asm volatile("" : "+s"(ws)); \
    float* ssq_x = (float*)(ws + WS_SSQX); float* ssq_c = (float*)(ws + WS_SSQC); float* ssq_y = (float*)(ws + WS_SSQY); \
    float* ctab = (float*)(ws + WS_CTAB); float* stab = (float*)(ws + WS_STAB); \
    bf16_t* XB = (bf16_t*)(ws + WS_XB); bf16_t* PROJ = (bf16_t*)(ws + WS_PROJ); bf16_t* QM = (bf16_t*)(ws + WS_QM); bf16_t* KNVM = (bf16_t*)(ws + WS_KNVM); \
    bf16_t* Y = (bf16_t*)(ws + WS_Y); bf16_t* P = (bf16_t*)(ws + WS_P); bf16_t* H = (bf16_t*)(ws + WS_H); \
    (void)ssq_x; (void)ssq_c; (void)ssq_y; (void)ctab; (void)stab; (void)XB; (void)PROJ; (void)QM; (void)KNVM; (void)Y; (void)P; (void)H
#define LAYER_PTRS() PHASE_PTRS(); int l = l0; asm volatile("" : "+s"(l)); unsigned char* wl = ws + WS_W + (size_t)l * W_LAYER; (void)wl
    const int gw = vcu * NWAVES + wave, NGW = G * NWAVES;
    const int nl = KA()->nl;

    for (int rep0_ = 0; rep0_ < (X_REP0 ? 2 : 1); ++rep0_) {
    constexpr int I_IN = 32 * 61, I_UQ = 8 * 24, I_UKV = 4 * 32, I_SQ = 32 * 32, I_G = 32 * 88, I_DN = 88 * 32;
    constexpr int I_LAYER = I_IN + I_UQ + I_UKV + 4 * I_SQ + 2 * I_G + I_DN, I_XKV0 = I_IN + I_UQ + I_UKV + I_SQ;
    if (IN(0)) {
        PHASE_PTRS();
        const int lane = lane_id(), tid = wave * 64 + lane; (void)tid;
        LAS unsigned char* scr = lds + wave * 16384;
#define IT_W0 gw
#define IT_NW NGW
#define IT_N (2 * I_SQ)
#define IT_LO I_XKV0
        for (int it = IT_W0; it < nl * IT_N; it += IT_NW) {
            const int l = it / IT_N; int r = (it % IT_N) + IT_LO;
            unsigned char* wl = ws + WS_W + (size_t)l * W_LAYER; unsigned char* tl = ws + WS_TMP + (size_t)l * T_LAYER;
            if (r < I_IN) { const int kb = r / 61, sb = r % 61;
                tr_item64(KA()->in[3] + (size_t)l * DM * 3904, 3904, DM, (bf16_t*)(wl + WL_IN), sb == 60 ? 1 : 0, KA()->in[2] + l * DM, sb < 16 ? QSC_NA : 1.0f, scr, kb, 64 * sb, 64 * sb, lane); continue; } r -= I_IN;
            if (r < I_UQ) { const int kb = r / 24, sb = r % 24, h = sb / 3, p = sb % 3;
                tr_item64(KA()->in[6] + (size_t)l * 512 * 1536, 1536, 512, (bf16_t*)(wl + WL_UQ), p == 2 ? 1 : 0, KA()->in[4] + l * 512, QSC_MLA, scr, kb, 64 * sb, p == 2 ? 1024 + 64 * h : 128 * h + 64 * p, lane); continue; } r -= I_UQ;
            if (r < I_UKV) { const int kb = r / 32, sb = r % 32, h = sb >> 2, p = sb & 3;
                tr_item64(KA()->in[7] + (size_t)l * 256 * 2048, 2048, 256, (bf16_t*)(wl + WL_UKV), 0, KA()->in[5] + l * 256, 1.0f, scr, kb, 64 * sb, (p >> 1) * 1024 + 128 * h + 64 * (p & 1), lane); continue; } r -= I_UKV;
            if (r < I_SQ) { const int kb = r / 32, sb = r % 32;
                const float* gn = (kb < 16) ? (KA()->in[9] + l * 1024) : (KA()->in[10] + l * 1024 - 1024);
                tr_item64(KA()->in[11] + (size_t)l * DM * DM, DM, DM, (bf16_t*)(wl + WL_OUT), 0, gn, 1.0f, scr, kb, 64 * sb, 64 * sb, lane); continue; } r -= I_SQ;
            if (r < I_SQ) { tr_item64(KA()->in[15] + (size_t)l * DM * DM, DM, DM, (bf16_t*)(tl + TL_XKV), 0, nullptr, 1.0f, scr, r / 32, 64 * (r % 32), 64 * (r % 32), lane); continue; } r -= I_SQ;
            if (r < I_SQ) { tr_item64(KA()->in[16] + (size_t)l * DM * DM, DM, DM, (bf16_t*)(tl + TL_XKV) + (size_t)DM * DM, 0, nullptr, 1.0f, scr, r / 32, 64 * (r % 32), 64 * (r % 32), lane); continue; } r -= I_SQ;
            if (r < I_SQ) { tr_item64(KA()->in[17] + (size_t)l * DM * DM, DM, DM, (bf16_t*)(tl + TL_XO), 0, nullptr, 1.0f, scr, r / 32, 64 * (r % 32), 64 * (r % 32), lane); continue; } r -= I_SQ;
            if (r < 2 * I_G) {
                const int up = r >= I_G; const int q = up ? r - I_G : r; const int kb = q / 88, sb = q % 88;
                tr_item64((up ? KA()->in[20] : KA()->in[19]) + (size_t)l * DM * DFF, DFF, DM, (bf16_t*)(wl + WL_GU), 0, KA()->in[18] + l * DM, 1.0f, scr, kb, 64 * sb, 256 * (sb >> 1) + 128 * up + 64 * (sb & 1), lane); continue; } r -= 2 * I_G;
            tr_item64(KA()->in[21] + (size_t)l * DFF * DM, DM, DFF, (bf16_t*)(wl + WL_DN), 0, nullptr, 1.0f, scr, r / 32, 64 * (r % 32), 64 * (r % 32), lane);
        }

#undef IT_W0
#undef IT_NW
#undef IT_N
#undef IT_LO
        for (int m = gw; m < nl * 256; m += NGW) {
            const int l = m >> 8, row = m & 255;
            const GAS f32x4* xr = (const GAS f32x4*)(KA()->in[1] + (size_t)row * DM) + lane; const GAS f32x4* gr = (const GAS f32x4*)(KA()->in[13] + (size_t)l * DM) + lane;
            f32x4 v[8]; float q = 0.f;
#pragma unroll
            for (int j = 0; j < 8; ++j) { v[j] = xr[64 * j]; q += (v[j][0] * v[j][0] + v[j][1] * v[j][1]) + (v[j][2] * v[j][2] + v[j][3] * v[j][3]); }
            const float rstd = 1.0f / sqrtf(wave_sum(q, lane) * (1.0f / DM) + EPS);
            bf16_t* o = (bf16_t*)(ws + WS_TMP + (size_t)l * T_LAYER + TL_MEMN) + (size_t)row * DM;
#pragma unroll
            for (int j = 0; j < 8; ++j) { const f32x4 gv = gr[64 * j]; u32x2 w; w.x = cvt_pk_bf16(v[j][0] * rstd * gv[0], v[j][1] * rstd * gv[1]); w.y = cvt_pk_bf16(v[j][2] * rstd * gv[2], v[j][3] * rstd * gv[3]);
                *(GAS u32x2*)(o + j * 256 + lane * 4) = w; }
        }
        if (IN(1) || X_REP0) GRID_BAR();
    }
    if (IN(1)) {
        PHASE_PTRS();
        const int nP1 = 16 * nl, split = (G >= 2 * nP1);
        if (bx < nP1 || !split) {
            Gemm g{(const bf16_t*)(ws + WS_TMP + TL_MEMN), (const bf16_t*)(ws + WS_TMP + TL_XKV), DM, DM, DM, (long)(T_LAYER / 2), (long)(T_LAYER / 2)};
            GridOrder So; So.init(1, 16, nl, G, bx);
            EpiRow<0> E{(bf16_t*)(ws + WS_TMP + TL_KVMEM), 4096, (long)(T_LAYER / 2), nullptr, 0, 0.f, 1 << 30, 0, nullptr, nullptr, nullptr, 0, 0};
            gemm_phase<EpiRow<0>, GridOrder>(lds, ex, g, So, E, wave);
        }
        if (bx >= nP1 || !split) {
        const int lane = lane_id(), tid = wave * 64 + lane;
        LAS unsigned char* scr = lds + wave * 16384;
        const int cb = split ? bx - nP1 : bx, NCB = split ? G - nP1 : G;
        const int gwc = cb * NWAVES + wave, NGWC = NCB * NWAVES;
#define IT_W0 gwc
#define IT_NW NGWC
#define IT_N (I_LAYER - 2 * I_SQ)
#define IT_LO 0
        for (int it = IT_W0; it < nl * IT_N; it += IT_NW) {
            const int l = X_REVL ? nl - 1 - it / IT_N : it / IT_N; int r = (it % IT_N) + IT_LO; if (r >= I_XKV0) r += 2 * I_SQ;
            unsigned char* wl = ws + WS_W + (size_t)l * W_LAYER; unsigned char* tl = ws + WS_TMP + (size_t)l * T_LAYER;
            if (r < I_IN) { const int kb = r / 61, sb = r % 61;
                tr_item64(KA()->in[3] + (size_t)l * DM * 3904, 3904, DM, (bf16_t*)(wl + WL_IN), sb == 60 ? 1 : 0, KA()->in[2] + l * DM, sb < 16 ? QSC_NA : 1.0f, scr, kb, 64 * sb, 64 * sb, lane); continue; } r -= I_IN;
            if (r < I_UQ) { const int kb = r / 24, sb = r % 24, h = sb / 3, p = sb % 3;
                tr_item64(KA()->in[6] + (size_t)l * 512 * 1536, 1536, 512, (bf16_t*)(wl + WL_UQ), p == 2 ? 1 : 0, KA()->in[4] + l * 512, QSC_MLA, scr, kb, 64 * sb, p == 2 ? 1024 + 64 * h : 128 * h + 64 * p, lane); continue; } r -= I_UQ;
            if (r < I_UKV) { const int kb = r / 32, sb = r % 32, h = sb >> 2, p = sb & 3;
                tr_item64(KA()->in[7] + (size_t)l * 256 * 2048, 2048, 256, (bf16_t*)(wl + WL_UKV), 0, KA()->in[5] + l * 256, 1.0f, scr, kb, 64 * sb, (p >> 1) * 1024 + 128 * h + 64 * (p & 1), lane); continue; } r -= I_UKV;
            if (r < I_SQ) { const int kb = r / 32, sb = r % 32;
                const float* gn = (kb < 16) ? (KA()->in[9] + l * 1024) : (KA()->in[10] + l * 1024 - 1024);
                tr_item64(KA()->in[11] + (size_t)l * DM * DM, DM, DM, (bf16_t*)(wl + WL_OUT), 0, gn, 1.0f, scr, kb, 64 * sb, 64 * sb, lane); continue; } r -= I_SQ;
            if (r < I_SQ) { tr_item64(KA()->in[15] + (size_t)l * DM * DM, DM, DM, (bf16_t*)(tl + TL_XKV), 0, nullptr, 1.0f, scr, r / 32, 64 * (r % 32), 64 * (r % 32), lane); continue; } r -= I_SQ;
            if (r < I_SQ) { tr_item64(KA()->in[16] + (size_t)l * DM * DM, DM, DM, (bf16_t*)(tl + TL_XKV) + (size_t)DM * DM, 0, nullptr, 1.0f, scr, r / 32, 64 * (r % 32), 64 * (r % 32), lane); continue; } r -= I_SQ;
            if (r < I_SQ) { tr_item64(KA()->in[17] + (size_t)l * DM * DM, DM, DM, (bf16_t*)(tl + TL_XO), 0, nullptr, 1.0f, scr, r / 32, 64 * (r % 32), 64 * (r % 32), lane); continue; } r -= I_SQ;
            if (r < 2 * I_G) {
                const int up = r >= I_G; const int q = up ? r - I_G : r; const int kb = q / 88, sb = q % 88;
                tr_item64((up ? KA()->in[20] : KA()->in[19]) + (size_t)l * DM * DFF, DFF, DM, (bf16_t*)(wl + WL_GU), 0, KA()->in[18] + l * DM, 1.0f, scr, kb, 64 * sb, 256 * (sb >> 1) + 128 * up + 64 * (sb & 1), lane); continue; } r -= 2 * I_G;
            tr_item64(KA()->in[21] + (size_t)l * DFF * DM, DM, DFF, (bf16_t*)(wl + WL_DN), 0, nullptr, 1.0f, scr, r / 32, 64 * (r % 32), 64 * (r % 32), lane);
        }

#undef IT_W0
#undef IT_NW
#undef IT_N
#undef IT_LO
        for (size_t i = (size_t)(cb * (NWAVES * 64) + tid); i < (size_t)nl * 192 * DM / 8; i += (size_t)NCB * NWAVES * 64) {
            const int l = (int)(i / (192 * DM / 8)); const size_t e = (i % (192 * DM / 8)) * 8;
            *(GAS u32x4*)((bf16_t*)(ws + WS_W + (size_t)l * W_LAYER + WL_IN) + (size_t)3904 * DM + e) = (u32x4){0u, 0u, 0u, 0u};
        }
        for (size_t i = (size_t)(cb * (NWAVES * 64) + tid); i < (size_t)nl * DM * DM / 8; i += (size_t)NCB * NWAVES * 64) {
            const int l = (int)(i / ((size_t)DM * DM / 8)); const size_t e = (i % ((size_t)DM * DM / 8)) * 8; const int k = (int)(e / DM);
            const float gsc = ((const GAS float*)KA()->in[12])[l * DM + k] * QSC_X;
            const f32x4 a = *(const GAS f32x4*)(KA()->in[14] + (size_t)l * DM * DM + e), b = *(const GAS f32x4*)(KA()->in[14] + (size_t)l * DM * DM + e + 4);
            *(GAS u32x4*)((bf16_t*)(ws + WS_TMP + (size_t)l * T_LAYER + TL_XQ) + e) = pack8(a * gsc, b * gsc);
        }
        for (int m = gwc; m < S; m += NGWC) {
            const GAS f32x4* xr = (const GAS f32x4*)(KA()->in[0] + (size_t)m * DM) + lane;
#pragma unroll
            for (int j = 0; j < 8; ++j) { const f32x4 v = xr[64 * j];
                float q = (v[0] * v[0] + v[1] * v[1]) + (v[2] * v[2] + v[3] * v[3]);
                q += shx(q, 1, lane); q += shx(q, 2, lane); q += shx(q, 4, lane); q += shx(q, 8, lane);
                if ((lane & 15) == 0) ((GAS float*)ssq_x)[(size_t)m * 32 + j * 4 + (lane >> 4)] = q;
                u32x2 w; w.x = cvt_pk_bf16(v[0], v[1]); w.y = cvt_pk_bf16(v[2], v[3]);
                *(GAS u32x2*)(XB + (size_t)m * DM + j * 256 + lane * 4) = w; }
        }
        for (int idx = cb * (NWAVES * 64) + tid; idx < S * 32; idx += NCB * NWAVES * 64) {
            const int pos = idx >> 5, j = idx & 31;
            const float inv = (float)exp2(-(double)j * (13.287712379549449 / 32.0));
            const float ang = (float)pos * inv;
            const double a = (double)ang;
            const double n = rint(a * 0.63661977236758134);
            const double r = fma(-n, 1.5707963267948966, a) - n * 6.123233995736766e-17;
            const int qd = (int)((long long)n & 3);
            const float rf = (float)r, z = rf * rf;
            const float sn = rf + rf * z * (-1.6666654611e-1f + z * (8.3321608736e-3f + z * -1.9515295891e-4f));
            const float cn = 1.0f - 0.5f * z + z * z * (4.166664568298827e-2f + z * (-1.388731625493765e-3f + z * 2.443315711809948e-5f));
            float c, s;
            if (qd == 0) { s = sn; c = cn; } else if (qd == 1) { s = cn; c = -sn; } else if (qd == 2) { s = -sn; c = -cn; } else { s = -cn; c = sn; }
            ((GAS float*)ctab)[idx] = c; ((GAS float*)stab)[idx] = s;
        }
        }
        if (IN(2)) GRID_BAR();
    }
    }
    if (IN(2)) {
        for (int l0 = 0; l0 < nl; ++l0) {
            LAYER_PTRS(); unsigned char* tl = ws + WS_TMP + (size_t)l * T_LAYER;
            { Gemm g{(const bf16_t*)(tl + TL_KVMEM), (const bf16_t*)(tl + TL_XQ), 4096, DM, 512, 512, 512};
              GridOrder So; So.init(1, 8, 4, G, (bx + G - ((l * 64) % G)) % G);
              EpiRow<0> E{(bf16_t*)(wl + WL_QK), DM, (long)256 * DM, nullptr, 0, 0.f, 1 << 30, 0, nullptr, nullptr, nullptr, 0, 0};
              gemm_phase<EpiRow<0>, GridOrder>(lds, ex, g, So, E, wave); }
            { Gemm g{(const bf16_t*)(tl + TL_XO), (const bf16_t*)(tl + TL_KVMEM) + 2048, DM, 4096, 512, 512, 512};
              GridOrder So; So.init(8, 1, 4, G, (bx + G - ((l * 64 + 32) % G)) % G);
              EpiRow<0> E{(bf16_t*)(wl + WL_VO), 1024, 256, nullptr, 0, 0.f, 1 << 30, 0, nullptr, nullptr, nullptr, 0, 0};
              gemm_phase<EpiRow<0>, GridOrder>(lds, ex, g, So, E, wave); }
        }
    }
    if (IN(3)) {
        const int slo = KA()->sub_lo, shi = KA()->sub_hi;
#define SUB(k) (slo <= (k) && (k) < shi)
        GRID_BAR();
        xcd_topology(bar, wave);
        const int xmode = X_XCDLOCAL ? (int)__builtin_amdgcn_readfirstlane((int)MISC[11]) : 0, xidx = (int)__builtin_amdgcn_readfirstlane((int)MISC[12]), xrank = (int)__builtin_amdgcn_readfirstlane((int)MISC[10]);
#if X_REQUIRE_XMODE
        if (!xmode) return;
#endif
#define ORDER(So, nN_) do { if (xmode) So.init_x(nN_, xidx, xrank); else So.init(S / BM, nN_, 1, G, bx); } while (0)
        for (int l0 = KA()->l_lo; l0 < KA()->l_hi; ++l0) {
            for (int rep_ = 0; rep_ < (X_REPG ? 2 : XREP(0)); ++rep_)
            if (SUB(0)) { LAYER_PTRS();
                Gemm g{XB, (const bf16_t*)(wl + WL_IN), DM, DM, DM, 0, 0};
                GridOrder So; ORDER(So, NPROJ / BM);
                EpiRow<8> E{PROJ, NPROJ, 0, ssq_x, 32, 1.0f / DM, 15, 0, ctab, stab, ssq_c, 12, 15};
                gemm_phase<EpiRow<8>, GridOrder>(lds, ex, g, So, E, wave);
                SEAM(true);
            }
            for (int rep_ = 0; rep_ < (X_REPG ? 2 : XREP(1)); ++rep_)
            if (SUB(1)) { LAYER_PTRS();
                { Gemm g{PROJ + 3072, (const bf16_t*)(wl + WL_UQ), NPROJ, 512, 512, 0, 0};
                  GridOrder So; ORDER(So, 6);
                  EpiRow<2> E{QM, 1536, 0, ssq_c, 16, 1.0f / 512.0f, 4, 1, ctab, stab, nullptr, 0, 0};
                  gemm_phase<EpiRow<2>, GridOrder>(lds, ex, g, So, E, wave); }
                { Gemm g{PROJ + 3584, (const bf16_t*)(wl + WL_UKV), NPROJ, 256, 256, 0, 0};
                  GridOrder So; if (xmode) So.init_x(8, xidx, (xrank + 8) & 31); else So.init(S / BM, 8, 1, G, (bx + G - (192 % G)) % G);
                  EpiRow<1> E{KNVM, 2048, 0, ssq_c + 8, 16, 1.0f / 256.0f, 1 << 30, 0, nullptr, nullptr, nullptr, 0, 0};
                  gemm_phase<EpiRow<1>, GridOrder>(lds, ex, g, So, E, wave); }
                GRID_BAR();
            }
            for (int rep_ = 0; rep_ < ((X_REPATT || (X_REPMASK & 0x304)) ? 2 : 1); ++rep_)
            if (SUB(2)) { LAYER_PTRS();
#if X_CLKPROBE == 2
                const unsigned long long pt0 = __builtin_readcyclecounter(), pr0 = __builtin_amdgcn_s_memrealtime();
#endif
                if (!(X_REPMASK & 0x300) || rep_ == 1 || (X_REPMASK & 0x200))
                for (int u0 = bx; u0 < 256; u0 += G) {
                    const int u = (xmode && X_ATTLOCAL) ? ((4 * xidx + (xrank & 3)) * 8 + (xrank >> 2)) : u0;
                    const int h = u & 7, qb = u >> 3; const size_t row0 = (size_t)qb * 256;
                    att::AttnArgs a{QM + row0 * 1536 + h * 128, QM + row0 * 1536 + 1024 + h * 64, KNVM + h * 128, PROJ + 3840, KNVM + 1024 + h * 128,
                                    Y + row0 * DM + 1024 + h * 128, ssq_y + row0 * 16 + 8 + h, S / 64, 0, 0, nullptr};
                    if (X_ATT16 & 1) att::attn_unit16<0, -1>(a, (LAS char*)lds, wave); else att::attn_unit<0>(a, (LAS char*)lds, wave);
                }
#if X_CLKPROBE == 2
                { const unsigned long long pt1 = __builtin_readcyclecounter(), pr1 = __builtin_amdgcn_s_memrealtime();
                  if (bx == X_CLKBLK && wave == 0 && lane_id() == 0) *(GAS float*)(ws + 60000) = ((X_CLKUS ? (float)(pr1 - pr0) * 0.01f : (float)(pt1 - pt0) / (float)(pr1 - pr0) * 100.f) > X_CLKQ) ? 1000.f : 0.f; }
#endif
                if (!(X_REPMASK & 0x300) || rep_ == 1 || (X_REPMASK & 0x100))
                for (int u0 = bx; u0 < 256; u0 += G) {
                    const int u = (xmode && X_ATTLOCAL) ? ((4 * xidx + (xrank & 3)) * 8 + (xrank >> 2)) : u0;
                    const int h = u & 7, rg = u >> 3, rq0 = 4 * rg; int t0 = rq0 - 4; t0 = t0 < 0 ? 0 : (t0 > 116 ? 116 : t0);
                    const size_t row0 = (size_t)rq0 * 64, key0 = (size_t)t0 * 64;
                    att::AttnArgs a{PROJ + row0 * NPROJ + h * 128, nullptr, PROJ + key0 * NPROJ + 1024 + h * 128, nullptr, PROJ + key0 * NPROJ + 2048 + h * 128,
                                    Y + row0 * DM + h * 128, ssq_y + row0 * 16 + h, 12, rq0, t0, KA()->in[8] + ((size_t)l * 8 + h) * 15 * 31};
                    if (X_ATT16 & 2) { if (X_NADEAD) { if (wave & 1) att::attn_unit16<1, 1>(a, (LAS char*)lds, wave); else att::attn_unit16<1, 0>(a, (LAS char*)lds, wave); } else att::attn_unit16<1, -1>(a, (LAS char*)lds, wave); } else att::attn_unit<1>(a, (LAS char*)lds, wave);
                }
                SEAM(X_ATTLOCAL);
            }
            for (int rep_ = 0; rep_ < XREP(3); ++rep_)
            if (SUB(3)) { LAYER_PTRS(); const bool dummy_ = (rep_ + 1 < XREP(3));
                Gemm g{Y, (const bf16_t*)(wl + WL_OUT), DM, DM, DM, 0, 0};
                GridOrder So; ORDER(So, DM / BM);
                EpiRes<true> E{(l == 0) ? KA()->in[0] : nullptr, XB, dummy_ ? QM : XB, dummy_ ? (float*)KNVM : ssq_x, ssq_y};
                gemm_phase<EpiRes<true>, GridOrder>(lds, ex, g, So, E, wave);
                SEAM(true);
            }
            for (int rep_ = 0; rep_ < (X_REPG ? 2 : XREP(4)); ++rep_)
            if (SUB(4)) { LAYER_PTRS();
                Gemm g{XB, (const bf16_t*)(wl + WL_QK), DM, DM, DM, 0, 0};
                if (xmode && X_BM128) {
                    OneUnit So{2 * (4 * xidx + (xrank & 3)) + ((xrank >> 2) & 1), xrank >> 3, 1};
                    EpiSoftmaxT<1> E{P, ssq_x};
                    gemm_phase128<EpiSoftmaxT<1>, OneUnit>(lds, ex, g, So, E, wave);
                } else {
                GridOrder So; ORDER(So, 4);
                EpiSoftmax E{P, ssq_x};
                gemm_phase<EpiSoftmax, GridOrder>(lds, ex, g, So, E, wave);
                }
                SEAM(true);
            }
            for (int rep_ = 0; rep_ < XREP(5); ++rep_)
            if (SUB(5)) { LAYER_PTRS(); const bool dummy_ = (rep_ + 1 < XREP(5));
                Gemm g{P, (const bf16_t*)(wl + WL_VO), 1024, 1024, (dummy_ && X_DUMMY_K) ? X_DUMMY_K : 1024, 0, 0};
                GridOrder So; ORDER(So, DM / BM);
                EpiRes<false> E{nullptr, XB, dummy_ ? QM : XB, dummy_ ? (float*)KNVM : ssq_x, nullptr};
                gemm_phase<EpiRes<false>, GridOrder>(lds, ex, g, So, E, wave, dummy_ && X_DUMMY_NOEPI);
                SEAM(true);
            }
            for (int rep_ = 0; rep_ < (X_REPG ? 2 : XREP(6)); ++rep_)
            if (SUB(6)) { LAYER_PTRS();
                Gemm g{XB, (const bf16_t*)(wl + WL_GU), DM, DM, DM, 0, 0};
                if (xmode && X_BM128) {
                    { GridOrder So; So.init_x(2 * DFF / BM, xidx, xrank, 160);
                      EpiSwiglu E{H, ssq_x};
                      gemm_phase<EpiSwiglu, GridOrder>(lds, ex, g, So, E, wave); }
                    { OneUnit So{2 * (4 * xidx + (xrank & 3)) + ((xrank >> 2) & 1), 40 + (xrank >> 3), 1};
                      EpiSwigluT<1> E{H, ssq_x, 1};
                      gemm_phase128<EpiSwigluT<1>, OneUnit>(lds, ex, g, So, E, wave); }
                } else {
                GridOrder So; ORDER(So, 2 * DFF / BM);
                EpiSwiglu E{H, ssq_x};
                gemm_phase<EpiSwiglu, GridOrder>(lds, ex, g, So, E, wave);
                }
                SEAM(true);
            }
            for (int rep_ = 0; rep_ < XREP(7); ++rep_)
            if (SUB(7)) { LAYER_PTRS(); const bool dummy_ = (rep_ + 1 < XREP(7));
                Gemm g{H, (const bf16_t*)(wl + WL_DN), DFF, DFF, DFF, 0, 0};
                GridOrder So; ORDER(So, DM / BM);
                EpiRes<false> E{nullptr, XB, dummy_ ? QM : XB, dummy_ ? (float*)KNVM : ssq_x, nullptr};
                gemm_phase<EpiRes<false>, GridOrder>(lds, ex, g, So, E, wave);
                SEAM(shi == 8 && slo == 0 && (l0 + 1 < KA()->l_hi || (X_LOCALFINAL && IN(4))));
            }
        }
#undef SUB
    }
    if (IN(4)) {
        PHASE_PTRS();
        const int lane = lane_id();
        const int xm4 = (X_LOCALFINAL && X_XCDLOCAL && IN(3)) ? (int)__builtin_amdgcn_readfirstlane((int)MISC[11]) : 0;
        const int xi4 = (int)__builtin_amdgcn_readfirstlane((int)MISC[12]), xr4 = (int)__builtin_amdgcn_readfirstlane((int)MISC[10]);
        const int m0 = xm4 ? (4 * xi4 + (xr4 & 3)) * 256 + (xr4 >> 2) * 32 + wave * 4 : gw, m1 = xm4 ? m0 + 4 : S, ms = xm4 ? 1 : NGW;
        for (int m = m0; m < m1; m += ms) {
            const GAS u32x4* xr = (const GAS u32x4*)(XB + (size_t)m * DM) + lane; const GAS f32x4* gr = (const GAS f32x4*)(KA()->in[22]);
            f32x4 v[8]; float q = 0.f;
#pragma unroll
            for (int j = 0; j < 4; ++j) { const u32x4 w = xr[64 * j]; v[2 * j] = (f32x4){bf_lo(w.x), bf_hi(w.x), bf_lo(w.y), bf_hi(w.y)}; v[2 * j + 1] = (f32x4){bf_lo(w.z), bf_hi(w.z), bf_lo(w.w), bf_hi(w.w)}; }
#pragma unroll
            for (int j = 0; j < 8; ++j) q += (v[j][0] * v[j][0] + v[j][1] * v[j][1]) + (v[j][2] * v[j][2] + v[j][3] * v[j][3]);
            const float rstd = 1.0f / sqrtf(wave_sum(q, lane) * (1.0f / DM) + EPS);
            float* o = KA()->out + (size_t)m * DM;
#pragma unroll
            for (int j = 0; j < 4; ++j) { const int c = j * 512 + lane * 8;
                *(GAS f32x4*)(o + c) = v[2 * j] * rstd * gr[c / 4]; *(GAS f32x4*)(o + c + 4) = v[2 * j + 1] * rstd * gr[c / 4 + 1]; }
#if X_CLKPROBE
            if (m == 0 && lane == 0) *(GAS float*)o = *(GAS float*)(ws + 60000);
#endif
        }
    }
#undef IN
#undef GRID_BAR
}
}
#ifndef MK_DEBUG
#define MK_DEBUG 0
#endif
static int mk_setup(int& grid) {
    static int g = 0;
    if (g == 0) {
        int dev = 0, cus = 0, per_cu = 0;
        if (hipGetDevice(&dev) != hipSuccess || hipDeviceGetAttribute(&cus, hipDeviceAttributeMultiprocessorCount, dev) != hipSuccess) { fprintf(stderr, "kernel_launch: device query failed\n"); g = -1; return g; }
        if (hipFuncSetAttribute((const void*)fk::mk_fwd, hipFuncAttributeMaxDynamicSharedMemorySize, fk::LDS_BYTES) != hipSuccess) { fprintf(stderr, "kernel_launch: hipFuncSetAttribute failed\n"); g = -1; return g; }
        if (hipOccupancyMaxActiveBlocksPerMultiprocessor(&per_cu, (const void*)fk::mk_fwd, fk::NWAVES * 64, fk::LDS_BYTES) != hipSuccess || per_cu < 1) { fprintf(stderr, "kernel_launch: occupancy query says %d blocks per CU\n", per_cu); }
        (void)hipGetLastError();
        g = cus;
#ifdef X_FORCE_GRID
        g = X_FORCE_GRID;
#endif
    }
    grid = g; return g;
}
#if MK_DEBUG
namespace dbg {
using namespace fk;
__global__ void cmp_k(int kind, const void* fast, const float* orc, int c0, int c1, double* acc) {
    const int row = blockIdx.x; double e = 0.0, r = 0.0;
    const bf16_t* fb = (const bf16_t*)fast; const float* ff = (const float*)fast;
    const int ncol = kind == 0 ? 2048 : kind == 1 ? 3904 : kind == 2 ? 1536 : kind == 3 ? 2048 : (c1 - c0);
    for (int c = threadIdx.x; c < ncol; c += 256) {
        float f, o;
        if (kind == 0) { f = ff[(size_t)row * 2048 + c]; o = orc[(size_t)row * 2048 + c]; }
        else if (kind == 1) { o = orc[(size_t)row * 3904 + c]; int fc = c; float sc = 1.f;
            if (c < 1024) sc = 1.0f / QSC_NA; else if (c >= 3840) { const int j = c - 3840; fc = 3840 + 2 * (j & 31) + (j >> 5); }
            f = __uint_as_float((unsigned)fb[(size_t)row * 4096 + fc] << 16) * sc; }
        else if (kind == 2) { o = orc[(size_t)row * 1536 + c]; const int h = c / 192, d = c % 192; int fc;
            if (d < 128) fc = h * 128 + d; else { const int j = d - 128; fc = 1024 + h * 64 + 2 * (j & 31) + (j >> 5); }
            f = __uint_as_float((unsigned)fb[(size_t)row * 1536 + fc] << 16) * (1.0f / QSC_MLA); }
        else if (kind == 3) { o = orc[(size_t)row * 2048 + c]; const int h = c / 256, d = c % 256; const int fc = d < 128 ? h * 128 + d : 1024 + h * 128 + (d - 128);
            f = __uint_as_float((unsigned)fb[(size_t)row * 2048 + fc] << 16); }
        else { o = orc[(size_t)row * 2048 + c0 + c]; f = __uint_as_float((unsigned)fb[(size_t)row * 2048 + c0 + c] << 16); }
        const double d = (double)f - (double)o; e += (f == f) ? d * d : 1e30; r += (double)o * (double)o;
    }
    for (int o = 32; o > 0; o >>= 1) { e += __shfl_xor(e, o); r += __shfl_xor(r, o); }
    if ((threadIdx.x & 63) == 0) { atomicAdd(acc, e); atomicAdd(acc + 1, r); }
}
__global__ void fin_k(const double* acc, int nstage, float thr, float* out) {
    if (threadIdx.x == 0 && blockIdx.x == 0) {
        int code = -1;
        for (int s = 0; s < nstage; ++s) { const double e = acc[2 * s], r = acc[2 * s + 1]; if (!(e <= (double)thr * r)) { code = s; break; } }
        if (code >= 0) out[0] += 100.0f * (float)(10 + code);
    }
}
}
#endif

extern "C" void kernel_launch(void* const* d_in, const int* in_sizes, int n_in, void* d_out, int out_size, void* d_ws, size_t ws_size, hipStream_t stream) {
    using namespace fk;
    int grid = 0;
    if (mk_setup(grid) <= 0) return;
    const size_t need = MK_DEBUG ? 1010 * MiB : WS_END;
    if (n_in != 23 || out_size != S * DM || ws_size < need) { fprintf(stderr, "kernel_launch: unexpected shapes n_in %d out %d ws %zu (need %zu)\n", n_in, out_size, ws_size, need); return; }
    unsigned char* ws = (unsigned char*)d_ws;
    if (hipMemsetAsync(ws + WS_CTL, 0, CTL_ZERO_BYTES, stream) != hipSuccess) { fprintf(stderr, "kernel_launch: memset failed\n"); return; }
    Args a{};
    for (int i = 0; i < 23; ++i) a.in[i] = (const float*)d_in[i];
    a.ws = ws;
#if !MK_DEBUG
    a.xres = (float*)d_out; a.out = (float*)d_out;
    a.ph_lo = 0; a.ph_hi = 5; a.nl = 4; a.l_lo = 0; a.l_hi = 4; a.sub_lo = 0; a.sub_hi = 8; a.region = 0;
    hipLaunchKernelGGL(mk_fwd, dim3(grid), dim3(NWAVES * 64), LDS_BYTES, stream, a);
    const hipError_t le = hipPeekAtLastError();
    if (le != hipSuccess) fprintf(stderr, "kernel_launch: launch failed: %s\n", hipGetErrorName(le));
#else
    constexpr int NLD = MK_DEBUG_NL;
    ref::Bufs b;
    b.x = (float*)d_out;
    b.proj = (float*)(ws + 210 * MiB); b.q = (float*)(ws + 338 * MiB);
    b.memn = (float*)(ws + 386 * MiB); b.kmem = (float*)(ws + 388 * MiB); b.vmem = (float*)(ws + 390 * MiB);
    b.ctab = (float*)(ws + 392 * MiB); b.stab = (float*)(ws + 393 * MiB);
    b.kv = (float*)(ws + 752 * MiB); b.y = (float*)(ws + 816 * MiB); b.h = (float*)(ws + 880 * MiB); b.Sb = b.h;
    float* xfast = (float*)(ws + 944 * MiB);
    double* acc = (double*)(ws + 1008 * MiB);
    hipMemsetAsync(acc, 0, 4096, stream);
    a.xres = xfast; a.out = xfast; a.nl = NLD;
    int region = 0;
    auto fast = [&](int plo, int phi, int l, int slo, int shi) { a.ph_lo = plo; a.ph_hi = phi; a.l_lo = l; a.l_hi = l + 1; a.sub_lo = slo; a.sub_hi = shi; a.region = region++;
        hipLaunchKernelGGL(mk_fwd, dim3(grid), dim3(NWAVES * 64), LDS_BYTES, stream, a); };
    int stage = 0;
    auto cmp = [&](int kind, const void* f, const float* o, int c0, int c1) { hipLaunchKernelGGL(dbg::cmp_k, dim3(S), dim3(256), 0, stream, kind, f, o, c0, c1, acc + 2 * stage); ++stage; };
    fast(0, 3, 0, 0, 0);
    hipMemcpyAsync(b.x, d_in[0], (size_t)S * DM * 4, hipMemcpyDeviceToDevice, stream);
    hipLaunchKernelGGL(ref::rope_table_k, dim3(S * 32 / 256), dim3(256), 0, stream, b.ctab, b.stab);
    for (int l = 0; l < 4; ++l) {
        if (l < NLD) {
#if MK_DEBUG == 2
            fast(3, 4, l, 0, 4);
#else
            for (int s = 0; s < 4; ++s) fast(3, 4, l, s, s + 1);
#endif
        }
        ref::mixer(stream, d_in, l, b);
        if (l < NLD) { cmp(1, ws + WS_PROJ, b.proj, 0, 0); cmp(2, ws + WS_QM, b.q, 0, 0); cmp(3, ws + WS_KNVM, b.kv, 0, 0); cmp(4, ws + WS_Y, b.y, 0, 1024); cmp(4, ws + WS_Y, b.y, 1024, 2048); }
        ref::mixer_out(stream, d_in, l, b);
        if (l < NLD) { cmp(0, xfast, b.x, 0, 0);
#if MK_DEBUG == 2
            fast(3, 4, l, 4, 6);
#else
            fast(3, 4, l, 4, 5); fast(3, 4, l, 5, 6);
#endif
        }
        ref::cross(stream, d_in, l, b);
        if (l < NLD) { cmp(0, xfast, b.x, 0, 0);
#if MK_DEBUG == 2
            fast(3, 4, l, 6, 8);
#else
            fast(3, 4, l, 6, 7); fast(3, 4, l, 7, 8);
#endif
        }
        ref::ffn(stream, d_in, l, b);
        if (l < NLD) cmp(0, xfast, b.x, 0, 0);
    }
    hipLaunchKernelGGL(ref::rmsnorm_k, dim3(S), dim3(256), 0, stream, b.x, DM, (const float*)d_in[22], b.x, DM, DM);
    hipLaunchKernelGGL(dbg::fin_k, dim3(1), dim3(64), 0, stream, (const double*)acc, stage, (float)MK_DEBUG_THR, (float*)d_out);
#endif
}
```

```cpp
#include <hip/hip_runtime.h>
#include <cstdio>
#include <cstdint>
#include <cmath>
#define X_PRIO47 1
#define LAS __attribute__((address_space(3)))
#define GAS __attribute__((address_space(1)))
typedef unsigned short bf16_t;
typedef short bf16x8 __attribute__((ext_vector_type(8)));
#ifndef X_NODUMMY
#define X_NODUMMY 0
#endif
typedef short s16x4 __attribute__((ext_vector_type(4)));
typedef float f32x2 __attribute__((ext_vector_type(2)));
typedef float f32x4 __attribute__((ext_vector_type(4)));
typedef float f32x16 __attribute__((ext_vector_type(16)));
typedef unsigned u32x2 __attribute__((ext_vector_type(2)));
typedef unsigned u32x4 __attribute__((ext_vector_type(4)));
typedef GAS unsigned gu32;

namespace fk {
constexpr int S = 8192, DM = 2048, NPROJ = 4096, DFF = 5632;
constexpr float EPS = 1e-6f;
constexpr float LOG2E = 1.4426950408889634f;
constexpr float QSC_NA = 0.08838834764831845f * LOG2E, QSC_MLA = 0.07216878364870323f * LOG2E, QSC_X = 0.04419417382415922f * LOG2E;

__device__ __forceinline__ int lane_id(int dep = 0) { unsigned z; asm volatile("s_mul_i32 %0, %1, 0" : "=s"(z) : "s"(dep)); return (int)__builtin_amdgcn_mbcnt_hi(~0u, __builtin_amdgcn_mbcnt_lo(~0u, z)); }
__device__ __forceinline__ float shi(float v, int src) { return __int_as_float(__builtin_amdgcn_ds_bpermute(src << 2, __float_as_int(v))); }
__device__ __forceinline__ float shx(float v, int mask, int lane) { return shi(v, lane ^ mask); }
typedef float f32x2_cv __attribute__((ext_vector_type(2))); typedef __bf16 bf16x2_cv __attribute__((ext_vector_type(2)));
__device__ __forceinline__ unsigned cvt_pk_bf16(float lo, float hi) { const f32x2_cv v = {lo, hi}; const bf16x2_cv b = __builtin_convertvector(v, bf16x2_cv); return __builtin_bit_cast(unsigned, b); }
__device__ __forceinline__ float bf_lo(unsigned w) { return __uint_as_float(w << 16); }
__device__ __forceinline__ float bf_hi(unsigned w) { return __uint_as_float(w & 0xffff0000u); }
__device__ __forceinline__ u32x4 pack8(f32x4 a, f32x4 b) { u32x4 w; w.x = cvt_pk_bf16(a[0], a[1]); w.y = cvt_pk_bf16(a[2], a[3]); w.z = cvt_pk_bf16(b[0], b[1]); w.w = cvt_pk_bf16(b[2], b[3]); return w; }

constexpr int BM = 256, BK = 64, HALF = 128, HTB = HALF * BK * 2, STAGE_BYTES = 8 * HTB, NXCD = 8, WGM = 8;
__host__ __device__ __forceinline__ int lds_byte(int r, int c) { const int st = (r >> 4) * 2 + (c >> 5), rr = r & 15, cc = c & 31, ob = rr * 64 + cc * 2; return st * 1024 + (ob ^ (((ob >> 9) & 1) << 5)); }
__host__ __device__ __forceinline__ void stage_rc(int b, int& R, int& C) { const int st = b / 1024, sb = b % 1024, swz = sb ^ (((sb >> 9) & 1) << 5); R = (st >> 1) * 16 + swz / 64; C = (st & 1) * 32 + (swz % 64) / 2; }
__host__ __device__ __forceinline__ int perm32(int rho) { const int n = rho >> 4, i = rho & 15; return 8 * (i >> 2) + 4 * n + (i & 3); }

struct Unit { int pm, pn, z; };
struct Gemm { const bf16_t* A; const bf16_t* Bt; int lda, ldb, K; long sAz, sBz; };

struct GridOrder {
    int nM, nN, nZ, nwg, G, c; int xm, xi;
    __device__ __forceinline__ void init(int nM_, int nN_, int nZ_, int G_, int c_) { nM = nM_; nN = nN_; nZ = nZ_; nwg = nM * nN * nZ; G = G_; c = c_; xm = 0; xi = 0; }
    __device__ __forceinline__ void init_x(int nN_, int xi_, int rank_, int nlim = 1 << 30) { nM = 32; nN = nN_; nZ = 1; nwg = 4 * nN_ < nlim ? 4 * nN_ : nlim; G = 32; c = rank_; xm = 1; xi = xi_; }
    __device__ __forceinline__ bool next(int i, Unit& u) const {
        const long L = (long)i * G + c; if (L >= nwg) return false;
        int wgid = (int)L, pm, pn, z;
        if (xm) { pm = 4 * xi + (wgid & 3); pn = wgid >> 2; z = 0; }
        else if (nZ == 1) {
            { const int q = nwg / NXCD, r = nwg % NXCD, xcd = wgid % NXCD, off = wgid / NXCD; wgid = (xcd < r ? xcd * (q + 1) : r * (q + 1) + (xcd - r) * q) + off; }
            const int nig = WGM * nN, gid = wgid / nig, fm = gid * WGM, gsz = (nM - fm) < WGM ? (nM - fm) : WGM;
            pm = fm + ((wgid % nig) % gsz); pn = (wgid % nig) / gsz; z = 0;
        } else { const int per = nM * nN; z = wgid / per; const int r = wgid % per; pm = r % nM; pn = r / nM; }
        u.pm = pm; u.pn = pn; u.z = z;
        return true;
    }
};

template <int NAI> using AccT = f32x4[NAI][2][4][2];
typedef AccT<2> Acc;

template <int NP4, int NAI = 2> __device__ __forceinline__ void wave_rstd(float (&rs)[2][4], const float* ssq, int ld, int row0, int lane, int fr, float inv_dim) {
    const GAS f32x4* pa = (const GAS f32x4*)(ssq + (size_t)(row0 + lane) * ld); const GAS f32x4* pb = (const GAS f32x4*)(ssq + (size_t)(row0 + (NAI == 2 ? 128 : 0) + lane) * ld);
    float a = 0.f, b = 0.f;
#pragma unroll
    for (int j = 0; j < NP4; ++j) { const f32x4 v = pa[j]; a += (v[0] + v[1]) + (v[2] + v[3]); if (NAI == 2) { const f32x4 w = pb[j]; b += (w[0] + w[1]) + (w[2] + w[3]); } }
    a = 1.0f / sqrtf(a * inv_dim + EPS); b = 1.0f / sqrtf(b * inv_dim + EPS);
#pragma unroll
    for (int m = 0; m < 4; ++m) { rs[0][m] = shi(a, m * 16 + fr); rs[1][m] = (NAI == 2) ? shi(b, m * 16 + fr) : 0.f; }
}
__device__ __forceinline__ float dpp_add8(float v) {
    v += __int_as_float(__builtin_amdgcn_update_dpp(0, __float_as_int(v), 0xB1, 0xF, 0xF, true));
    v += __int_as_float(__builtin_amdgcn_update_dpp(0, __float_as_int(v), 0x4E, 0xF, 0xF, true));
    v += __int_as_float(__builtin_amdgcn_update_dpp(0, __float_as_int(v), 0x141, 0xF, 0xF, true));
    return v;
}
template <int NAI> struct RsRegs { f32x4 va[8], vb[NAI == 2 ? 8 : 1]; };
template <int NAI = 2> __device__ __forceinline__ void wave_rstd_issue8(RsRegs<NAI>& r, const float* ssq, int row0, int lane) {
    const GAS f32x4* pa = (const GAS f32x4*)(ssq + (size_t)row0 * 32) + lane; const GAS f32x4* pb = (const GAS f32x4*)(ssq + (size_t)(row0 + 128) * 32) + lane;
#pragma unroll
    for (int k = 0; k < 8; ++k) { r.va[k] = pa[64 * k]; if (NAI == 2) r.vb[k] = pb[64 * k]; }
}
template <int NAI = 2> __device__ __forceinline__ void wave_rstd_finish8(const RsRegs<NAI>& r, int lane, float inv_dim, LAS float* cache) {
    float sa[8], sb[8];
#pragma unroll
    for (int k = 0; k < 8; ++k) { const f32x4 v = r.va[k]; sa[k] = dpp_add8((v[0] + v[1]) + (v[2] + v[3])); if (NAI == 2) { const f32x4 w = r.vb[k]; sb[k] = dpp_add8((w[0] + w[1]) + (w[2] + w[3])); } }
    float xa = sa[0], xb = (NAI == 2) ? sb[0] : 0.f; const int kk = lane & 7;
#pragma unroll
    for (int k = 1; k < 8; ++k) { xa = (kk == k) ? sa[k] : xa; if (NAI == 2) xb = (kk == k) ? sb[k] : xb; }
    const int rr = 8 * kk + (lane >> 3);
    cache[rr] = 1.0f / sqrtf(xa * inv_dim + EPS); if (NAI == 2) cache[64 + rr] = 1.0f / sqrtf(xb * inv_dim + EPS);
}
template <int NAI = 2> __device__ __forceinline__ void wave_rstd_fill8(const float* ssq, int row0, int lane, float inv_dim, LAS float* cache) {
    RsRegs<NAI> r; wave_rstd_issue8<NAI>(r, ssq, row0, lane); wave_rstd_finish8<NAI>(r, lane, inv_dim, cache);
}
template <int NP4, int NAI = 2> __device__ __forceinline__ void wave_rstd_c(float (&rs)[2][4], const float* ssq, int ld, int row0, int lane, int fr, float inv_dim, LAS float* cache, int hit) {
    static_assert(NP4 == 8, "cached form: 32 partials per row");
    if (!hit) wave_rstd_fill8<NAI>(ssq, row0, lane, inv_dim, cache);
    const float a = cache[lane], b = (NAI == 2) ? cache[64 + lane] : 0.f;
#pragma unroll
    for (int m = 0; m < 4; ++m) { rs[0][m] = shi(a, m * 16 + fr); rs[1][m] = (NAI == 2) ? shi(b, m * 16 + fr) : 0.f; }
}
__device__ __forceinline__ float sumsq8(f32x4 a, f32x4 b) { return ((a[0] * a[0] + a[1] * a[1]) + (a[2] * a[2] + a[3] * a[3])) + ((b[0] * b[0] + b[1] * b[1]) + (b[2] * b[2] + b[3] * b[3])); }
__device__ __forceinline__ void rope8(f32x4& v0, f32x4& v1, f32x4 c, f32x4 s) {
    const f32x4 a = v0, b = v1;
    v0[0] = a[0] * c[0] - a[1] * s[0]; v0[1] = a[0] * s[0] + a[1] * c[0]; v0[2] = a[2] * c[1] - a[3] * s[1]; v0[3] = a[2] * s[1] + a[3] * c[1];
    v1[0] = b[0] * c[2] - b[1] * s[2]; v1[1] = b[0] * s[2] + b[1] * c[2]; v1[2] = b[2] * c[3] - b[3] * s[3]; v1[3] = b[2] * s[3] + b[3] * c[3];
}

template <int NP4> struct EpiRow {
    static constexpr bool HAS_MID = false, HAS_INIT = false;
    bf16_t* O; int ldc; long sOz;
    const float* ssq_in; int ld_in; float inv_dim;
    int rope_pn; int rope_full; const float* ctab; const float* stab;
    float* ssq_out; int ssq_pn0, ssq_pn1;
    __device__ __forceinline__ void mid(Acc&, const Unit&, int, int, int, int, LAS unsigned char*) const {}
    static constexpr bool RS_CACHE = (NP4 > 0);
    __device__ __forceinline__ void rs_issue(RsRegs<2>& r, const Unit& u, int wr, int lane) const {
        if constexpr (NP4 == 8) wave_rstd_issue8<2>(r, ssq_in, u.pm * BM + wr * 64, lane);
        else if constexpr (NP4 > 0) { const GAS f32x4* pa = (const GAS f32x4*)(ssq_in + (size_t)(u.pm * BM + wr * 64 + lane) * ld_in); const GAS f32x4* pb = (const GAS f32x4*)(ssq_in + (size_t)(u.pm * BM + wr * 64 + 128 + lane) * ld_in);
#pragma unroll
            for (int j = 0; j < NP4; ++j) { r.va[j] = pa[j]; r.vb[j] = pb[j]; } }
    }
    __device__ __forceinline__ void rs_finish(const RsRegs<2>& r, int wr, int wc, int lane, LAS unsigned char* ex) const {
        LAS float* cache = (LAS float*)(ex + (wr * 4 + wc) * 512);
        if constexpr (NP4 == 8) wave_rstd_finish8<2>(r, lane, inv_dim, cache);
        else if constexpr (NP4 > 0) { float a = 0.f, b = 0.f;
#pragma unroll
            for (int j = 0; j < NP4; ++j) { const f32x4 v = r.va[j], w = r.vb[j]; a += (v[0] + v[1]) + (v[2] + v[3]); b += (w[0] + w[1]) + (w[2] + w[3]); }
            cache[lane] = 1.0f / sqrtf(a * inv_dim + EPS); cache[64 + lane] = 1.0f / sqrtf(b * inv_dim + EPS); }
    }
    __device__ __forceinline__ void run(Acc& acc, const Unit& u, int wr, int wc, int fr, int fq, int lane, LAS unsigned char* ex, int hit = 0) const {
        float rs[2][4];
        if constexpr (NP4 > 0) {
            if (!hit) { RsRegs<2> r; rs_issue(r, u, wr, lane); rs_finish(r, wr, wc, lane, ex); }
            LAS float* cache = (LAS float*)(ex + (wr * 4 + wc) * 512); const float a = cache[lane], b = cache[64 + lane];
#pragma unroll
            for (int m = 0; m < 4; ++m) { rs[0][m] = shi(a, m * 16 + fr); rs[1][m] = shi(b, m * 16 + fr); }
        }
        const bool do_ssq = (u.pn >= ssq_pn0 && u.pn < ssq_pn1);
        const bool rope_t = (u.pn >= rope_pn);
        bf16_t* base = O + (size_t)u.z * sOz;
        const int col0 = u.pn * BM + wc * 32 + 8 * fq;
        f32x4 rc[2][4], rsn[2][4];
        if (rope_t) { const int j0 = 16 * (wc & 1) + 4 * fq;
#pragma unroll
            for (int ai = 0; ai < 2; ++ai)
#pragma unroll
                for (int m = 0; m < 4; ++m) { const int row = u.pm * BM + ai * HALF + wr * 64 + m * 16 + fr;
                    rc[ai][m] = *(const GAS f32x4*)(ctab + (size_t)row * 32 + j0); rsn[ai][m] = *(const GAS f32x4*)(stab + (size_t)row * 32 + j0); } }
#pragma unroll
        for (int ai = 0; ai < 2; ++ai)
#pragma unroll
            for (int m = 0; m < 4; ++m) {
                const int row = u.pm * BM + ai * HALF + wr * 64 + m * 16 + fr;
                const float s = (NP4 > 0) ? rs[ai][m] : 1.0f;
                float q = 0.f;
#pragma unroll
                for (int bj = 0; bj < 2; ++bj) {
                    f32x4 v0 = acc[ai][bj][m][0] * s, v1 = acc[ai][bj][m][1] * s;
                    if (rope_t && (rope_full || (bj == 0 && wc < 2))) rope8(v0, v1, rc[ai][m], rsn[ai][m]);
                    q += sumsq8(v0, v1);
                    *(GAS u32x4*)(base + (size_t)row * ldc + col0 + bj * HALF) = pack8(v0, v1);
                }
                if (do_ssq) { q += shx(q, 16, lane); q += shx(q, 32, lane); if (fq == 0) ((GAS float*)ssq_out)[(size_t)row * 16 + (u.pn - ssq_pn0) * 4 + wc] = q; }
            }
    }
};

template <bool MID> struct EpiRes {
    static constexpr bool HAS_MID = MID, HAS_INIT = true, RS_CACHE = false;
    const float* base32; bf16_t* xb; bf16_t* xo; float* ssq_x;
    const float* ssq_y;
    __device__ __forceinline__ void mid(Acc& acc, const Unit& u, int wr, int wc, int fr, int lane, LAS unsigned char* ex) const {
        if constexpr (MID) {
            const LAS float* cache = (const LAS float*)(ex + (wr * 4 + wc) * 1024);
            const float ra = cache[lane], rb = cache[64 + lane];
#pragma unroll
            for (int m = 0; m < 4; ++m) { const float r0 = shi(ra, m * 16 + fr), r1 = shi(rb, m * 16 + fr);
#pragma unroll
                for (int bj = 0; bj < 2; ++bj)
#pragma unroll
                    for (int n = 0; n < 2; ++n) { acc[0][bj][m][n] *= r0; acc[1][bj][m][n] *= r1; } }
        }
    }
    __device__ __forceinline__ void init(Acc& acc, const Unit& u, int wr, int wc, int fr, int fq, int lane, LAS unsigned char* ex) const {
        float sc[2][4];
        if constexpr (MID) {
            const int row0 = u.pm * BM + wr * 64; float a, b;
            LAS float* cache = (LAS float*)(ex + (wr * 4 + wc) * 1024);
            { const GAS f32x4* p = (const GAS f32x4*)(ssq_y + (size_t)(row0 + lane) * 16); const f32x4 a0 = p[0], a1 = p[1], b0 = p[2], b1 = p[3];
              const float na = (((a0[0] + a0[1]) + (a0[2] + a0[3])) + ((a1[0] + a1[1]) + (a1[2] + a1[3]))) * (1.0f / 1024.0f) + EPS, ml = (((b0[0] + b0[1]) + (b0[2] + b0[3])) + ((b1[0] + b1[1]) + (b1[2] + b1[3]))) * (1.0f / 1024.0f) + EPS;
              a = sqrtf(na); cache[lane] = sqrtf(ml / na); cache[128 + lane] = 1.0f / sqrtf(ml); }
            { const GAS f32x4* p = (const GAS f32x4*)(ssq_y + (size_t)(row0 + 128 + lane) * 16); const f32x4 a0 = p[0], a1 = p[1], b0 = p[2], b1 = p[3];
              const float na = (((a0[0] + a0[1]) + (a0[2] + a0[3])) + ((a1[0] + a1[1]) + (a1[2] + a1[3]))) * (1.0f / 1024.0f) + EPS, ml = (((b0[0] + b0[1]) + (b0[2] + b0[3])) + ((b1[0] + b1[1]) + (b1[2] + b1[3]))) * (1.0f / 1024.0f) + EPS;
              b = sqrtf(na); cache[64 + lane] = sqrtf(ml / na); cache[192 + lane] = 1.0f / sqrtf(ml); }
#pragma unroll
            for (int m = 0; m < 4; ++m) { sc[0][m] = shi(a, m * 16 + fr); sc[1][m] = shi(b, m * 16 + fr); }
        }
        const int col0 = u.pn * BM + wc * 32 + 8 * fq;
        if (base32) {
#pragma unroll
            for (int ai = 0; ai < 2; ++ai)
#pragma unroll
                for (int m = 0; m < 4; ++m) {
                    const size_t off = (size_t)(u.pm * BM + ai * HALF + wr * 64 + m * 16 + fr) * DM + col0;
#pragma unroll
                    for (int bj = 0; bj < 2; ++bj) {
                        f32x4 b0 = *(const GAS f32x4*)(base32 + off + bj * HALF), b1 = *(const GAS f32x4*)(base32 + off + bj * HALF + 4);
                        if constexpr (MID) { b0 = b0 * sc[ai][m]; b1 = b1 * sc[ai][m]; }
                        acc[ai][bj][m][0] = b0; acc[ai][bj][m][1] = b1;
                    }
                }
        } else {
            u32x4 w[2][4][2];
#pragma unroll
            for (int ai = 0; ai < 2; ++ai)
#pragma unroll
                for (int m = 0; m < 4; ++m) {
                    const size_t off = (size_t)(u.pm * BM + ai * HALF + wr * 64 + m * 16 + fr) * DM + col0;
#pragma unroll
                    for (int bj = 0; bj < 2; ++bj) w[ai][m][bj] = *(const GAS u32x4*)(xb + off + bj * HALF);
                }
#pragma unroll
            for (int ai = 0; ai < 2; ++ai)
#pragma unroll
                for (int m = 0; m < 4; ++m)
#pragma unroll
                    for (int bj = 0; bj < 2; ++bj) {
                        const u32x4 v = w[ai][m][bj];
                        f32x4 b0 = (f32x4){bf_lo(v.x), bf_hi(v.x), bf_lo(v.y), bf_hi(v.y)}, b1 = (f32x4){bf_lo(v.z), bf_hi(v.z), bf_lo(v.w), bf_hi(v.w)};
                        if constexpr (MID) { b0 = b0 * sc[ai][m]; b1 = b1 * sc[ai][m]; }
                        acc[ai][bj][m][0] = b0; acc[ai][bj][m][1] = b1;
                    }
        }
    }
    __device__ __forceinline__ void run(Acc& acc, const Unit& u, int wr, int wc, int fr, int fq, int lane, LAS unsigned char* ex) const {
        float rs[2][4];
        if constexpr (MID) { const LAS float* cache = (const LAS float*)(ex + (wr * 4 + wc) * 1024); const float ma = cache[128 + lane], mb = cache[192 + lane];
#pragma unroll
            for (int m = 0; m < 4; ++m) { rs[0][m] = shi(ma, m * 16 + fr); rs[1][m] = shi(mb, m * 16 + fr); } }
        const int col0 = u.pn * BM + wc * 32 + 8 * fq;
#pragma unroll
        for (int ai = 0; ai < 2; ++ai)
#pragma unroll
            for (int m = 0; m < 4; ++m) {
                const int row = u.pm * BM + ai * HALF + wr * 64 + m * 16 + fr;
                const float s = MID ? rs[ai][m] : 1.0f;
                const size_t off = (size_t)row * DM + col0;
                float q = 0.f;
#pragma unroll
                for (int bj = 0; bj < 2; ++bj) {
                    const f32x4 v0 = acc[ai][bj][m][0] * s, v1 = acc[ai][bj][m][1] * s;
                    *(GAS u32x4*)(xo + off + bj * HALF) = pack8(v0, v1);
                    q += sumsq8(v0, v1);
                }
                q += shx(q, 16, lane); q += shx(q, 32, lane);
                if (fq == 0) ((GAS float*)ssq_x)[(size_t)row * 32 + u.pn * 4 + wc] = q;
            }
    }
};

template <int NAI> struct EpiSoftmaxT {
    static constexpr bool HAS_MID = false, HAS_INIT = false, RS_CACHE = false;
    bf16_t* P; const float* ssq_x;
    __device__ __forceinline__ void mid(AccT<NAI>&, const Unit&, int, int, int, int, LAS unsigned char*) const {}
    __device__ __forceinline__ void run(AccT<NAI>& acc, const Unit& u, int wr, int wc, int fr, int fq, int lane, LAS unsigned char* ex) const {
        float rs[2][4];
        wave_rstd<8, NAI>(rs, ssq_x, 32, u.pm * (HALF * NAI) + wr * 64, lane, fr, 1.0f / (float)DM);
        LAS f32x2* X = (LAS f32x2*)ex;
#pragma unroll
        for (int ai = 0; ai < NAI; ++ai)
#pragma unroll
            for (int m = 0; m < 4; ++m) {
                const float s = rs[ai][m]; float mx = -INFINITY;
#pragma unroll
                for (int bj = 0; bj < 2; ++bj)
#pragma unroll
                    for (int n = 0; n < 2; ++n) { f32x4 v = acc[ai][bj][m][n] * s; acc[ai][bj][m][n] = v; mx = fmaxf(mx, fmaxf(fmaxf(v[0], v[1]), fmaxf(v[2], v[3]))); }
                mx = fmaxf(mx, shx(mx, 16, lane)); mx = fmaxf(mx, shx(mx, 32, lane));
                float sm = 0.f;
#pragma unroll
                for (int bj = 0; bj < 2; ++bj)
#pragma unroll
                    for (int n = 0; n < 2; ++n) { f32x4 v = acc[ai][bj][m][n];
                        v[0] = __builtin_amdgcn_exp2f(v[0] - mx); v[1] = __builtin_amdgcn_exp2f(v[1] - mx); v[2] = __builtin_amdgcn_exp2f(v[2] - mx); v[3] = __builtin_amdgcn_exp2f(v[3] - mx);
                        acc[ai][bj][m][n] = v; sm += (v[0] + v[1]) + (v[2] + v[3]); }
                sm += shx(sm, 16, lane); sm += shx(sm, 32, lane);
                rs[ai][m] = mx;
                if (fq == 0) X[(ai * HALF + wr * 64 + m * 16 + fr) * 4 + wc] = (f32x2){mx, sm};
            }
        asm volatile("s_waitcnt lgkmcnt(0)" ::: "memory"); __builtin_amdgcn_s_barrier(); asm volatile("" ::: "memory");
        const int col0 = u.pn * BM + wc * 32 + 8 * fq;
#pragma unroll
        for (int ai = 0; ai < NAI; ++ai)
#pragma unroll
            for (int m = 0; m < 4; ++m) {
                const int rl = ai * HALF + wr * 64 + m * 16 + fr, row = u.pm * (HALF * NAI) + rl;
                const f32x2 a = X[rl * 4 + 0], b = X[rl * 4 + 1], c = X[rl * 4 + 2], d = X[rl * 4 + 3];
                const float M = fmaxf(fmaxf(a[0], b[0]), fmaxf(c[0], d[0]));
                const float tot = (a[1] * __builtin_amdgcn_exp2f(a[0] - M) + b[1] * __builtin_amdgcn_exp2f(b[0] - M)) + (c[1] * __builtin_amdgcn_exp2f(c[0] - M) + d[1] * __builtin_amdgcn_exp2f(d[0] - M));
                const float f = __builtin_amdgcn_exp2f(rs[ai][m] - M) / tot;
#pragma unroll
                for (int bj = 0; bj < 2; ++bj)
                    *(GAS u32x4*)(P + (size_t)row * 1024 + col0 + bj * HALF) = pack8(acc[ai][bj][m][0] * f, acc[ai][bj][m][1] * f);
            }
    }
};

template <int NAI> struct EpiSwigluT {
    static constexpr bool HAS_MID = false, HAS_INIT = false;
    bf16_t* H; const float* ssq_x; int reuse = 0;
    __device__ __forceinline__ void mid(AccT<NAI>&, const Unit&, int, int, int, int, LAS unsigned char*) const {}
    static constexpr bool RS_CACHE = true;
    __device__ __forceinline__ void rs_issue(RsRegs<NAI>& r, const Unit& u, int wr, int lane) const { wave_rstd_issue8<NAI>(r, ssq_x, u.pm * (HALF * NAI) + wr * 64, lane); }
    __device__ __forceinline__ void rs_finish(const RsRegs<NAI>& r, int wr, int wc, int lane, LAS unsigned char* ex) const { wave_rstd_finish8<NAI>(r, lane, 1.0f / (float)DM, (LAS float*)(ex + (wr * 4 + wc) * 512)); }
    __device__ __forceinline__ void run(AccT<NAI>& acc, const Unit& u, int wr, int wc, int fr, int fq, int lane, LAS unsigned char* ex, int hit = 0) const {
        float rs[2][4];
        wave_rstd_c<8, NAI>(rs, ssq_x, 32, u.pm * (HALF * NAI) + wr * 64, lane, fr, 1.0f / (float)DM, (LAS float*)(ex + (wr * 4 + wc) * 512) + ((NAI == 1 && reuse) ? (u.pm & 1) * 64 : 0), hit | reuse);
        const int col0 = u.pn * HALF + wc * 32 + 8 * fq;
#pragma unroll
        for (int ai = 0; ai < NAI; ++ai)
#pragma unroll
            for (int m = 0; m < 4; ++m) {
                const int row = u.pm * (HALF * NAI) + ai * HALF + wr * 64 + m * 16 + fr; const float s = rs[ai][m];
                f32x4 o[2];
#pragma unroll
                for (int n = 0; n < 2; ++n) { const f32x4 g = acc[ai][0][m][n] * s, up = acc[ai][1][m][n] * s;
                    f32x4 t = g * (-LOG2E);
                    t = (f32x4){__builtin_amdgcn_exp2f(t[0]), __builtin_amdgcn_exp2f(t[1]), __builtin_amdgcn_exp2f(t[2]), __builtin_amdgcn_exp2f(t[3])};
                    t = t + 1.0f;
                    t = (f32x4){__builtin_amdgcn_rcpf(t[0]), __builtin_amdgcn_rcpf(t[1]), __builtin_amdgcn_rcpf(t[2]), __builtin_amdgcn_rcpf(t[3])};
                    o[n] = (g * up) * t; }
                *(GAS u32x4*)(H + (size_t)row * DFF + col0) = pack8(o[0], o[1]);
            }
    }
};

typedef EpiSoftmaxT<2> EpiSoftmax; typedef EpiSwigluT<2> EpiSwiglu;

template <class Epi, class Sched>
__device__ __forceinline__ void gemm_phase(LAS unsigned char* lds, LAS unsigned char* ex, const Gemm g, const Sched& S_, const Epi& E, int wid_, bool skip_epi = false) {
    int wid = wid_; asm volatile("" : "+s"(wid));
    const int lane = lane_id(), tid = wid * 64 + lane, wr = wid >> 2, wc = wid & 3, fr = lane & 15, fq = lane >> 4;
    int nt = g.K / BK; asm volatile("" : "+s"(nt));
    unsigned voffA[2], voffB[2];
#pragma unroll
    for (int i = 0; i < 2; ++i) { int R, C; stage_rc(tid * 16 + i * 8192, R, C); const int Rb = (R & ~31) + perm32(R & 31);
        voffA[i] = (unsigned)(R * g.lda + C) * 2u; voffB[i] = (unsigned)(Rb * g.ldb + C) * 2u; }
    const size_t kstep = (size_t)(BK * 2);
    const size_t hstepA = (size_t)HALF * g.lda * 2, hstepB = (size_t)HALF * g.ldb * 2;
    const unsigned ldsw = (unsigned)wid * 1024u;
    const int aoff = lds_byte(wr * 64 + fr, fq * 8), boff = lds_byte(wc * 32 + fr, fq * 8);
#define PG8_SA(b, h) (((b) * 2 + (h)) * HTB)
#define PG8_SB(b, h) ((4 + (b) * 2 + (h)) * HTB)
#define PG8_STAGE(bufoff, gbase, voff) do { _Pragma("unroll") for (int _i = 0; _i < 2; ++_i) \
        __builtin_amdgcn_global_load_lds((const unsigned*)((const char*)(gbase) + (voff)[_i]), (LAS unsigned*)(lds + (bufoff) + ldsw + _i * 8192), 16, 0, 0); } while (0)
#define PG8_LDA(dst, b, h) do { _Pragma("unroll") for (int m = 0; m < 4; ++m) _Pragma("unroll") for (int k = 0; k < 2; ++k) dst[m][k] = *(const LAS bf16x8*)(lds + PG8_SA(b, h) + aoff + m * 2048 + k * 1024); } while (0)
#define PG8_LDB(dst, b, h) do { _Pragma("unroll") for (int n = 0; n < 2; ++n) _Pragma("unroll") for (int k = 0; k < 2; ++k) dst[n][k] = *(const LAS bf16x8*)(lds + PG8_SB(b, h) + boff + n * 2048 + k * 1024); } while (0)
#define PG8_MMA(ai, bj, At, Bt) do { __builtin_amdgcn_s_setprio(1); _Pragma("unroll") for (int m = 0; m < 4; ++m) _Pragma("unroll") for (int n = 0; n < 2; ++n) _Pragma("unroll") for (int k = 0; k < 2; ++k) \
        acc[ai][bj][m][n] = __builtin_amdgcn_mfma_f32_16x16x32_bf16(Bt[n][k], At[m][k], acc[ai][bj][m][n], 0, 0, 0); __builtin_amdgcn_s_setprio(0); } while (0)
#define PG8_WAIT_V(n) asm volatile("s_waitcnt vmcnt(" #n ")" ::: "memory")
#define PG8_WAIT_L(n) asm volatile("s_waitcnt lgkmcnt(" #n ")" ::: "memory")
#define PG8_BAR __builtin_amdgcn_s_barrier()
#define PG8_SCHED __builtin_amdgcn_sched_barrier(0)
    Unit cur, nxt; int ui = 0; int prev_pm = -1; (void)prev_pm;
    if (!S_.next(0, cur)) return;
    Acc acc;
    if constexpr (!Epi::HAS_INIT) {
#pragma unroll
    for (int a = 0; a < 2; ++a)
#pragma unroll
        for (int b = 0; b < 2; ++b)
#pragma unroll
            for (int m = 0; m < 4; ++m)
#pragma unroll
                for (int n = 0; n < 2; ++n) acc[a][b][m][n] = (f32x4){0.f, 0.f, 0.f, 0.f};
    }
    bf16x8 At[4][2], B0[2][2], B1[2][2];
    const char* cA = (const char*)(g.A + (size_t)cur.z * g.sAz) + (size_t)cur.pm * 2 * hstepA; const char* cB = (const char*)(g.Bt + (size_t)cur.z * g.sBz) + (size_t)cur.pn * 2 * hstepB;
    RsRegs<2> rsr; (void)rsr; int rs_lane = 0; (void)rs_lane;
    if constexpr (Epi::RS_CACHE) { rs_lane = lane_id(2); E.rs_issue(rsr, cur, wr, rs_lane); }
    PG8_STAGE(PG8_SB(0, 0), cB, voffB); PG8_STAGE(PG8_SB(0, 1), cB + hstepB, voffB); PG8_STAGE(PG8_SA(0, 0), cA, voffA); PG8_STAGE(PG8_SA(0, 1), cA + hstepA, voffA);
    if constexpr (Epi::RS_CACHE) { E.rs_finish(rsr, wr, wc, rs_lane, ex); prev_pm = cur.pm; }
    if constexpr (Epi::HAS_INIT) { const int ln = lane_id(); E.init(acc, cur, wr, wc, ln & 15, ln >> 4, ln, ex); }
    if (wr == 1) PG8_BAR;
    PG8_WAIT_V(2); PG8_BAR;
    PG8_STAGE(PG8_SB(1, 0), cB + kstep, voffB); PG8_STAGE(PG8_SA(1, 0), cA + kstep, voffA); PG8_STAGE(PG8_SB(1, 1), cB + hstepB + kstep, voffB);
    PG8_WAIT_V(6); PG8_BAR;
    for (;;) {
        const bool has_next = S_.next(ui + 1, nxt);
        const char* nA = has_next ? (const char*)(g.A + (size_t)nxt.z * g.sAz) + (size_t)nxt.pm * 2 * hstepA : cA;
        const char* nB = has_next ? (const char*)(g.Bt + (size_t)nxt.z * g.sBz) + (size_t)nxt.pn * 2 * hstepB : cB;
#pragma nounroll
        for (int t = 0; t < nt; t += 2) {
            const bool last = (t == nt - 2);
            if constexpr (Epi::HAS_MID) { if (t == (nt >> 1)) { const int ln = lane_id(t + ui); E.mid(acc, cur, wr, wc, ln & 15, ln, ex); } }
            const char* a1 = cA + (size_t)(t + 1) * kstep;
            const char* a2 = last ? nA : cA + (size_t)(t + 2) * kstep; const char* b2 = last ? nB : cB + (size_t)(t + 2) * kstep;
            const char* a3 = a2 + kstep; const char* b3 = b2 + kstep;
            PG8_LDB(B0, 0, 0); PG8_LDB(B1, 0, 1); PG8_SCHED; PG8_LDA(At, 0, 0); PG8_STAGE(PG8_SA(1, 1), a1 + hstepA, voffA);
            PG8_WAIT_V(8); PG8_WAIT_L(0); PG8_BAR; PG8_MMA(0, 0, At, B0); PG8_MMA(0, 1, At, B1); PG8_BAR; PG8_SCHED;
            const bool nostage = X_NODUMMY && last && !has_next;
            PG8_LDA(At, 0, 1); if (!nostage) { PG8_STAGE(PG8_SB(0, 0), b2, voffB); PG8_STAGE(PG8_SB(0, 1), b2 + hstepB, voffB); PG8_STAGE(PG8_SA(0, 0), a2, voffA); }
            if (nostage) PG8_WAIT_V(2); else PG8_WAIT_V(8); PG8_WAIT_L(0); PG8_BAR; PG8_MMA(1, 0, At, B0); PG8_MMA(1, 1, At, B1); PG8_BAR; PG8_SCHED;
            PG8_LDB(B0, 1, 0); PG8_LDB(B1, 1, 1); PG8_SCHED; PG8_LDA(At, 1, 0); if (!nostage) PG8_STAGE(PG8_SA(0, 1), a2 + hstepA, voffA);
            if (nostage) PG8_WAIT_V(0); else PG8_WAIT_V(8); PG8_WAIT_L(0); PG8_BAR; PG8_MMA(0, 0, At, B0); PG8_MMA(0, 1, At, B1); PG8_BAR; PG8_SCHED;
            PG8_LDA(At, 1, 1); if (!nostage) { PG8_STAGE(PG8_SB(1, 0), b3, voffB); PG8_STAGE(PG8_SB(1, 1), b3 + hstepB, voffB); PG8_STAGE(PG8_SA(1, 0), a3, voffA); }
            if (!nostage) PG8_WAIT_V(8); PG8_WAIT_L(0); PG8_BAR; PG8_MMA(1, 0, At, B0); PG8_MMA(1, 1, At, B1); PG8_BAR; PG8_SCHED;
        }
        if (wr == 0) PG8_BAR;
        if (!skip_epi) { const int ln = lane_id(ui);
            if constexpr (Epi::RS_CACHE) { const int hit = (cur.pm == prev_pm) ? 1 : 0; prev_pm = cur.pm; E.run(acc, cur, wr, wc, ln & 15, ln >> 4, ln, ex, hit); }
            else E.run(acc, cur, wr, wc, ln & 15, ln >> 4, ln, ex); }
        if (!has_next) break;
        if constexpr (Epi::HAS_INIT) { const int ln = lane_id(ui + 1); E.init(acc, nxt, wr, wc, ln & 15, ln >> 4, ln, ex); }
        else {
#pragma unroll
        for (int a = 0; a < 2; ++a)
#pragma unroll
            for (int b = 0; b < 2; ++b)
#pragma unroll
                for (int m = 0; m < 4; ++m)
#pragma unroll
                    for (int n = 0; n < 2; ++n) acc[a][b][m][n] = (f32x4){0.f, 0.f, 0.f, 0.f};
        }
        cur = nxt; cA = nA; cB = nB; ++ui;
        if (wr == 1) PG8_BAR;
    }
    PG8_WAIT_V(0);
    PG8_BAR;
#undef PG8_SA
#undef PG8_SB
#undef PG8_STAGE
#undef PG8_LDA
#undef PG8_LDB
#undef PG8_MMA
#undef PG8_WAIT_V
#undef PG8_WAIT_L
#undef PG8_BAR
#undef PG8_SCHED
}

struct OneUnit { int pm, pn, has;
    __device__ __forceinline__ bool next(int i, Unit& u) const { u.pm = pm; u.pn = pn; u.z = 0; return i == 0 && has != 0; } };

template <class Epi, class Sched>
__device__ __forceinline__ void gemm_phase128(LAS unsigned char* lds, LAS unsigned char* ex, const Gemm g, const Sched& S_, const Epi& E, int wid_) {
    int wid = wid_; asm volatile("" : "+s"(wid));
    const int lane = lane_id(), tid = wid * 64 + lane, wr = wid >> 2, wc = wid & 3, fr = lane & 15;
    const int nt = g.K / BK;
    unsigned voffA[2], voffB[2];
#pragma unroll
    for (int i = 0; i < 2; ++i) { int R, C; stage_rc(tid * 16 + i * 8192, R, C); const int Rb = (R & ~31) + perm32(R & 31);
        voffA[i] = (unsigned)(R * g.lda + C) * 2u; voffB[i] = (unsigned)(Rb * g.ldb + C) * 2u; }
    const size_t kstep = (size_t)(BK * 2);
    const size_t hstepA = (size_t)HALF * g.lda * 2, hstepB = (size_t)HALF * g.ldb * 2;
    const unsigned ldsw = (unsigned)wid * 1024u;
    const int aoff = lds_byte(wr * 64 + fr, (lane >> 4) * 8), boff = lds_byte(wc * 32 + fr, (lane >> 4) * 8);
    constexpr int SLOT = 3 * HTB;
#define P1_STG(off, gbase, voff) do { _Pragma("unroll") for (int _i = 0; _i < 2; ++_i) \
        __builtin_amdgcn_global_load_lds((const unsigned*)((const char*)(gbase) + (voff)[_i]), (LAS unsigned*)(lds + (off) + ldsw + _i * 8192), 16, 0, 0); } while (0)
#define P1_STAGE(slot, pA, pB) do { P1_STG((slot) * SLOT, pA, voffA); P1_STG((slot) * SLOT + HTB, pB, voffB); P1_STG((slot) * SLOT + 2 * HTB, (pB) + hstepB, voffB); } while (0)
#define P1_LDA(dst, slot) do { _Pragma("unroll") for (int m = 0; m < 4; ++m) _Pragma("unroll") for (int k = 0; k < 2; ++k) dst[m][k] = *(const LAS bf16x8*)(lds + (slot) * SLOT + aoff + m * 2048 + k * 1024); } while (0)
#define P1_LDB(dst, slot, h) do { _Pragma("unroll") for (int n = 0; n < 2; ++n) _Pragma("unroll") for (int k = 0; k < 2; ++k) dst[n][k] = *(const LAS bf16x8*)(lds + (slot) * SLOT + (1 + (h)) * HTB + boff + n * 2048 + k * 1024); } while (0)
#define P1_MMA(bj, At, Bt) do { __builtin_amdgcn_s_setprio(1); _Pragma("unroll") for (int m = 0; m < 4; ++m) _Pragma("unroll") for (int n = 0; n < 2; ++n) _Pragma("unroll") for (int k = 0; k < 2; ++k) \
        acc[0][bj][m][n] = __builtin_amdgcn_mfma_f32_16x16x32_bf16(Bt[n][k], At[m][k], acc[0][bj][m][n], 0, 0, 0); __builtin_amdgcn_s_setprio(0); } while (0)
#define P1_WAIT_V(n) asm volatile("s_waitcnt vmcnt(" #n ")" ::: "memory")
#define P1_WAIT_L(n) asm volatile("s_waitcnt lgkmcnt(" #n ")" ::: "memory")
#define P1_BAR __builtin_amdgcn_s_barrier()
#define P1_SCHED __builtin_amdgcn_sched_barrier(0)
    Unit cur, nxt; int ui = 0;
    if (!S_.next(0, cur)) return;
    AccT<1> acc;
#pragma unroll
    for (int b = 0; b < 2; ++b)
#pragma unroll
        for (int m = 0; m < 4; ++m)
#pragma unroll
            for (int n = 0; n < 2; ++n) acc[0][b][m][n] = (f32x4){0.f, 0.f, 0.f, 0.f};
    bf16x8 At[4][2], B0[2][2], B1[2][2];
    const char* cA = (const char*)g.A + (size_t)cur.pm * hstepA; const char* cB = (const char*)g.Bt + (size_t)cur.pn * 2 * hstepB;
    P1_STAGE(0, cA, cB); P1_STAGE(1, cA + kstep, cB + kstep);
    if (wr == 1) P1_BAR;
    P1_WAIT_V(6); P1_BAR; P1_BAR;
    int slot = 0;
    for (;;) {
        const bool has_next = S_.next(ui + 1, nxt);
        const char* nA = has_next ? (const char*)g.A + (size_t)nxt.pm * hstepA : cA;
        const char* nB = has_next ? (const char*)g.Bt + (size_t)nxt.pn * 2 * hstepB : cB;
        for (int t = 0; t < nt; ++t) {
            const int t2 = t + 2;
            const char* a2 = (t2 < nt) ? cA + (size_t)t2 * kstep : nA + (size_t)(t2 - nt) * kstep;
            const char* b2 = (t2 < nt) ? cB + (size_t)t2 * kstep : nB + (size_t)(t2 - nt) * kstep;
            const int s2 = (slot == 0) ? 2 : slot - 1;
            P1_LDB(B0, slot, 0); P1_LDB(B1, slot, 1); P1_SCHED; P1_LDA(At, slot); P1_STAGE(s2, a2, b2);
            P1_WAIT_V(6); P1_WAIT_L(0); P1_BAR; P1_MMA(0, At, B0); P1_MMA(1, At, B1); P1_BAR; P1_SCHED;
            slot = (slot == 2) ? 0 : slot + 1;
        }
        if (wr == 0) P1_BAR;
        { const int ln = lane_id(ui); E.run(acc, cur, wr, wc, ln & 15, ln >> 4, ln, ex); }
        if (!has_next) break;
#pragma unroll
        for (int b = 0; b < 2; ++b)
#pragma unroll
            for (int m = 0; m < 4; ++m)
#pragma unroll
                for (int n = 0; n < 2; ++n) acc[0][b][m][n] = (f32x4){0.f, 0.f, 0.f, 0.f};
        cur = nxt; cA = nA; cB = nB; ++ui;
        if (wr == 1) P1_BAR;
    }
    P1_WAIT_V(0);
    P1_BAR;
#undef P1_STG
#undef P1_STAGE
#undef P1_LDA
#undef P1_LDB
#undef P1_MMA
#undef P1_WAIT_V
#undef P1_WAIT_L
#undef P1_BAR
#undef P1_SCHED
}
}
#ifndef X_PRIO47
#define X_PRIO47 0
#endif
#ifndef X_LATE
#define X_LATE 0
#endif
namespace att {
using namespace fk;
constexpr int NW = 8, QBLK = 32, KVBLK = 64;
constexpr int SHM_V = KVBLK * 128 * 2;
template <int MODE> struct AttL { static constexpr int KSLOT = MODE ? 16384 : 24576, OFF_K = 0, OFF_V = 3 * KSLOT, OFF_WS = OFF_V + 4 * SHM_V, OFF_BIAS = OFF_WS + NW * 64 * 4, END = OFF_BIAS + 4096; };
constexpr int OSTG_PITCH = 272, OSTG_WAVE = 32 * OSTG_PITCH;
static_assert(NW * OSTG_WAVE <= AttL<0>::OFF_WS && NW * OSTG_WAVE <= AttL<1>::OFF_WS && AttL<0>::END <= 147456 && AttL<1>::END <= 147456, "attention LDS map");
constexpr float THR2 = 11.0f;
#define KSWZ(row, colB) ((row) * 256 + ((colB) ^ (((row) & 7) << 4)))
#define KRSWZ(row, colB) ((row) * 128 + ((colB) ^ (((row) & 7) << 4)))
#define SBAR() __builtin_amdgcn_sched_barrier(0)
__device__ __forceinline__ int crow(int r, int hi) { return (r & 3) + 8 * (r >> 2) + 4 * hi; }

#define F2(P, I) ((f32x2){P[I], P[(I) + 1]})
__device__ __forceinline__ float vmax3(float a, float b, float c) { float r; asm("v_max3_f32 %0, %1, %2, %3" : "=v"(r) : "v"(a), "v"(b), "v"(c)); return r; }
__device__ __forceinline__ float vmax3g(float a, float b, float c, float after) { float r; asm("v_max3_f32 %0, %1, %2, %3" : "=v"(r) : "v"(a), "v"(b), "v"(c), "v"(after)); return r; }
__device__ __forceinline__ float vmax2(float a, float b) { float r; asm("v_max_f32 %0, %1, %2" : "=v"(r) : "v"(a), "v"(b)); return r; }
__device__ __forceinline__ void softmax_ref(f32x16& p0, f32x16& p1, f32x16& negm, bool& valid, float& alpha, bf16x8& pa0, bf16x8& pa1, bf16x8& pa2, bf16x8& pa3, float& l_reg) {
  float pmax;
  {
    const float g = fmaxf(p0[15], p1[15]);
    float m0 = vmax3g(p0[0], p0[1], p0[2], g), m1 = vmax3g(p0[8], p0[9], p0[10], g), m2 = vmax3g(p1[0], p1[1], p1[2], g), m3 = vmax3g(p1[8], p1[9], p1[10], g);
    m0 = vmax3(m0, p0[3], p0[4]); m1 = vmax3(m1, p0[11], p0[12]); m2 = vmax3(m2, p1[3], p1[4]); m3 = vmax3(m3, p1[11], p1[12]);
    m0 = vmax3(m0, p0[5], p0[6]); m1 = vmax3(m1, p0[13], p0[14]); m2 = vmax3(m2, p1[5], p1[6]); m3 = vmax3(m3, p1[13], p1[14]);
    m0 = vmax3(m0, m1, p0[7]); m2 = vmax3(m2, m3, p1[7]);
    pmax = vmax3(m0, m2, g); }
  { auto rr = __builtin_amdgcn_permlane32_swap(__float_as_uint(pmax), __float_as_uint(pmax), false, false);
    pmax = vmax2(__uint_as_float(rr[0]), __uint_as_float(rr[1])); }
  alpha = 1.f;
  if (!__builtin_expect(__all(valid && pmax <= THR2), 1)) {
    const bool fin = pmax > -INFINITY;
    const float d = valid ? fmaxf(pmax, 0.f) : (fin ? pmax : 0.f);
    alpha = valid ? __builtin_amdgcn_exp2f(-d) : 1.f;
    valid = valid || fin;
#pragma unroll
    for (int r = 0; r < 16; ++r) { p0[r] -= d; p1[r] -= d; negm[r] -= d; }
  }
#pragma unroll
  for (int r = 0; r < 16; ++r) p0[r] = __builtin_amdgcn_exp2f(p0[r]);
#pragma unroll
  for (int r = 0; r < 16; ++r) p1[r] = __builtin_amdgcn_exp2f(p1[r]);
#define PK4(P, BASE, OUT) do { u32x4 w = {cvt_pk_bf16(P[BASE + 0], P[BASE + 1]), cvt_pk_bf16(P[BASE + 2], P[BASE + 3]), cvt_pk_bf16(P[BASE + 4], P[BASE + 5]), cvt_pk_bf16(P[BASE + 6], P[BASE + 7])}; \
    OUT = *reinterpret_cast<bf16x8*>(&w); } while (0)
  PK4(p0, 0, pa0); PK4(p0, 8, pa1); PK4(p1, 0, pa2); PK4(p1, 8, pa3);
#undef PK4
  {
    f32x2 t0 = F2(p0, 0) + F2(p1, 0), t1 = F2(p0, 2) + F2(p1, 2), t2 = F2(p0, 4) + F2(p1, 4), t3 = F2(p0, 6) + F2(p1, 6);
    f32x2 t4 = F2(p0, 8) + F2(p1, 8), t5 = F2(p0, 10) + F2(p1, 10), t6 = F2(p0, 12) + F2(p1, 12), t7 = F2(p0, 14) + F2(p1, 14);
    t0 += t4; t1 += t5; t2 += t6; t3 += t7; t0 += t2; t1 += t3; t0 += t1;
    l_reg = l_reg * alpha + (t0[0] + t0[1]); }
}
template <int OFF> __device__ __forceinline__ bf16x8 lds_rd128(int addr) { bf16x8 r; asm volatile("ds_read_b128 %0, %1 offset:%2" : "=v"(r) : "v"(addr), "i"(OFF)); return r; }
template <int NP> __device__ __forceinline__ void qkt_pipe(f32x16& p0, f32x16& p1, const f32x16& cinit, const int (&an)[8], const int (&ar)[4], const bf16x8* qr) {
  bf16x8 ka[4], kb[4];
#define KRD(d0) do { constexpr int s_ = (d0) & 3; \
    if constexpr ((d0) < 8) { ka[s_] = lds_rd128<0>(an[(d0) & 7]); kb[s_] = lds_rd128<8192>(an[(d0) & 7]); } \
    else { ka[s_] = lds_rd128<16384>(ar[(d0) & 3]); kb[s_] = lds_rd128<16384 + 4096>(ar[(d0) & 3]); } } while (0)
#define KMM(d0) do { constexpr int s_ = (d0) & 3; constexpr int left_ = (NP - 1 - (d0)) < 2 ? (NP - 1 - (d0)) : 2; \
    if constexpr (left_ == 2) asm volatile("s_waitcnt lgkmcnt(4)" : "+v"(ka[s_]), "+v"(kb[s_])); else if constexpr (left_ == 1) asm volatile("s_waitcnt lgkmcnt(2)" : "+v"(ka[s_]), "+v"(kb[s_])); else asm volatile("s_waitcnt lgkmcnt(0)" : "+v"(ka[s_]), "+v"(kb[s_])); \
    if constexpr ((d0) == 0) { p0 = __builtin_amdgcn_mfma_f32_32x32x16_bf16(ka[s_], qr[d0], cinit, 0, 0, 0); p1 = __builtin_amdgcn_mfma_f32_32x32x16_bf16(kb[s_], qr[d0], cinit, 0, 0, 0); } \
    else { p0 = __builtin_amdgcn_mfma_f32_32x32x16_bf16(ka[s_], qr[d0], p0, 0, 0, 0); p1 = __builtin_amdgcn_mfma_f32_32x32x16_bf16(kb[s_], qr[d0], p1, 0, 0, 0); } \
    if constexpr ((d0) + 3 < NP) KRD((d0) + 3); } while (0)
  KRD(0); KRD(1); KRD(2);
  KMM(0); KMM(1); KMM(2); KMM(3); KMM(4); KMM(5); KMM(6); KMM(7);
  if constexpr (NP > 8) { KMM(8); KMM(9); KMM(10); KMM(11); }
#undef KRD
#undef KMM
}
__device__ __forceinline__ int v_st(int k, int c) { const int kk = (k & ~0xC) | ((k & 4) << 1) | ((k & 8) >> 1); return ((kk >> 3) * 4 + (c >> 5)) * 512 + ((kk & 7) * 32 + (c & 31)) * 2; }
__device__ __forceinline__ int v_rd_base(int lane) { return ((lane & 3) << 3) | (((lane >> 2) & 3) << 6) | (((lane >> 4) & 1) << 5) | (((lane >> 5) & 1) << 8); }
constexpr int v_rd_off(int d0, int ks, int half) { return d0 * 512 + ks * 4096 + half * 2048; }
template <int OFF> __device__ __forceinline__ s16x4 tr_read(int vb) {
  s16x4 r; asm volatile("ds_read_b64_tr_b16 %0, %1 offset:%2" : "=&v"(r) : "v"(vb), "i"(OFF) : "memory"); return r;
}
struct VSet { s16x4 l[4], h[4]; };
template <int KS> __device__ __forceinline__ void v_rd_set(VSet& f, int vb) {
  f.l[0] = tr_read<v_rd_off(0, KS, 0)>(vb); f.h[0] = tr_read<v_rd_off(0, KS, 1)>(vb); f.l[1] = tr_read<v_rd_off(1, KS, 0)>(vb); f.h[1] = tr_read<v_rd_off(1, KS, 1)>(vb);
  f.l[2] = tr_read<v_rd_off(2, KS, 0)>(vb); f.h[2] = tr_read<v_rd_off(2, KS, 1)>(vb); f.l[3] = tr_read<v_rd_off(3, KS, 0)>(vb); f.h[3] = tr_read<v_rd_off(3, KS, 1)>(vb);
}
#define VWAIT(n, f) asm volatile("s_waitcnt lgkmcnt(" #n ")" : "+v"(f.l[0]), "+v"(f.h[0]), "+v"(f.l[1]), "+v"(f.h[1]), "+v"(f.l[2]), "+v"(f.h[2]), "+v"(f.l[3]), "+v"(f.h[3]))
__device__ __forceinline__ void v_mm_set(f32x16* o, const VSet& f, bf16x8 pa) {
#define PK(L, H) (bf16x8){L[0], L[1], L[2], L[3], H[0], H[1], H[2], H[3]}
  o[0] = __builtin_amdgcn_mfma_f32_32x32x16_bf16(PK(f.l[0], f.h[0]), pa, o[0], 0, 0, 0);
  o[1] = __builtin_amdgcn_mfma_f32_32x32x16_bf16(PK(f.l[1], f.h[1]), pa, o[1], 0, 0, 0);
  o[2] = __builtin_amdgcn_mfma_f32_32x32x16_bf16(PK(f.l[2], f.h[2]), pa, o[2], 0, 0, 0);
  o[3] = __builtin_amdgcn_mfma_f32_32x32x16_bf16(PK(f.l[3], f.h[3]), pa, o[3], 0, 0, 0);
#undef PK
}
__device__ __forceinline__ void pv_d0(f32x16* o, int vb, bf16x8 pa0, bf16x8 pa1, bf16x8 pa2, bf16x8 pa3) {
  VSet A, B;
  v_rd_set<0>(A, vb); v_rd_set<1>(B, vb);
  VWAIT(8, A); SBAR(); v_mm_set(o, A, pa0); SBAR(); v_rd_set<2>(A, vb);
  VWAIT(8, B); SBAR(); v_mm_set(o, B, pa1); SBAR(); v_rd_set<3>(B, vb);
  VWAIT(8, A); SBAR(); v_mm_set(o, A, pa2); SBAR();
  VWAIT(0, B); SBAR(); v_mm_set(o, B, pa3);
}
#undef VWAIT
__device__ __forceinline__ void na_bias(f32x16& p0, f32x16& p1, const LAS float* bl, int kc_lo, bool inwin) {
#pragma unroll
  for (int r = 0; r < 16; ++r) { const int k0 = (r & 3) + 8 * (r >> 2);
    const bool v0 = inwin && ((unsigned)(k0 + kc_lo) < 16u), v1 = inwin && ((unsigned)(k0 + 32 + kc_lo) < 16u);
    const float b0 = bl[k0], b1 = bl[k0 + 32];
    p0[r] = v0 ? p0[r] + b0 : -INFINITY; p1[r] = v1 ? p1[r] + b1 : -INFINITY; }
}

struct AttnArgs {
  const bf16_t* Qn; const bf16_t* Qr;
  const bf16_t* Kn; const bf16_t* Kr; const bf16_t* Vh;
  bf16_t* Ob; float* ssq;
  int NT;
  int rq0, krow0; const float* rpb;
};

template <int MODE> __device__ __forceinline__ void attn_unit(const AttnArgs& a, LAS char* lds, int wid_) {
  int wid = wid_; asm volatile("" : "+s"(wid));
  constexpr int LDQ = MODE ? NPROJ : 1536, LDK = MODE ? NPROJ : 2048, LDKR = NPROJ, NQ = MODE ? 8 : 12, ND = MODE ? 4 : 5;
  constexpr int KSLOT = AttL<MODE>::KSLOT, OFF_K = AttL<MODE>::OFF_K, OFF_V = AttL<MODE>::OFF_V, OFF_WS = AttL<MODE>::OFF_WS, OFF_BIAS = AttL<MODE>::OFF_BIAS;
  const int lane = lane_id(a.NT + a.rq0), tid = wid * 64 + lane, r32 = lane & 31, hi = lane >> 5;
  LAS char* V_lds = lds + OFF_V; LAS char* K_lds = lds + OFF_K;

  LAS float* bias_l = (LAS float*)(lds + OFF_BIAS) + 128;
  f32x16 o[4] = {}; f32x16 negm = {}; bool valid = false; float l_reg = 0.f; bf16x8 qr[NQ];
  {
    const bf16_t* Qw = a.Qn + (size_t)(wid * QBLK + r32) * LDQ + hi * 8;
#pragma unroll
    for (int d0 = 0; d0 < 8; ++d0) qr[d0] = *(const GAS bf16x8*)(Qw + d0 * 16);
    if constexpr (MODE == 0) { const bf16_t* Qx = a.Qr + (size_t)(wid * QBLK + r32) * LDQ + hi * 8;
#pragma unroll
      for (int d0 = 0; d0 < 4; ++d0) qr[8 + d0] = *(const GAS bf16x8*)(Qx + d0 * 16); }
  }
  int rq = 0, rs = 0, kc_lo = 0, blane = 0;
  if constexpr (MODE == 1) {
    for (int i = tid; i < 15 * 32; i += NW * 64) { const int dr = i >> 5, dc = i & 31; bias_l[i] = dc < 31 ? ((const GAS float*)a.rpb)[dr * 31 + dc] * LOG2E : 0.f; }
    rq = a.rq0 + (wid >> 1); rs = rq - 4; rs = rs < 0 ? 0 : (rs > 120 ? 120 : rs);
    const int c = (wid & 1) * 32 + r32; int cs = c - 8; cs = cs < 0 ? 0 : (cs > 48 ? 48 : cs);
    kc_lo = 4 * hi - cs; blane = 4 * hi - c + 15;
  }
  unsigned kof[2], vof[2], krof = 0;
#pragma unroll
  for (int e = 0; e < 2; ++e) { const int q = 2 * wid + e;
    { const int row = 4 * q + (lane >> 4), ch = (lane & 15) ^ (row & 15); kof[e] = (unsigned)(row * LDK + ch * 8); }
    { const int sub = lane >> 5, kk = (q >> 1) * 8 + ((lane >> 2) & 7), k = kk, c = ((q & 1) * 2 + sub) * 32 + (lane & 3) * 8; vof[e] = (unsigned)(k * LDK + c); } }
  if constexpr (MODE == 0) { const int row = 8 * wid + (lane >> 3), ch = (lane & 7) ^ ((row >> 1) & 7); krof = (unsigned)(row * LDKR + ch * 8); }
  const int NT = a.NT;
#define GLDS(src, dst) __builtin_amdgcn_global_load_lds((const unsigned*)(src), (LAS unsigned*)(dst), 16, 0, 0)
#define DMA_K(t, slot) do { const int t_ = (t) < NT ? (t) : NT - 1; const bf16_t* kb_ = a.Kn + (size_t)t_ * KVBLK * LDK; LAS char* kd_ = K_lds + (slot) * KSLOT + wid * 2048; \
    GLDS(kb_ + kof[0], kd_); GLDS(kb_ + kof[1], kd_ + 1024); \
    if constexpr (MODE == 0) GLDS(a.Kr + (size_t)t_ * KVBLK * LDKR + krof, K_lds + (slot) * KSLOT + 16384 + wid * 1024); } while (0)
#define DMA_V(t, slot) do { const int t_ = (t) < NT ? (t) : NT - 1; const bf16_t* vb_ = a.Vh + (size_t)t_ * KVBLK * LDK; LAS char* vd_ = V_lds + (slot) * SHM_V + wid * 2048; \
    GLDS(vb_ + vof[0], vd_); GLDS(vb_ + vof[1], vd_ + 1024); } while (0)
#define WAITBAR() do { if constexpr (MODE == 0) asm volatile("s_waitcnt vmcnt(5) lgkmcnt(0)\n\ts_barrier" ::: "memory"); else asm volatile("s_waitcnt vmcnt(4) lgkmcnt(0)\n\ts_barrier" ::: "memory"); } while (0)
  const int vb0 = (int)(unsigned)(uintptr_t)V_lds + v_rd_base(lane);
  const int kl0 = (int)(unsigned)(uintptr_t)K_lds, kxn = ((r32 & 15) << 4) ^ (hi << 4), kxr = (((r32 >> 1) & 7) << 4) ^ (hi << 4);
#define RESC(al) do { if (__any((al) < 1.f)) { _Pragma("unroll") for (int d = 0; d < 4; ++d) _Pragma("unroll") for (int r = 0; r < 16; ++r) o[d][r] *= (al); } } while (0)
#define INW(t) (MODE == 0 || ((a.krow0 + (t)) >= rs && (a.krow0 + (t)) < rs + 8))
#define QK(slot, t) do { if (INW(t)) { int an_[8], ar_[4]; const int sb_ = kl0 + (slot) * KSLOT; \
      _Pragma("unroll") for (int q_ = 0; q_ < 4; ++q_) { an_[q_] = sb_ + r32 * 256 + ((q_ << 5) ^ kxn); an_[4 + q_] = an_[q_] ^ 128; ar_[q_] = sb_ + r32 * 128 + ((q_ << 5) ^ kxr); } \
      qkt_pipe<NQ>(P0, P1, negm, an_, ar_, qr); \
      if constexpr (MODE == 1) { int dr_ = a.krow0 + (t) - rq + 7; dr_ = dr_ < 0 ? 0 : (dr_ > 14 ? 14 : dr_); na_bias(P0, P1, bias_l + dr_ * 32 + blane, kc_lo, true); } } \
    else { _Pragma("unroll") for (int r_ = 0; r_ < 16; ++r_) { P0[r_] = -INFINITY; P1[r_] = -INFINITY; } } } while (0)
#define SMX() do { float al_; softmax_ref(P0, P1, negm, valid, al_, pa0, pa1, pa2, pa3, l_reg); RESC(al_); } while (0)
#define PV(slot, t) do { if (INW(t)) pv_d0(o, vb0 + (slot) * SHM_V, pa0, pa1, pa2, pa3); } while (0)
  f32x16 P0, P1; bf16x8 pa0, pa1, pa2, pa3;
  const bool late = X_LATE == 1 ? (wid >= 4) : (X_LATE == 2 ? ((wid & 1) != 0) : false);
  if (X_PRIO47 && wid >= 4) __builtin_amdgcn_s_setprio(1);
  int ks = 0, vs = 0;
  DMA_K(0, 0); DMA_V(0, 0); DMA_K(1, 1); DMA_V(1, 1);
#define STEP_HEAD(j) WAITBAR(); DMA_K((j) + 2, ks == 0 ? 2 : ks - 1); DMA_V((j) + 2, (vs + 2) & 3)
#define STEP_TAIL() ks = (ks == 2) ? 0 : ks + 1; vs = (vs + 1) & 3
  if (!late) {
    for (int j = 0; j < NT; ++j) { STEP_HEAD(j); QK(ks, j); if (INW(j)) { SMX(); } PV(vs, j); STEP_TAIL(); }
  } else {
    STEP_HEAD(0); QK(ks, 0); STEP_TAIL();
    for (int j = 1; j < NT; ++j) { STEP_HEAD(j); SMX(); PV((vs + 3) & 3, j - 1); QK(ks, j); STEP_TAIL(); }
    SMX(); PV((vs + 3) & 3, NT - 1);
  }
#undef STEP_HEAD
#undef STEP_TAIL
  if (X_PRIO47) __builtin_amdgcn_s_setprio(0);
  asm volatile("s_waitcnt vmcnt(0)" ::: "memory");
  float rl; { auto rr = __builtin_amdgcn_permlane32_swap(__float_as_uint(l_reg), __float_as_uint(l_reg), false, false); rl = __builtin_amdgcn_rcpf(__uint_as_float(rr[0]) + __uint_as_float(rr[1])); }
  __syncthreads();
  LAS char* stg = lds + wid * OSTG_WAVE;
#pragma unroll
  for (int d0 = 0; d0 < 4; ++d0)
#pragma unroll
    for (int g = 0; g < 4; ++g) { u32x2 w; w.x = cvt_pk_bf16(o[d0][4 * g] * rl, o[d0][4 * g + 1] * rl); w.y = cvt_pk_bf16(o[d0][4 * g + 2] * rl, o[d0][4 * g + 3] * rl);
      *(LAS u32x2*)(stg + r32 * OSTG_PITCH + (d0 * 32 + 8 * g + 4 * hi) * 2) = w; }
  asm volatile("s_waitcnt lgkmcnt(0)" ::: "memory");
#pragma unroll
  for (int i = 0; i < 8; ++i) { const int row = i * 4 + (lane >> 4), ch = lane & 15;
    const u32x4 v = *(const LAS u32x4*)(stg + row * OSTG_PITCH + ch * 16);
    *(GAS u32x4*)(a.Ob + (size_t)(wid * QBLK + row) * DM + ch * 8) = v;
    float q = (bf_lo(v.x) * bf_lo(v.x) + bf_hi(v.x) * bf_hi(v.x)) + (bf_lo(v.y) * bf_lo(v.y) + bf_hi(v.y) * bf_hi(v.y)) + (bf_lo(v.z) * bf_lo(v.z) + bf_hi(v.z) * bf_hi(v.z)) + (bf_lo(v.w) * bf_lo(v.w) + bf_hi(v.w) * bf_hi(v.w));
    q += shx(q, 1, lane); q += shx(q, 2, lane); q += shx(q, 4, lane); q += shx(q, 8, lane);
    if (ch == 0) ((GAS float*)a.ssq)[(size_t)(wid * QBLK + row) * 16] = q; }
  asm volatile("s_waitcnt lgkmcnt(0)" ::: "memory");
  __syncthreads();
#undef GLDS
#undef SMX
#undef DMA_K
#undef DMA_V
#undef WAITBAR
#undef RESC
#undef INW
#undef QK
#undef PV
}
#undef KSWZ
#undef KRSWZ
#undef SBAR
}
namespace att {
#define SBAR() __builtin_amdgcn_sched_barrier(0)
template <int N> __device__ __forceinline__ void lgk_wait_tied(bf16x8& f) { asm volatile("s_waitcnt lgkmcnt(%1)" : "+v"(f) : "n"(N)); }
struct VSet16 { s16x4 l[4], h[4]; };
template <int N> struct IC16 { static constexpr int value = N; };
__device__ __forceinline__ float vmax3gu(float a, float b, float c, unsigned after) { float r; asm("v_max3_f32 %0, %1, %2, %3" : "=v"(r) : "v"(a), "v"(b), "v"(c), "v"(after)); return r; }

template <int MODE, int PARW> __device__ __forceinline__ void attn_unit16(const AttnArgs& a, LAS char* lds, int wid_) {
  int wid = wid_; asm volatile("" : "+s"(wid));
  constexpr int LDQ = MODE ? NPROJ : 1536, LDK = MODE ? NPROJ : 2048, LDKR = NPROJ, NDC = MODE ? 4 : 6, NI = 4 * NDC;
  constexpr int KSLOT = AttL<MODE>::KSLOT, OFF_K = AttL<MODE>::OFF_K, OFF_V = AttL<MODE>::OFF_V, OFF_BIAS = AttL<MODE>::OFF_BIAS;
  const int lane = lane_id(a.NT + a.rq0), tid = wid * 64 + lane, c16 = lane & 15, g = lane >> 4;
  LAS char* V_lds = lds + OFF_V; LAS char* K_lds = lds + OFF_K;
  LAS float* bias_l = (LAS float*)(lds + OFF_BIAS) + 128;
  f32x4 o[8][2]; f32x4 cinit[2]; bool valid0 = false, valid1 = false; float l0 = 0.f, l1 = 0.f; bf16x8 qf[2][NDC];
#pragma unroll
  for (int db = 0; db < 8; ++db) { o[db][0] = (f32x4){0.f, 0.f, 0.f, 0.f}; o[db][1] = (f32x4){0.f, 0.f, 0.f, 0.f}; }
  cinit[0] = (f32x4){0.f, 0.f, 0.f, 0.f}; cinit[1] = (f32x4){0.f, 0.f, 0.f, 0.f};
#pragma unroll
  for (int qb = 0; qb < 2; ++qb) {
    const bf16_t* Qw = a.Qn + (size_t)(wid * QBLK + 16 * qb + c16) * LDQ + g * 8;
#pragma unroll
    for (int dc = 0; dc < 4; ++dc) qf[qb][dc] = *(const GAS bf16x8*)(Qw + dc * 32);
    if constexpr (MODE == 0) { const bf16_t* Qx = a.Qr + (size_t)(wid * QBLK + 16 * qb + c16) * LDQ + g * 8;
#pragma unroll
      for (int dc = 0; dc < 2; ++dc) qf[qb][4 + dc] = *(const GAS bf16x8*)(Qx + dc * 32); }
  }
  int rq = 0, rs = 0, klo0 = 0, klo1 = 0, bof0 = 0, bof1 = 0;
  if constexpr (MODE == 1) {
    for (int i = tid; i < 15 * 32; i += NW * 64) { const int dr = i >> 5, dc = i & 31; bias_l[i] = dc < 31 ? ((const GAS float*)a.rpb)[dr * 31 + dc] * LOG2E : 0.f; }
    rq = a.rq0 + (wid >> 1); rs = rq - 4; rs = rs < 0 ? 0 : (rs > 120 ? 120 : rs);
    const int c0 = (wid & 1) * 32 + c16, c1 = c0 + 16; int cs0 = c0 - 8, cs1 = c1 - 8; cs0 = cs0 < 0 ? 0 : (cs0 > 48 ? 48 : cs0); cs1 = cs1 < 0 ? 0 : (cs1 > 48 ? 48 : cs1);
    klo0 = 4 * g - cs0; klo1 = 4 * g - cs1; bof0 = 4 * g - c0 + 15; bof1 = 4 * g - c1 + 15;
  }
  unsigned kof[2], vof[2], krof = 0;
#pragma unroll
  for (int e = 0; e < 2; ++e) { const int q = 2 * wid + e, row = 4 * q + (lane >> 4);
    { const int ch = (lane & 15) ^ (row & 15); kof[e] = (unsigned)(row * LDK + ch * 8); }
    { const int ch = (lane & 15) ^ (2 * (row & 7)); vof[e] = (unsigned)(row * LDK + ch * 8); } }
  if constexpr (MODE == 0) { const int row = 8 * wid + (lane >> 3), ch = (lane & 7) ^ ((row >> 1) & 7); krof = (unsigned)(row * LDKR + ch * 8); }
  const int NT = a.NT;
#define GLDS(src, dst) __builtin_amdgcn_global_load_lds((const unsigned*)(src), (LAS unsigned*)(dst), 16, 0, 0)
#define DMA_K(t, slot) do { const int t_ = (t) < NT ? (t) : NT - 1; const bf16_t* kb_ = a.Kn + (size_t)t_ * KVBLK * LDK; LAS char* kd_ = K_lds + (slot) * KSLOT + wid * 2048; \
    GLDS(kb_ + kof[0], kd_); GLDS(kb_ + kof[1], kd_ + 1024); \
    if constexpr (MODE == 0) GLDS(a.Kr + (size_t)t_ * KVBLK * LDKR + krof, K_lds + (slot) * KSLOT + 16384 + wid * 1024); } while (0)
#define DMA_V(t, slot) do { const int t_ = (t) < NT ? (t) : NT - 1; const bf16_t* vb_ = a.Vh + (size_t)t_ * KVBLK * LDK; LAS char* vd_ = V_lds + (slot) * SHM_V + wid * 2048; \
    GLDS(vb_ + vof[0], vd_); GLDS(vb_ + vof[1], vd_ + 1024); } while (0)
#define WAITBAR() do { if constexpr (MODE == 0) asm volatile("s_waitcnt vmcnt(5) lgkmcnt(0)\n\ts_barrier" ::: "memory"); else asm volatile("s_waitcnt vmcnt(4) lgkmcnt(0)\n\ts_barrier" ::: "memory"); } while (0)
#define INW(t) (MODE == 0 || ((a.krow0 + (t)) >= rs && (a.krow0 + (t)) < rs + 8))
  const int kl0 = (int)(unsigned)(uintptr_t)K_lds;
  const int vX = ((c16 >> 1) & 1) ^ (8 * (g & 1) + 2 * (c16 >> 2));
  const int vb0 = (int)(unsigned)(uintptr_t)V_lds + 256 * (4 * g + (c16 >> 2)) + 16 * vX + 8 * (c16 & 1);
  int ks = 0, vs = 0;
  if (X_PRIO47 && wid >= 4) __builtin_amdgcn_s_setprio(1);
  DMA_K(0, 0); DMA_V(0, 0); DMA_K(1, 1); DMA_V(1, 1);
#define STEP_HEAD(j) WAITBAR(); DMA_K((j) + 2, ks == 0 ? 2 : ks - 1); DMA_V((j) + 2, (vs + 2) & 3)
#define STEP_TAIL() ks = (ks == 2) ? 0 : ks + 1; vs = (vs + 1) & 3
  auto step = [&](auto par_, const int j) __attribute__((always_inline)) {
      constexpr int PAR = decltype(par_)::value;
#define LIVE(kb, qb) (PAR < 0 || (PAR == 0 ? !(((qb) == 0 && (kb) >= 2) || ((qb) == 1 && (kb) == 3)) : !(((qb) == 0 && (kb) == 0) || ((qb) == 1 && (kb) <= 1))))
#define CLIVE(c, qb) (LIVE(2 * (c), qb) || LIVE(2 * (c) + 1, qb))
      f32x4 S[4][2];
      { const int sb_ = kl0 + ks * KSLOT;
        int an_[4], ar_[2];
#pragma unroll
        for (int dc = 0; dc < 4; ++dc) an_[dc] = sb_ + c16 * 256 + (((4 * dc + g) ^ c16) << 4);
#pragma unroll
        for (int dc = 0; dc < 2; ++dc) ar_[dc] = sb_ + 16384 + c16 * 128 + (((4 * dc + g) ^ ((c16 >> 1) & 7)) << 4);
        (void)ar_;
        bf16x8 kf[8];
#define KRD16(idx) do { constexpr int dc_ = (idx) >> 2, kb_ = (idx) & 3; \
          if constexpr (dc_ < 4) kf[(idx) & 7] = lds_rd128<kb_ * 4096>(an_[dc_ & 3]); else kf[(idx) & 7] = lds_rd128<kb_ * 2048>(ar_[dc_ & 1]); } while (0)
#define KMM16(idx) do { constexpr int dc_ = (idx) >> 2, kb_ = (idx) & 3; constexpr int left_ = (NI - 1 - (idx)) < 7 ? (NI - 1 - (idx)) : 7; \
          lgk_wait_tied<left_>(kf[(idx) & 7]); \
          if constexpr (dc_ == 0) { if constexpr (LIVE(kb_, 0)) S[kb_][0] = __builtin_amdgcn_mfma_f32_16x16x32_bf16(kf[(idx) & 7], qf[0][0], cinit[0], 0, 0, 0); \
                                    if constexpr (LIVE(kb_, 1)) S[kb_][1] = __builtin_amdgcn_mfma_f32_16x16x32_bf16(kf[(idx) & 7], qf[1][0], cinit[1], 0, 0, 0); } \
          else { if constexpr (LIVE(kb_, 0)) S[kb_][0] = __builtin_amdgcn_mfma_f32_16x16x32_bf16(kf[(idx) & 7], qf[0][dc_], S[kb_][0], 0, 0, 0); \
                 if constexpr (LIVE(kb_, 1)) S[kb_][1] = __builtin_amdgcn_mfma_f32_16x16x32_bf16(kf[(idx) & 7], qf[1][dc_], S[kb_][1], 0, 0, 0); } \
          if constexpr ((idx) + 8 < NI) KRD16((idx) + 8); } while (0)
        KRD16(0); KRD16(1); KRD16(2); KRD16(3); KRD16(4); KRD16(5); KRD16(6); KRD16(7);
        KMM16(0); KMM16(1); KMM16(2); KMM16(3); KMM16(4); KMM16(5); KMM16(6); KMM16(7);
        KMM16(8); KMM16(9); KMM16(10); KMM16(11); KMM16(12); KMM16(13); KMM16(14); KMM16(15);
        if constexpr (NDC > 4) { KMM16(16); KMM16(17); KMM16(18); KMM16(19); KMM16(20); KMM16(21); KMM16(22); KMM16(23); }
#undef KRD16
#undef KMM16
      }
      float pm0, pm1;
      if constexpr (MODE == 1) {
        int dr_ = a.krow0 + j - rq + 7; dr_ = dr_ < 0 ? 0 : (dr_ > 14 ? 14 : dr_);
        const LAS float* bl0 = bias_l + dr_ * 32 + bof0; const LAS float* bl1 = bias_l + dr_ * 32 + bof1;
        pm0 = -INFINITY; pm1 = -INFINITY;
#pragma unroll
        for (int kb = 0; kb < 4; ++kb) {
          if (LIVE(kb, 0)) {
#pragma unroll
            for (int i = 0; i < 4; ++i) { const int k0 = 16 * kb + i; const float b0 = bl0[k0]; const bool v0 = (unsigned)(k0 + klo0) < 16u; S[kb][0][i] = v0 ? S[kb][0][i] + b0 : -INFINITY; }
            pm0 = vmax3(pm0, S[kb][0][0], S[kb][0][1]); pm0 = vmax3(pm0, S[kb][0][2], S[kb][0][3]); }
          if (LIVE(kb, 1)) {
#pragma unroll
            for (int i = 0; i < 4; ++i) { const int k0 = 16 * kb + i; const float b1 = bl1[k0]; const bool v1 = (unsigned)(k0 + klo1) < 16u; S[kb][1][i] = v1 ? S[kb][1][i] + b1 : -INFINITY; }
            pm1 = vmax3(pm1, S[kb][1][0], S[kb][1][1]); pm1 = vmax3(pm1, S[kb][1][2], S[kb][1][3]); }
        }
      } else {
      {
        const unsigned gd = (__float_as_uint(S[0][0][3]) | __float_as_uint(S[1][0][3]) | __float_as_uint(S[2][0][3])) | (__float_as_uint(S[3][0][3]) | __float_as_uint(S[0][1][3]) | __float_as_uint(S[1][1][3])) | (__float_as_uint(S[2][1][3]) | __float_as_uint(S[3][1][3]));
        float a0 = vmax3gu(S[0][0][0], S[0][0][1], S[0][0][2], gd), b0 = vmax3gu(S[2][0][0], S[2][0][1], S[2][0][2], gd), a1 = vmax3gu(S[0][1][0], S[0][1][1], S[0][1][2], gd), b1 = vmax3gu(S[2][1][0], S[2][1][1], S[2][1][2], gd);
        a0 = vmax3(a0, S[0][0][3], S[1][0][0]); b0 = vmax3(b0, S[2][0][3], S[3][0][0]); a1 = vmax3(a1, S[0][1][3], S[1][1][0]); b1 = vmax3(b1, S[2][1][3], S[3][1][0]);
        a0 = vmax3(a0, S[1][0][1], S[1][0][2]); b0 = vmax3(b0, S[3][0][1], S[3][0][2]); a1 = vmax3(a1, S[1][1][1], S[1][1][2]); b1 = vmax3(b1, S[3][1][1], S[3][1][2]);
        a0 = vmax3(a0, b0, S[1][0][3]); a1 = vmax3(a1, b1, S[1][1][3]);
        pm0 = vmax2(a0, S[3][0][3]); pm1 = vmax2(a1, S[3][1][3]); }
      }
      { auto r0 = __builtin_amdgcn_permlane16_swap(__float_as_uint(pm0), __float_as_uint(pm0), false, false); pm0 = vmax2(__uint_as_float(r0[0]), __uint_as_float(r0[1]));
        auto r1 = __builtin_amdgcn_permlane16_swap(__float_as_uint(pm1), __float_as_uint(pm1), false, false); pm1 = vmax2(__uint_as_float(r1[0]), __uint_as_float(r1[1]));
        auto s0 = __builtin_amdgcn_permlane32_swap(__float_as_uint(pm0), __float_as_uint(pm0), false, false); pm0 = vmax2(__uint_as_float(s0[0]), __uint_as_float(s0[1]));
        auto s1 = __builtin_amdgcn_permlane32_swap(__float_as_uint(pm1), __float_as_uint(pm1), false, false); pm1 = vmax2(__uint_as_float(s1[0]), __uint_as_float(s1[1])); }
      if (!__builtin_expect(__all(valid0 && valid1 && pm0 <= THR2 && pm1 <= THR2), 1)) {
        { const bool fin = pm0 > -INFINITY; const float d = valid0 ? fmaxf(pm0, 0.f) : (fin ? pm0 : 0.f); const float al = valid0 ? __builtin_amdgcn_exp2f(-d) : 1.f; valid0 = valid0 || fin;
#pragma unroll
          for (int kb = 0; kb < 4; ++kb) if (LIVE(kb, 0)) S[kb][0] -= d;
          cinit[0] -= d; l0 *= al;
          if (__any(al < 1.f)) {
#pragma unroll
            for (int db = 0; db < 8; ++db) o[db][0] *= al; } }
        { const bool fin = pm1 > -INFINITY; const float d = valid1 ? fmaxf(pm1, 0.f) : (fin ? pm1 : 0.f); const float al = valid1 ? __builtin_amdgcn_exp2f(-d) : 1.f; valid1 = valid1 || fin;
#pragma unroll
          for (int kb = 0; kb < 4; ++kb) if (LIVE(kb, 1)) S[kb][1] -= d;
          cinit[1] -= d; l1 *= al;
          if (__any(al < 1.f)) {
#pragma unroll
            for (int db = 0; db < 8; ++db) o[db][1] *= al; } }
      }
#pragma unroll
      for (int kb = 0; kb < 4; ++kb)
#pragma unroll
        for (int qb = 0; qb < 2; ++qb)
          if (LIVE(kb, qb)) {
#pragma unroll
            for (int i = 0; i < 4; ++i) S[kb][qb][i] = __builtin_amdgcn_exp2f(S[kb][qb][i]); }
      bf16x8 pa[2][2];
      const f32x4 zero4 = {0.f, 0.f, 0.f, 0.f};
#pragma unroll
      for (int qb = 0; qb < 2; ++qb)
#pragma unroll
        for (int c = 0; c < 2; ++c) if (CLIVE(c, qb)) { const u32x4 w = pack8(LIVE(2 * c, qb) ? S[2 * c][qb] : zero4, LIVE(2 * c + 1, qb) ? S[2 * c + 1][qb] : zero4); pa[qb][c] = *reinterpret_cast<const bf16x8*>(&w); }
      { f32x4 t0 = zero4, t1 = zero4;
        if constexpr (PAR < 0) { t0 = (S[0][0] + S[1][0]) + (S[2][0] + S[3][0]); t1 = (S[0][1] + S[1][1]) + (S[2][1] + S[3][1]); }
        else {
#pragma unroll
          for (int kb = 0; kb < 4; ++kb) { if (LIVE(kb, 0)) t0 += S[kb][0]; if (LIVE(kb, 1)) t1 += S[kb][1]; } }
        l0 += (t0[0] + t0[1]) + (t0[2] + t0[3]); l1 += (t1[0] + t1[1]) + (t1[2] + t1[3]); }
      { const int vb = vb0 + vs * SHM_V;
        int va[8];
#pragma unroll
        for (int db = 0; db < 8; ++db) va[db] = vb ^ (32 * db);
        VSet16 A, B;
#define VRD16(f, c_, dbh_) do { _Pragma("unroll") for (int n_ = 0; n_ < 4; ++n_) { f.l[n_] = tr_read<(c_) * 8192>(va[4 * (dbh_) + n_]); f.h[n_] = tr_read<(c_) * 8192 + 4096>(va[4 * (dbh_) + n_]); } } while (0)
#define VWAIT16(n, f) asm volatile("s_waitcnt lgkmcnt(" #n ")" : "+v"(f.l[0]), "+v"(f.h[0]), "+v"(f.l[1]), "+v"(f.h[1]), "+v"(f.l[2]), "+v"(f.h[2]), "+v"(f.l[3]), "+v"(f.h[3]))
#define PKV(L, H) (bf16x8){L[0], L[1], L[2], L[3], H[0], H[1], H[2], H[3]}
#define VMM16(f, c_, dbh_) do { _Pragma("unroll") for (int n_ = 0; n_ < 4; ++n_) { const bf16x8 vf_ = PKV(f.l[n_], f.h[n_]); \
            if constexpr (CLIVE(c_, 0)) o[4 * (dbh_) + n_][0] = __builtin_amdgcn_mfma_f32_16x16x32_bf16(vf_, pa[0][c_], o[4 * (dbh_) + n_][0], 0, 0, 0); \
            if constexpr (CLIVE(c_, 1)) o[4 * (dbh_) + n_][1] = __builtin_amdgcn_mfma_f32_16x16x32_bf16(vf_, pa[1][c_], o[4 * (dbh_) + n_][1], 0, 0, 0); } } while (0)
        VRD16(A, 0, 0); VRD16(B, 0, 1);
        VWAIT16(8, A); SBAR(); VMM16(A, 0, 0); SBAR(); VRD16(A, 1, 0);
        VWAIT16(8, B); SBAR(); VMM16(B, 0, 1); SBAR(); VRD16(B, 1, 1);
        VWAIT16(8, A); SBAR(); VMM16(A, 1, 0); SBAR();
        VWAIT16(0, B); SBAR(); VMM16(B, 1, 1);
#undef VRD16
#undef VWAIT16
#undef VMM16
#undef PKV
      }
#undef LIVE
#undef CLIVE
  };
  for (int j = 0; j < NT; ++j) { STEP_HEAD(j); if (INW(j)) step(IC16<PARW>{}, j); STEP_TAIL(); }
#undef STEP_HEAD
#undef STEP_TAIL
  if (X_PRIO47) __builtin_amdgcn_s_setprio(0);
  asm volatile("s_waitcnt vmcnt(0)" ::: "memory");
  float rl0, rl1;
  { auto r0 = __builtin_amdgcn_permlane16_swap(__float_as_uint(l0), __float_as_uint(l0), false, false); l0 = __uint_as_float(r0[0]) + __uint_as_float(r0[1]);
    auto r1 = __builtin_amdgcn_permlane16_swap(__float_as_uint(l1), __float_as_uint(l1), false, false); l1 = __uint_as_float(r1[0]) + __uint_as_float(r1[1]);
    auto s0 = __builtin_amdgcn_permlane32_swap(__float_as_uint(l0), __float_as_uint(l0), false, false); rl0 = __builtin_amdgcn_rcpf(__uint_as_float(s0[0]) + __uint_as_float(s0[1]));
    auto s1 = __builtin_amdgcn_permlane32_swap(__float_as_uint(l1), __float_as_uint(l1), false, false); rl1 = __builtin_amdgcn_rcpf(__uint_as_float(s1[0]) + __uint_as_float(s1[1])); }
  __syncthreads();
  LAS char* stg = lds + wid * OSTG_WAVE;
#pragma unroll
  for (int db = 0; db < 8; ++db) {
    { u32x2 w; w.x = cvt_pk_bf16(o[db][0][0] * rl0, o[db][0][1] * rl0); w.y = cvt_pk_bf16(o[db][0][2] * rl0, o[db][0][3] * rl0); *(LAS u32x2*)(stg + c16 * OSTG_PITCH + (16 * db + 4 * g) * 2) = w; }
    { u32x2 w; w.x = cvt_pk_bf16(o[db][1][0] * rl1, o[db][1][1] * rl1); w.y = cvt_pk_bf16(o[db][1][2] * rl1, o[db][1][3] * rl1); *(LAS u32x2*)(stg + (16 + c16) * OSTG_PITCH + (16 * db + 4 * g) * 2) = w; }
  }
  asm volatile("s_waitcnt lgkmcnt(0)" ::: "memory");
#pragma unroll
  for (int i = 0; i < 8; ++i) { const int row = i * 4 + (lane >> 4), ch = lane & 15;
    const u32x4 v = *(const LAS u32x4*)(stg + row * OSTG_PITCH + ch * 16);
    *(GAS u32x4*)(a.Ob + (size_t)(wid * QBLK + row) * DM + ch * 8) = v;
    float q = (bf_lo(v.x) * bf_lo(v.x) + bf_hi(v.x) * bf_hi(v.x)) + (bf_lo(v.y) * bf_lo(v.y) + bf_hi(v.y) * bf_hi(v.y)) + (bf_lo(v.z) * bf_lo(v.z) + bf_hi(v.z) * bf_hi(v.z)) + (bf_lo(v.w) * bf_lo(v.w) + bf_hi(v.w) * bf_hi(v.w));
    q += shx(q, 1, lane); q += shx(q, 2, lane); q += shx(q, 4, lane); q += shx(q, 8, lane);
    if (ch == 0) ((GAS float*)a.ssq)[(size_t)(wid * QBLK + row) * 16] = q; }
  asm volatile("s_waitcnt lgkmcnt(0)" ::: "memory");
  __syncthreads();
#undef GLDS
#undef DMA_K
#undef DMA_V
#undef WAITBAR
#undef INW
}
#undef SBAR
}
#ifndef X_LOCALFINAL
#define X_LOCALFINAL 1
#endif
#ifndef X_EARLYINV
#define X_EARLYINV 1
#endif
#ifndef X_REP0
#define X_REP0 0
#endif
#ifndef X_REPATT
#define X_REPATT 0
#endif
#ifndef X_REPG
#define X_REPG 0
#endif
#ifndef X_DUMMY_K
#define X_DUMMY_K 0
#endif
#ifndef X_DUMMY_NOEPI
#define X_DUMMY_NOEPI 0
#endif
#ifndef X_XCDLOCAL
#define X_XCDLOCAL 1
#endif
#ifndef X_REQUIRE_XMODE
#define X_REQUIRE_XMODE 0
#endif
#ifndef X_ATTLOCAL
#define X_ATTLOCAL 1
#endif
#ifndef X_BM128
#define X_BM128 1
#endif
#ifndef X_REPMASK
#define X_REPMASK 0
#endif
#define XREP(k) ((((X_REPMASK) >> (k)) & 1) ? 2 : 1)
namespace fk {
constexpr int NWAVES = 8;
constexpr size_t MiB = 1u << 20;
constexpr size_t WS_CTL = 0, CTL_ZERO_BYTES = 64 * 1024;
constexpr size_t WS_SSQX = 1 * MiB;
constexpr size_t WS_SSQC = 2 * MiB;
constexpr size_t WS_SSQY = 2 * MiB + 512 * 1024;
constexpr size_t WS_CTAB = 3 * MiB, WS_STAB = 4 * MiB;
constexpr size_t WS_W = 8 * MiB, W_LAYER = 101 * MiB;
constexpr size_t WL_IN = 0, WL_UQ = 16 * MiB, WL_UKV = 17 * MiB + 512 * 1024, WL_OUT = 18 * MiB + 512 * 1024, WL_QK = 26 * MiB + 512 * 1024, WL_VO = 30 * MiB + 512 * 1024,
                 WL_GU = 34 * MiB + 512 * 1024, WL_DN = 78 * MiB + 512 * 1024;
constexpr size_t WS_XB = 412 * MiB;
constexpr size_t WS_PROJ = 444 * MiB;
constexpr size_t WS_QM = 508 * MiB;
constexpr size_t WS_KNVM = 532 * MiB;
constexpr size_t WS_Y = 564 * MiB;
constexpr size_t WS_P = 596 * MiB;
constexpr size_t WS_TMP = 612 * MiB, T_LAYER = 35 * MiB;
constexpr size_t TL_XQ = 0, TL_XKV = 8 * MiB, TL_XO = 24 * MiB, TL_MEMN = 32 * MiB, TL_KVMEM = 33 * MiB;
constexpr size_t WS_H = 612 * MiB;
constexpr size_t WS_END = 752 * MiB;
static_assert(WS_W + 4 * W_LAYER <= WS_XB && WS_TMP + 4 * T_LAYER <= WS_END && WS_H + (size_t)S * DFF * 2 <= WS_END, "d_ws map");
constexpr int CW_BAR = 4096;
constexpr int RING_BYTES = 147456, EX_OFF = RING_BYTES, MISC_OFF = EX_OFF + 8192, LDS_BYTES = 159744;

#define RLX_AGENT __ATOMIC_RELAXED, __HIP_MEMORY_SCOPE_AGENT
#define LDS_WAIT() asm volatile("s_waitcnt lgkmcnt(0)" ::: "memory")
#define XB_TMO      128
#define XB_XCNT(j)  (256  + 64 * (j))
#define XB_XSUB(j)  (1280 + 64 * (j))
#define XB_XGEN(j)  (2304 + 64 * (j))
#define XB_TOP      3328
#define XB_TOPGEN   3392
#define XB_LSUB(j)  (3456 + 64 * (j))
#define XCD_BAR_WORDS 7552
#define XB_SPIN_CAP (1u << 18)
__device__ __forceinline__ unsigned xb_ld(unsigned* p)              { return __hip_atomic_load(p, __ATOMIC_RELAXED, __HIP_MEMORY_SCOPE_AGENT); }
__device__ __forceinline__ unsigned xb_add(unsigned* p, unsigned v) { return __hip_atomic_fetch_add(p, v, __ATOMIC_RELAXED, __HIP_MEMORY_SCOPE_AGENT); }
__device__ __forceinline__ unsigned xb_xcc_id() { return (unsigned)__builtin_amdgcn_s_getreg((3 << 11) | 20) & 0xFu; }
#define XB_SPIN(cond, bar) do { unsigned _sp = 0; while (cond) { __builtin_amdgcn_s_sleep(1); \
    if ((++_sp & 255u) == 0u) { if (xb_ld(&(bar)[XB_TMO])) break; if (_sp > XB_SPIN_CAP) { atomicAdd(&(bar)[XB_TMO], 1u); break; } } } } while (0)
struct XcdBarrier { unsigned* bar; unsigned x; volatile LAS unsigned* st; };
__device__ __forceinline__ XcdBarrier xcd_barrier_post(unsigned* bar, volatile LAS unsigned* st, int wave) {
    XcdBarrier b; b.bar = bar; b.x = xb_xcc_id(); b.st = st;
    if (wave == 0 && lane_id() == 0) st[2] = xb_add(&bar[XB_XCNT(b.x)], 1u);
    return b;
}
__device__ __forceinline__ void xcd_topology(const XcdBarrier& b, int wave) {
    if (wave == 0 && lane_id() == 0) {
        unsigned nx = 0u, ok = 1u, xi = 0u;
#pragma unroll
        for (unsigned j = 0; j < 16; ++j) { const unsigned c = xb_ld(&b.bar[XB_XCNT(j)]); if (c) { ++nx; if (c != 32u) ok = 0u; if (j < b.x) ++xi; } }
        if (nx != 8u || gridDim.x != 256u) ok = 0u;
        b.st[3] = ok; b.st[4] = xi;
    }
    __syncthreads();
}
__device__ __forceinline__ void xcd_local_barrier(const XcdBarrier& b, int wave, int grp) {
    asm volatile("s_waitcnt vmcnt(0)" ::: "memory");
    __syncthreads();
    if (wave == 0 && lane_id() == 0) {
        unsigned* c = &b.bar[XB_LSUB(4 * b.x + grp)];
        const unsigned target = b.st[6] + 8u; b.st[6] = target;
        (void)xb_add(c, 1u);
#if X_EARLYINV
        asm volatile("buffer_inv sc1" ::: "memory");
        XB_SPIN(xb_ld(c) < target, b.bar);
#else
        XB_SPIN(xb_ld(c) < target, b.bar);
        __builtin_amdgcn_fence(__ATOMIC_ACQUIRE, "agent");
#endif
        asm volatile("s_waitcnt vmcnt(0)" ::: "memory");
    }
    __syncthreads();
}
__device__ __forceinline__ void xcd_barrier_complete(unsigned* bar, unsigned x, unsigned& nloc, unsigned& nx) {
    const unsigned G = gridDim.x * gridDim.y * gridDim.z;
    unsigned sum, cnt, mine, sp = 0u;
    for (;;) {
        sum = 0u; cnt = 0u; mine = 0u;
#pragma unroll
        for (unsigned j = 0; j < 16; ++j) { const unsigned c = xb_ld(&bar[XB_XCNT(j)]); sum += c; cnt += (c > 0u) ? 1u : 0u; mine = (j == x) ? c : mine; }
        if (sum == G) break;
        __builtin_amdgcn_s_sleep(1);
        if ((++sp & 255u) == 0u) { if (xb_ld(&bar[XB_TMO])) break; if (sp > XB_SPIN_CAP) { atomicAdd(&bar[XB_TMO], 1u); break; } }
    }
    nloc = mine > 0u ? mine : 1u; nx = cnt > 0u ? cnt : 1u;
}
__device__ __forceinline__ void xcd_barrier(const XcdBarrier& b, int wave) {
    asm volatile("s_waitcnt vmcnt(0)" ::: "memory");
    __syncthreads();
    if (wave == 0 && lane_id() == 0) {
        unsigned* bar = b.bar;
        __builtin_amdgcn_s_waitcnt(0);
        unsigned nloc = b.st[0], nx = b.st[1];
        if (nloc == 0u) { xcd_barrier_complete(bar, b.x, nloc, nx); b.st[0] = nloc; b.st[1] = nx; }
        const unsigned old = xb_add(&bar[XB_XSUB(b.x)], 1u);
        const unsigned gen = old / nloc;
        if (old + 1u == (gen + 1u) * nloc) {
            __builtin_amdgcn_fence(__ATOMIC_RELEASE, "agent");
            asm volatile("s_waitcnt vmcnt(0)" ::: "memory");
            const unsigned og = xb_add(&bar[XB_TOP], 1u);
            const unsigned tg = og / nx;
            if (og + 1u == (tg + 1u) * nx) xb_add(&bar[XB_TOPGEN], 1u);
            else XB_SPIN(xb_ld(&bar[XB_TOPGEN]) == tg, bar);
            __builtin_amdgcn_fence(__ATOMIC_ACQUIRE, "agent");
            xb_add(&bar[XB_XGEN(b.x)], 1u);
            asm volatile("s_waitcnt vmcnt(0)" ::: "memory");
        } else {
#if X_EARLYINV
            asm volatile("buffer_inv sc1" ::: "memory");
            XB_SPIN(xb_ld(&bar[XB_XGEN(b.x)]) == gen, bar);
#else
            XB_SPIN(xb_ld(&bar[XB_XGEN(b.x)]) == gen, bar);
            __builtin_amdgcn_fence(__ATOMIC_ACQUIRE, "agent");
#endif
            asm volatile("s_waitcnt vmcnt(0)" ::: "memory");
        }
    }
    __syncthreads();
}

__device__ __forceinline__ int tr_dloc(int kind, int c) { return kind == 1 ? (2 * (c & 31) + (c >> 5)) : c; }
__device__ __forceinline__ void tr_item64(const float* W, int ldw, int K, bf16_t* WT, int kind, const float* gain, float cscale, LAS unsigned char* scr, int kb, int s0, int dbase, int lane) {
    const int k0 = 64 * kb, nb = lane & 15, kq = lane >> 4;
    f32x4 v[4][4];
#pragma unroll
    for (int i = 0; i < 4; ++i)
#pragma unroll
        for (int j = 0; j < 4; ++j) v[i][j] = __builtin_nontemporal_load((const GAS f32x4*)(W + (size_t)(k0 + 4 * (kq + 4 * i) + j) * ldw + s0 + 4 * nb));
#pragma unroll
    for (int i = 0; i < 4; ++i) {
        const int kk = 4 * (kq + 4 * i);
        f32x4 g = (f32x4){cscale, cscale, cscale, cscale};
        if (gain) g = *(const GAS f32x4*)(gain + k0 + kk) * cscale;
#pragma unroll
        for (int e = 0; e < 4; ++e) {
            u32x2 w; w.x = cvt_pk_bf16(v[i][0][e] * g[0], v[i][1][e] * g[1]); w.y = cvt_pk_bf16(v[i][2][e] * g[2], v[i][3][e] * g[3]);
            *(LAS u32x2*)(scr + tr_dloc(kind, 4 * nb + e) * 144 + kk * 2) = w;
        }
    }
    LDS_WAIT(); asm volatile("" ::: "memory");
#pragma unroll
    for (int i = 0; i < 8; ++i) { const int n = (lane >> 3) + 8 * i, ch = lane & 7;
        const u32x4 o = *(const LAS u32x4*)(scr + n * 144 + ch * 16);
        *(GAS u32x4*)(WT + (size_t)(dbase + n) * K + k0 + 8 * ch) = o; }
    LDS_WAIT(); asm volatile("" ::: "memory");
}
__device__ __forceinline__ float wave_sum(float v, int lane) {
#pragma unroll
    for (int o = 1; o < 64; o <<= 1) v += shx(v, o, lane);
    return v;
}

#ifndef X_NADEAD
#define X_NADEAD 1
#endif
#ifndef X_REVL
#define X_REVL 0
#endif
#ifndef X_ATT16
#define X_ATT16 3
#endif
#ifndef X_CLKPROBE
#define X_CLKPROBE 0
#endif
#ifndef X_CLKQ
#define X_CLKQ 250.0f
#endif
#ifndef X_CLKUS
#define X_CLKUS 0
#endif
#ifndef X_CLKBLK
#define X_CLKBLK 0
#endif
struct Args { const float* in[23]; float* xres; float* out; unsigned char* ws; int ph_lo, ph_hi, nl, l_lo, l_hi, sub_lo, sub_hi, region; };

__global__ void __launch_bounds__(NWAVES * 64, 2) mk_fwd(Args args_unused) {
    (void)args_unused;
    typedef const __attribute__((address_space(4))) Args* KArgP;
    const KArgP ka0 = (KArgP)__builtin_amdgcn_kernarg_segment_ptr();
#define KA() ({ KArgP k_ = ka0; asm volatile("" : "+s"(k_)); k_; })

    extern __shared__ __attribute__((aligned(16))) unsigned char lds_raw[];
    LAS unsigned char* lds = (LAS unsigned char*)lds_raw;
    LAS unsigned char* ex = lds + EX_OFF;
    volatile LAS unsigned* MISC = (volatile LAS unsigned*)(lds + MISC_OFF);
    const int wave = __builtin_amdgcn_readfirstlane(threadIdx.x >> 6);
    const int G = gridDim.x, bx = blockIdx.x;
    const int vcu = (G % 8 == 0) ? (bx % 8) * (G / 8) + bx / 8 : bx;
    gu32* ctl = (gu32*)(KA()->ws + WS_CTL);
    for (int u = wave * 64 + lane_id(); u < (LDS_BYTES - MISC_OFF) / 4; u += NWAVES * 64) ((LAS unsigned*)(lds + MISC_OFF))[u] = 0u;
    __syncthreads();
    XcdBarrier bar = xcd_barrier_post((unsigned*)(ctl + CW_BAR) + KA()->region * XCD_BAR_WORDS, MISC + 8, wave);
    const int lo = KA()->ph_lo, hi = KA()->ph_hi;
#define IN(k) (lo <= (k) && (k) < hi)
#define GRID_BAR() xcd_barrier(bar, wave)
#define SEAM(local_ok) do { if (xmode && (local_ok)) xcd_local_barrier(bar, wave, xrank & 3); else xcd_barrier(bar, wave); } while (0)
#define PHASE_PTRS() unsigned char* ws = KA()->ws; asm volatile("" : "+s"(ws)); \
    float* ssq_x = (float*)(ws + WS_SSQX); float* ssq_c = (float*)(ws + WS_SSQC); float* ssq_y = (float*)(ws + WS_SSQY); \
    float* ctab = (float*)(ws + WS_CTAB); float* stab = (float*)(ws + WS_STAB); \
    bf16_t* XB = (bf16_t*)(ws + WS_XB); bf16_t* PROJ = (bf16_t*)(ws + WS_PROJ); bf16_t* QM = (bf16_t*)(ws + WS_QM); bf16_t* KNVM = (bf16_t*)(ws + WS_KNVM); \
    bf16_t* Y = (bf16_t*)(ws + WS_Y); bf16_t* P = (bf16_t*)(ws + WS_P); bf16_t* H = (bf16_t*)(ws + WS_H); \
    (void)ssq_x; (void)ssq_c; (void)ssq_y; (void)ctab; (void)stab; (void)XB; (void)PROJ; (void)QM; (void)KNVM; (void)Y; (void)P; (void)H
#define LAYER_PTRS() PHASE_PTRS(); int l = l0; asm volatile("" : "+s"(l)); unsigned char* wl = ws + WS_W + (size_t)l * W_LAYER; (void)wl
    const int gw = vcu * NWAVES + wave, NGW = G * NWAVES;
    const int nl = KA()->nl;

    for (int rep0_ = 0; rep0_ < (X_REP0 ? 2 : 1); ++rep0_) {
    constexpr int I_IN = 32 * 61, I_UQ = 8 * 24, I_UKV = 4 * 32, I_SQ = 32 * 32, I_G = 32 * 88, I_DN = 88 * 32;
    constexpr int I_LAYER = I_IN + I_UQ + I_UKV + 4 * I_SQ + 2 * I_G + I_DN, I_XKV0 = I_IN + I_UQ + I_UKV + I_SQ;
    if (IN(0)) {
        PHASE_PTRS();
        const int lane = lane_id(), tid = wave * 64 + lane; (void)tid;
        LAS unsigned char* scr = lds + wave * 16384;
#define IT_W0 gw
#define IT_NW NGW
#define IT_N (2 * I_SQ)
#define IT_LO I_XKV0
        for (int it = IT_W0; it < nl * IT_N; it += IT_NW) {
            const int l = it / IT_N; int r = (it % IT_N) + IT_LO;
            unsigned char* wl = ws + WS_W + (size_t)l * W_LAYER; unsigned char* tl = ws + WS_TMP + (size_t)l * T_LAYER;
            if (r < I_IN) { const int kb = r / 61, sb = r % 61;
                tr_item64(KA()->in[3] + (size_t)l * DM * 3904, 3904, DM, (bf16_t*)(wl + WL_IN), sb == 60 ? 1 : 0, KA()->in[2] + l * DM, sb < 16 ? QSC_NA : 1.0f, scr, kb, 64 * sb, 64 * sb, lane); continue; } r -= I_IN;
            if (r < I_UQ) { const int kb = r / 24, sb = r % 24, h = sb / 3, p = sb % 3;
                tr_item64(KA()->in[6] + (size_t)l * 512 * 1536, 1536, 512, (bf16_t*)(wl + WL_UQ), p == 2 ? 1 : 0, KA()->in[4] + l * 512, QSC_MLA, scr, kb, 64 * sb, p == 2 ? 1024 + 64 * h : 128 * h + 64 * p, lane); continue; } r -= I_UQ;
            if (r < I_UKV) { const int kb = r / 32, sb = r % 32, h = sb >> 2, p = sb & 3;
                tr_item64(KA()->in[7] + (size_t)l * 256 * 2048, 2048, 256, (bf16_t*)(wl + WL_UKV), 0, KA()->in[5] + l * 256, 1.0f, scr, kb, 64 * sb, (p >> 1) * 1024 + 128 * h + 64 * (p & 1), lane); continue; } r -= I_UKV;
            if (r < I_SQ) { const int kb = r / 32, sb = r % 32;
                const float* gn = (kb < 16) ? (KA()->in[9] + l * 1024) : (KA()->in[10] + l * 1024 - 1024);
                tr_item64(KA()->in[11] + (size_t)l * DM * DM, DM, DM, (bf16_t*)(wl + WL_OUT), 0, gn, 1.0f, scr, kb, 64 * sb, 64 * sb, lane); continue; } r -= I_SQ;
            if (r < I_SQ) { tr_item64(KA()->in[15] + (size_t)l * DM * DM, DM, DM, (bf16_t*)(tl + TL_XKV), 0, nullptr, 1.0f, scr, r / 32, 64 * (r % 32), 64 * (r % 32), lane); continue; } r -= I_SQ;
            if (r < I_SQ) { tr_item64(KA()->in[16] + (size_t)l * DM * DM, DM, DM, (bf16_t*)(tl + TL_XKV) + (size_t)DM * DM, 0, nullptr, 1.0f, scr, r / 32, 64 * (r % 32), 64 * (r % 32), lane); continue; } r -= I_SQ;
            if (r < I_SQ) { tr_item64(KA()->in[17] + (size_t)l * DM * DM, DM, DM, (bf16_t*)(tl + TL_XO), 0, nullptr, 1.0f, scr, r / 32, 64 * (r % 32), 64 * (r % 32), lane); continue; } r -= I_SQ;
            if (r < 2 * I_G) {
                const int up = r >= I_G; const int q = up ? r - I_G : r; const int kb = q / 88, sb = q % 88;
                tr_item64((up ? KA()->in[20] : KA()->in[19]) + (size_t)l * DM * DFF, DFF, DM, (bf16_t*)(wl + WL_GU), 0, KA()->in[18] + l * DM, 1.0f, scr, kb, 64 * sb, 256 * (sb >> 1) + 128 * up + 64 * (sb & 1), lane); continue; } r -= 2 * I_G;
            tr_item64(KA()->in[21] + (size_t)l * DFF * DM, DM, DFF, (bf16_t*)(wl + WL_DN), 0, nullptr, 1.0f, scr, r / 32, 64 * (r % 32), 64 * (r % 32), lane);
        }

#undef IT_W0
#undef IT_NW
#undef IT_N
#undef IT_LO
        for (int m = gw; m < nl * 256; m += NGW) {
            const int l = m >> 8, row = m & 255;
            const GAS f32x4* xr = (const GAS f32x4*)(KA()->in[1] + (size_t)row * DM) + lane; const GAS f32x4* gr = (const GAS f32x4*)(KA()->in[13] + (size_t)l * DM) + lane;
            f32x4 v[8]; float q = 0.f;
#pragma unroll
            for (int j = 0; j < 8; ++j) { v[j] = xr[64 * j]; q += (v[j][0] * v[j][0] + v[j][1] * v[j][1]) + (v[j][2] * v[j][2] + v[j][3] * v[j][3]); }
            const float rstd = 1.0f / sqrtf(wave_sum(q, lane) * (1.0f / DM) + EPS);
            bf16_t* o = (bf16_t*)(ws + WS_TMP + (size_t)l * T_LAYER + TL_MEMN) + (size_t)row * DM;
#pragma unroll
            for (int j = 0; j < 8; ++j) { const f32x4 gv = gr[64 * j]; u32x2 w; w.x = cvt_pk_bf16(v[j][0] * rstd * gv[0], v[j][1] * rstd * gv[1]); w.y = cvt_pk_bf16(v[j][2] * rstd * gv[2], v[j][3] * rstd * gv[3]);
                *(GAS u32x2*)(o + j * 256 + lane * 4) = w; }
        }
        if (IN(1) || X_REP0) GRID_BAR();
    }
    if (IN(1)) {
        PHASE_PTRS();
        const int nP1 = 16 * nl, split = (G >= 2 * nP1);
        if (bx < nP1 || !split) {
            Gemm g{(const bf16_t*)(ws + WS_TMP + TL_MEMN), (const bf16_t*)(ws + WS_TMP + TL_XKV), DM, DM, DM, (long)(T_LAYER / 2), (long)(T_LAYER / 2)};
            GridOrder So; So.init(1, 16, nl, G, bx);
            EpiRow<0> E{(bf16_t*)(ws + WS_TMP + TL_KVMEM), 4096, (long)(T_LAYER / 2), nullptr, 0, 0.f, 1 << 30, 0, nullptr, nullptr, nullptr, 0, 0};
            gemm_phase<EpiRow<0>, GridOrder>(lds, ex, g, So, E, wave);
        }
        if (bx >= nP1 || !split) {
        const int lane = lane_id(), tid = wave * 64 + lane;
        LAS unsigned char* scr = lds + wave * 16384;
        const int cb = split ? bx - nP1 : bx, NCB = split ? G - nP1 : G;
        const int gwc = cb * NWAVES + wave, NGWC = NCB * NWAVES;
#define IT_W0 gwc
#define IT_NW NGWC
#define IT_N (I_LAYER - 2 * I_SQ)
#define IT_LO 0
        for (int it = IT_W0; it < nl * IT_N; it += IT_NW) {
            const int l = X_REVL ? nl - 1 - it / IT_N : it / IT_N; int r = (it % IT_N) + IT_LO; if (r >= I_XKV0) r += 2 * I_SQ;
            unsigned char* wl = ws + WS_W + (size_t)l * W_LAYER; unsigned char* tl = ws + WS_TMP + (size_t)l * T_LAYER;
            if (r < I_IN) { const int kb = r / 61, sb = r % 61;
                tr_item64(KA()->in[3] + (size_t)l * DM * 3904, 3904, DM, (bf16_t*)(wl + WL_IN), sb == 60 ? 1 : 0, KA()->in[2] + l * DM, sb < 16 ? QSC_NA : 1.0f, scr, kb, 64 * sb, 64 * sb, lane); continue; } r -= I_IN;
            if (r < I_UQ) { const int kb = r / 24, sb = r % 24, h = sb / 3, p = sb % 3;
                tr_item64(KA()->in[6] + (size_t)l * 512 * 1536, 1536, 512, (bf16_t*)(wl + WL_UQ), p == 2 ? 1 : 0, KA()->in[4] + l * 512, QSC_MLA, scr, kb, 64 * sb, p == 2 ? 1024 + 64 * h : 128 * h + 64 * p, lane); continue; } r -= I_UQ;
            if (r < I_UKV) { const int kb = r / 32, sb = r % 32, h = sb >> 2, p = sb & 3;
                tr_item64(KA()->in[7] + (size_t)l * 256 * 2048, 2048, 256, (bf16_t*)(wl + WL_UKV), 0, KA()->in[5] + l * 256, 1.0f, scr, kb, 64 * sb, (p >> 1) * 1024 + 128 * h + 64 * (p & 1), lane); continue; } r -= I_UKV;
            if (r < I_SQ) { const int kb = r / 32, sb = r % 32;
                const float* gn = (kb < 16) ? (KA()->in[9] + l * 1024) : (KA()->in[10] + l * 1024 - 1024);
                tr_item64(KA()->in[11] + (size_t)l * DM * DM, DM, DM, (bf16_t*)(wl + WL_OUT), 0, gn, 1.0f, scr, kb, 64 * sb, 64 * sb, lane); continue; } r -= I_SQ;
            if (r < I_SQ) { tr_item64(KA()->in[15] + (size_t)l * DM * DM, DM, DM, (bf16_t*)(tl + TL_XKV), 0, nullptr, 1.0f, scr, r / 32, 64 * (r % 32), 64 * (r % 32), lane); continue; } r -= I_SQ;
            if (r < I_SQ) { tr_item64(KA()->in[16] + (size_t)l * DM * DM, DM, DM, (bf16_t*)(tl + TL_XKV) + (size_t)DM * DM, 0, nullptr, 1.0f, scr, r / 32, 64 * (r % 32), 64 * (r % 32), lane); continue; } r -= I_SQ;
            if (r < I_SQ) { tr_item64(KA()->in[17] + (size_t)l * DM * DM, DM, DM, (bf16_t*)(tl + TL_XO), 0, nullptr, 1.0f, scr, r / 32, 64 * (r % 32), 64 * (r % 32), lane); continue; } r -= I_SQ;
            if (r < 2 * I_G) {
                const int up = r >= I_G; const int q = up ? r - I_G : r; const int kb = q / 88, sb = q % 88;
                tr_item64((up ? KA()->in[20] : KA()->in[19]) + (size_t)l * DM * DFF, DFF, DM, (bf16_t*)(wl + WL_GU), 0, KA()->in[18] + l * DM, 1.0f, scr, kb, 64 * sb, 256 * (sb >> 1) + 128 * up + 64 * (sb & 1), lane); continue; } r -= 2 * I_G;
            tr_item64(KA()->in[21] + (size_t)l * DFF * DM, DM, DFF, (bf16_t*)(wl + WL_DN), 0, nullptr, 1.0f, scr, r / 32, 64 * (r % 32), 64 * (r % 32), lane);
        }

#undef IT_W0
#undef IT_NW
#undef IT_N
#undef IT_LO
        for (size_t i = (size_t)(cb * (NWAVES * 64) + tid); i < (size_t)nl * 192 * DM / 8; i += (size_t)NCB * NWAVES * 64) {
            const int l = (int)(i / (192 * DM / 8)); const size_t e = (i % (192 * DM / 8)) * 8;
            *(GAS u32x4*)((bf16_t*)(ws + WS_W + (size_t)l * W_LAYER + WL_IN) + (size_t)3904 * DM + e) = (u32x4){0u, 0u, 0u, 0u};
        }
        for (size_t i = (size_t)(cb * (NWAVES * 64) + tid); i < (size_t)nl * DM * DM / 8; i += (size_t)NCB * NWAVES * 64) {
            const int l = (int)(i / ((size_t)DM * DM / 8)); const size_t e = (i % ((size_t)DM * DM / 8)) * 8; const int k = (int)(e / DM);
            const float gsc = ((const GAS float*)KA()->in[12])[l * DM + k] * QSC_X;
            const f32x4 a = *(const GAS f32x4*)(KA()->in[14] + (size_t)l * DM * DM + e), b = *(const GAS f32x4*)(KA()->in[14] + (size_t)l * DM * DM + e + 4);
            *(GAS u32x4*)((bf16_t*)(ws + WS_TMP + (size_t)l * T_LAYER + TL_XQ) + e) = pack8(a * gsc, b * gsc);
        }
        for (int m = gwc; m < S; m += NGWC) {
            const GAS f32x4* xr = (const GAS f32x4*)(KA()->in[0] + (size_t)m * DM) + lane;
#pragma unroll
            for (int j = 0; j < 8; ++j) { const f32x4 v = xr[64 * j];
                float q = (v[0] * v[0] + v[1] * v[1]) + (v[2] * v[2] + v[3] * v[3]);
                q += shx(q, 1, lane); q += shx(q, 2, lane); q += shx(q, 4, lane); q += shx(q, 8, lane);
                if ((lane & 15) == 0) ((GAS float*)ssq_x)[(size_t)m * 32 + j * 4 + (lane >> 4)] = q;
                u32x2 w; w.x = cvt_pk_bf16(v[0], v[1]); w.y = cvt_pk_bf16(v[2], v[3]);
                *(GAS u32x2*)(XB + (size_t)m * DM + j * 256 + lane * 4) = w; }
        }
        for (int idx = cb * (NWAVES * 64) + tid; idx < S * 32; idx += NCB * NWAVES * 64) {
            const int pos = idx >> 5, j = idx & 31;
            const float inv = (float)exp2(-(double)j * (13.287712379549449 / 32.0));
            const float ang = (float)pos * inv;
            const double a = (double)ang;
            const double n = rint(a * 0.63661977236758134);
            const double r = fma(-n, 1.5707963267948966, a) - n * 6.123233995736766e-17;
            const int qd = (int)((long long)n & 3);
            const float rf = (float)r, z = rf * rf;
            const float sn = rf + rf * z * (-1.6666654611e-1f + z * (8.3321608736e-3f + z * -1.9515295891e-4f));
            const float cn = 1.0f - 0.5f * z + z * z * (4.166664568298827e-2f + z * (-1.388731625493765e-3f + z * 2.443315711809948e-5f));
            float c, s;
            if (qd == 0) { s = sn; c = cn; } else if (qd == 1) { s = cn; c = -sn; } else if (qd == 2) { s = -sn; c = -cn; } else { s = -cn; c = sn; }
            ((GAS float*)ctab)[idx] = c; ((GAS float*)stab)[idx] = s;
        }
        }
        if (IN(2)) GRID_BAR();
    }
    }
    if (IN(2)) {
        for (int l0 = 0; l0 < nl; ++l0) {
            LAYER_PTRS(); unsigned char* tl = ws + WS_TMP + (size_t)l * T_LAYER;
            { Gemm g{(const bf16_t*)(tl + TL_KVMEM), (const bf16_t*)(tl + TL_XQ), 4096, DM, 512, 512, 512};
              GridOrder So; So.init(1, 8, 4, G, (bx + G - ((l * 64) % G)) % G);
              EpiRow<0> E{(bf16_t*)(wl + WL_QK), DM, (long)256 * DM, nullptr, 0, 0.f, 1 << 30, 0, nullptr, nullptr, nullptr, 0, 0};
              gemm_phase<EpiRow<0>, GridOrder>(lds, ex, g, So, E, wave); }
            { Gemm g{(const bf16_t*)(tl + TL_XO), (const bf16_t*)(tl + TL_KVMEM) + 2048, DM, 4096, 512, 512, 512};
              GridOrder So; So.init(8, 1, 4, G, (bx + G - ((l * 64 + 32) % G)) % G);
              EpiRow<0> E{(bf16_t*)(wl + WL_VO), 1024, 256, nullptr, 0, 0.f, 1 << 30, 0, nullptr, nullptr, nullptr, 0, 0};
              gemm_phase<EpiRow<0>, GridOrder>(lds, ex, g, So, E, wave); }
        }
    }
    if (IN(3)) {
        const int slo = KA()->sub_lo, shi = KA()->sub_hi;
#define SUB(k) (slo <= (k) && (k) < shi)
        GRID_BAR();
        xcd_topology(bar, wave);
        const int xmode = X_XCDLOCAL ? (int)__builtin_amdgcn_readfirstlane((int)MISC[11]) : 0, xidx = (int)__builtin_amdgcn_readfirstlane((int)MISC[12]), xrank = (int)__builtin_amdgcn_readfirstlane((int)MISC[10]);
#if X_REQUIRE_XMODE
        if (!xmode) return;
#endif
#define ORDER(So, nN_) do { if (xmode) So.init_x(nN_, xidx, xrank); else So.init(S / BM, nN_, 1, G, bx); } while (0)
        for (int l0 = KA()->l_lo; l0 < KA()->l_hi; ++l0) {
            for (int rep_ = 0; rep_ < (X_REPG ? 2 : XREP(0)); ++rep_)
            if (SUB(0)) { LAYER_PTRS();
                Gemm g{XB, (const bf16_t*)(wl + WL_IN), DM, DM, DM, 0, 0};
                GridOrder So; ORDER(So, NPROJ / BM);
                EpiRow<8> E{PROJ, NPROJ, 0, ssq_x, 32, 1.0f / DM, 15, 0, ctab, stab, ssq_c, 12, 15};
                gemm_phase<EpiRow<8>, GridOrder>(lds, ex, g, So, E, wave);
                SEAM(true);
            }
            for (int rep_ = 0; rep_ < (X_REPG ? 2 : XREP(1)); ++rep_)
            if (SUB(1)) { LAYER_PTRS();
                { Gemm g{PROJ + 3072, (const bf16_t*)(wl + WL_UQ), NPROJ, 512, 512, 0, 0};
                  GridOrder So; ORDER(So, 6);
                  EpiRow<2> E{QM, 1536, 0, ssq_c, 16, 1.0f / 512.0f, 4, 1, ctab, stab, nullptr, 0, 0};
                  gemm_phase<EpiRow<2>, GridOrder>(lds, ex, g, So, E, wave); }
                { Gemm g{PROJ + 3584, (const bf16_t*)(wl + WL_UKV), NPROJ, 256, 256, 0, 0};
                  GridOrder So; if (xmode) So.init_x(8, xidx, (xrank + 8) & 31); else So.init(S / BM, 8, 1, G, (bx + G - (192 % G)) % G);
                  EpiRow<1> E{KNVM, 2048, 0, ssq_c + 8, 16, 1.0f / 256.0f, 1 << 30, 0, nullptr, nullptr, nullptr, 0, 0};
                  gemm_phase<EpiRow<1>, GridOrder>(lds, ex, g, So, E, wave); }
                GRID_BAR();
            }
            for (int rep_ = 0; rep_ < ((X_REPATT || (X_REPMASK & 0x304)) ? 2 : 1); ++rep_)
            if (SUB(2)) { LAYER_PTRS();
#if X_CLKPROBE == 2
                const unsigned long long pt0 = __builtin_readcyclecounter(), pr0 = __builtin_amdgcn_s_memrealtime();
#endif
                if (!(X_REPMASK & 0x300) || rep_ == 1 || (X_REPMASK & 0x200))
                for (int u0 = bx; u0 < 256; u0 += G) {
                    const int u = (xmode && X_ATTLOCAL) ? ((4 * xidx + (xrank & 3)) * 8 + (xrank >> 2)) : u0;
                    const int h = u & 7, qb = u >> 3; const size_t row0 = (size_t)qb * 256;
                    att::AttnArgs a{QM + row0 * 1536 + h * 128, QM + row0 * 1536 + 1024 + h * 64, KNVM + h * 128, PROJ + 3840, KNVM + 1024 + h * 128,
                                    Y + row0 * DM + 1024 + h * 128, ssq_y + row0 * 16 + 8 + h, S / 64, 0, 0, nullptr};
                    if (X_ATT16 & 1) att::attn_unit16<0, -1>(a, (LAS char*)lds, wave); else att::attn_unit<0>(a, (LAS char*)lds, wave);
                }
#if X_CLKPROBE == 2
                { const unsigned long long pt1 = __builtin_readcyclecounter(), pr1 = __builtin_amdgcn_s_memrealtime();
                  if (bx == X_CLKBLK && wave == 0 && lane_id() == 0) *(GAS float*)(ws + 60000) = ((X_CLKUS ? (float)(pr1 - pr0) * 0.01f : (float)(pt1 - pt0) / (float)(pr1 - pr0) * 100.f) > X_CLKQ) ? 1000.f : 0.f; }
#endif
                if (!(X_REPMASK & 0x300) || rep_ == 1 || (X_REPMASK & 0x100))
                for (int u0 = bx; u0 < 256; u0 += G) {
                    const int u = (xmode && X_ATTLOCAL) ? ((4 * xidx + (xrank & 3)) * 8 + (xrank >> 2)) : u0;
                    const int h = u & 7, rg = u >> 3, rq0 = 4 * rg; int t0 = rq0 - 4; t0 = t0 < 0 ? 0 : (t0 > 116 ? 116 : t0);
                    const size_t row0 = (size_t)rq0 * 64, key0 = (size_t)t0 * 64;
                    att::AttnArgs a{PROJ + row0 * NPROJ + h * 128, nullptr, PROJ + key0 * NPROJ + 1024 + h * 128, nullptr, PROJ + key0 * NPROJ + 2048 + h * 128,
                                    Y + row0 * DM + h * 128, ssq_y + row0 * 16 + h, 12, rq0, t0, KA()->in[8] + ((size_t)l * 8 + h) * 15 * 31};
                    if (X_ATT16 & 2) { if (X_NADEAD) { if (wave & 1) att::attn_unit16<1, 1>(a, (LAS char*)lds, wave); else att::attn_unit16<1, 0>(a, (LAS char*)lds, wave); } else att::attn_unit16<1, -1>(a, (LAS char*)lds, wave); } else att::attn_unit<1>(a, (LAS char*)lds, wave);
                }
                SEAM(X_ATTLOCAL);
            }
            for (int rep_ = 0; rep_ < XREP(3); ++rep_)
            if (SUB(3)) { LAYER_PTRS(); const bool dummy_ = (rep_ + 1 < XREP(3));
                Gemm g{Y, (const bf16_t*)(wl + WL_OUT), DM, DM, DM, 0, 0};
                GridOrder So; ORDER(So, DM / BM);
                EpiRes<true> E{(l == 0) ? KA()->in[0] : nullptr, XB, dummy_ ? QM : XB, dummy_ ? (float*)KNVM : ssq_x, ssq_y};
                gemm_phase<EpiRes<true>, GridOrder>(lds, ex, g, So, E, wave);
                SEAM(true);
            }
            for (int rep_ = 0; rep_ < (X_REPG ? 2 : XREP(4)); ++rep_)
            if (SUB(4)) { LAYER_PTRS();
                Gemm g{XB, (const bf16_t*)(wl + WL_QK), DM, DM, DM, 0, 0};
                if (xmode && X_BM128) {
                    OneUnit So{2 * (4 * xidx + (xrank & 3)) + ((xrank >> 2) & 1), xrank >> 3, 1};
                    EpiSoftmaxT<1> E{P, ssq_x};
                    gemm_phase128<EpiSoftmaxT<1>, OneUnit>(lds, ex, g, So, E, wave);
                } else {
                GridOrder So; ORDER(So, 4);
                EpiSoftmax E{P, ssq_x};
                gemm_phase<EpiSoftmax, GridOrder>(lds, ex, g, So, E, wave);
                }
                SEAM(true);
            }
            for (int rep_ = 0; rep_ < XREP(5); ++rep_)
            if (SUB(5)) { LAYER_PTRS(); const bool dummy_ = (rep_ + 1 < XREP(5));
                Gemm g{P, (const bf16_t*)(wl + WL_VO), 1024, 1024, (dummy_ && X_DUMMY_K) ? X_DUMMY_K : 1024, 0, 0};
                GridOrder So; ORDER(So, DM / BM);
                EpiRes<false> E{nullptr, XB, dummy_ ? QM : XB, dummy_ ? (float*)KNVM : ssq_x, nullptr};
                gemm_phase<EpiRes<false>, GridOrder>(lds, ex, g, So, E, wave, dummy_ && X_DUMMY_NOEPI);
                SEAM(true);
            }
            for (int rep_ = 0; rep_ < (X_REPG ? 2 : XREP(6)); ++rep_)
            if (SUB(6)) { LAYER_PTRS();
                Gemm g{XB, (const bf16_t*)(wl + WL_GU), DM, DM, DM, 0, 0};
                if (xmode && X_BM128) {
                    { GridOrder So; So.init_x(2 * DFF / BM, xidx, xrank, 160);
                      EpiSwiglu E{H, ssq_x};
                      gemm_phase<EpiSwiglu, GridOrder>(lds, ex, g, So, E, wave); }
                    { OneUnit So{2 * (4 * xidx + (xrank & 3)) + ((xrank >> 2) & 1), 40 + (xrank >> 3), 1};
                      EpiSwigluT<1> E{H, ssq_x, 1};
                      gemm_phase128<EpiSwigluT<1>, OneUnit>(lds, ex, g, So, E, wave); }
                } else {
                GridOrder So; ORDER(So, 2 * DFF / BM);
                EpiSwiglu E{H, ssq_x};
                gemm_phase<EpiSwiglu, GridOrder>(lds, ex, g, So, E, wave);
                }
                SEAM(true);
            }
            for (int rep_ = 0; rep_ < XREP(7); ++rep_)
            if (SUB(7)) { LAYER_PTRS(); const bool dummy_ = (rep_ + 1 < XREP(7));
                Gemm g{H, (const bf16_t*)(wl + WL_DN), DFF, DFF, DFF, 0, 0};
                GridOrder So; ORDER(So, DM / BM);
                EpiRes<false> E{nullptr, XB, dummy_ ? QM : XB, dummy_ ? (float*)KNVM : ssq_x, nullptr};
                gemm_phase<EpiRes<false>, GridOrder>(lds, ex, g, So, E, wave);
                SEAM(shi == 8 && slo == 0 && (l0 + 1 < KA()->l_hi || (X_LOCALFINAL && IN(4))));
            }
        }
#undef SUB
    }
    if (IN(4)) {
        PHASE_PTRS();
        const int lane = lane_id();
        const int xm4 = (X_LOCALFINAL && X_XCDLOCAL && IN(3)) ? (int)__builtin_amdgcn_readfirstlane((int)MISC[11]) : 0;
        const int xi4 = (int)__builtin_amdgcn_readfirstlane((int)MISC[12]), xr4 = (int)__builtin_amdgcn_readfirstlane((int)MISC[10]);
        const int m0 = xm4 ? (4 * xi4 + (xr4 & 3)) * 256 + (xr4 >> 2) * 32 + wave * 4 : gw, m1 = xm4 ? m0 + 4 : S, ms = xm4 ? 1 : NGW;
        for (int m = m0; m < m1; m += ms) {
            const GAS u32x4* xr = (const GAS u32x4*)(XB + (size_t)m * DM) + lane; const GAS f32x4* gr = (const GAS f32x4*)(KA()->in[22]);
            f32x4 v[8]; float q = 0.f;
#pragma unroll
            for (int j = 0; j < 4; ++j) { const u32x4 w = xr[64 * j]; v[2 * j] = (f32x4){bf_lo(w.x), bf_hi(w.x), bf_lo(w.y), bf_hi(w.y)}; v[2 * j + 1] = (f32x4){bf_lo(w.z), bf_hi(w.z), bf_lo(w.w), bf_hi(w.w)}; }
#pragma unroll
            for (int j = 0; j < 8; ++j) q += (v[j][0] * v[j][0] + v[j][1] * v[j][1]) + (v[j][2] * v[j][2] + v[j][3] * v[j][3]);
            const float rstd = 1.0f / sqrtf(wave_sum(q, lane) * (1.0f / DM) + EPS);
            float* o = KA()->out + (size_t)m * DM;
#pragma unroll
            for (int j = 0; j < 4; ++j) { const int c = j * 512 + lane * 8;
                *(GAS f32x4*)(o + c) = v[2 * j] * rstd * gr[c / 4]; *(GAS f32x4*)(o + c + 4) = v[2 * j + 1] * rstd * gr[c / 4 + 1]; }
#if X_CLKPROBE
            if (m == 0 && lane == 0) *(GAS float*)o = *(GAS float*)(ws + 60000);
#endif
        }
    }
#undef IN
#undef GRID_BAR
}
}
#ifndef MK_DEBUG
#define MK_DEBUG 0
#endif
static int mk_setup(int& grid) {
    static int g = 0;
    if (g == 0) {
        int dev = 0, cus = 0, per_cu = 0;
        if (hipGetDevice(&dev) != hipSuccess || hipDeviceGetAttribute(&cus, hipDeviceAttributeMultiprocessorCount, dev) != hipSuccess) { fprintf(stderr, "kernel_launch: device query failed\n"); g = -1; return g; }
        if (hipFuncSetAttribute((const void*)fk::mk_fwd, hipFuncAttributeMaxDynamicSharedMemorySize, fk::LDS_BYTES) != hipSuccess) { fprintf(stderr, "kernel_launch: hipFuncSetAttribute failed\n"); g = -1; return g; }
        if (hipOccupancyMaxActiveBlocksPerMultiprocessor(&per_cu, (const void*)fk::mk_fwd, fk::NWAVES * 64, fk::LDS_BYTES) != hipSuccess || per_cu < 1) { fprintf(stderr, "kernel_launch: occupancy query says %d blocks per CU\n", per_cu); }
        (void)hipGetLastError();
        g = cus;
#ifdef X_FORCE_GRID
        g = X_FORCE_GRID;
#endif
    }
    grid = g; return g;
}
#if MK_DEBUG
namespace dbg {
using namespace fk;
__global__ void cmp_k(int kind, const void* fast, const float* orc, int c0, int c1, double* acc) {
    const int row = blockIdx.x; double e = 0.0, r = 0.0;
    const bf16_t* fb = (const bf16_t*)fast; const float* ff = (const float*)fast;
    const int ncol = kind == 0 ? 2048 : kind == 1 ? 3904 : kind == 2 ? 1536 : kind == 3 ? 2048 : (c1 - c0);
    for (int c = threadIdx.x; c < ncol; c += 256) {
        float f, o;
        if (kind == 0) { f = ff[(size_t)row * 2048 + c]; o = orc[(size_t)row * 2048 + c]; }
        else if (kind == 1) { o = orc[(size_t)row * 3904 + c]; int fc = c; float sc = 1.f;
            if (c < 1024) sc = 1.0f / QSC_NA; else if (c >= 3840) { const int j = c - 3840; fc = 3840 + 2 * (j & 31) + (j >> 5); }
            f = __uint_as_float((unsigned)fb[(size_t)row * 4096 + fc] << 16) * sc; }
        else if (kind == 2) { o = orc[(size_t)row * 1536 + c]; const int h = c / 192, d = c % 192; int fc;
            if (d < 128) fc = h * 128 + d; else { const int j = d - 128; fc = 1024 + h * 64 + 2 * (j & 31) + (j >> 5); }
            f = __uint_as_float((unsigned)fb[(size_t)row * 1536 + fc] << 16) * (1.0f / QSC_MLA); }
        else if (kind == 3) { o = orc[(size_t)row * 2048 + c]; const int h = c / 256, d = c % 256; const int fc = d < 128 ? h * 128 + d : 1024 + h * 128 + (d - 128);
            f = __uint_as_float((unsigned)fb[(size_t)row * 2048 + fc] << 16); }
        else { o = orc[(size_t)row * 2048 + c0 + c]; f = __uint_as_float((unsigned)fb[(size_t)row * 2048 + c0 + c] << 16); }
        const double d = (double)f - (double)o; e += (f == f) ? d * d : 1e30; r += (double)o * (double)o;
    }
    for (int o = 32; o > 0; o >>= 1) { e += __shfl_xor(e, o); r += __shfl_xor(r, o); }
    if ((threadIdx.x & 63) == 0) { atomicAdd(acc, e); atomicAdd(acc + 1, r); }
}
__global__ void fin_k(const double* acc, int nstage, float thr, float* out) {
    if (threadIdx.x == 0 && blockIdx.x == 0) {
        int code = -1;
        for (int s = 0; s < nstage; ++s) { const double e = acc[2 * s], r = acc[2 * s + 1]; if (!(e <= (double)thr * r)) { code = s; break; } }
        if (code >= 0) out[0] += 100.0f * (float)(10 + code);
    }
}
}
#endif

extern "C" void kernel_launch(void* const* d_in, const int* in_sizes, int n_in, void* d_out, int out_size, void* d_ws, size_t ws_size, hipStream_t stream) {
    using namespace fk;
    int grid = 0;
    if (mk_setup(grid) <= 0) return;
    const size_t need = MK_DEBUG ? 1010 * MiB : WS_END;
    if (n_in != 23 || out_size != S * DM || ws_size < need) { fprintf(stderr, "kernel_launch: unexpected shapes n_in %d out %d ws %zu (need %zu)\n", n_in, out_size, ws_size, need); return; }
    unsigned char* ws = (unsigned char*)d_ws;
    if (hipMemsetAsync(ws + WS_CTL, 0, CTL_ZERO_BYTES, stream) != hipSuccess) { fprintf(stderr, "kernel_launch: memset failed\n"); return; }
    Args a{};
    for (int i = 0; i < 23; ++i) a.in[i] = (const float*)d_in[i];
    a.ws = ws;
#if !MK_DEBUG
    a.xres = (float*)d_out; a.out = (float*)d_out;
    a.ph_lo = 0; a.ph_hi = 5; a.nl = 4; a.l_lo = 0; a.l_hi = 4; a.sub_lo = 0; a.sub_hi = 8; a.region = 0;
    hipLaunchKernelGGL(mk_fwd, dim3(grid), dim3(NWAVES * 64), LDS_BYTES, stream, a);
    const hipError_t le = hipPeekAtLastError();
    if (le != hipSuccess) fprintf(stderr, "kernel_launch: launch failed: %s\n", hipGetErrorName(le));
#else
    constexpr int NLD = MK_DEBUG_NL;
    ref::Bufs b;
    b.x = (float*)d_out;
    b.proj = (float*)(ws + 210 * MiB); b.q = (float*)(ws + 338 * MiB);
    b.memn = (float*)(ws + 386 * MiB); b.kmem = (float*)(ws + 388 * MiB); b.vmem = (float*)(ws + 390 * MiB);
    b.ctab = (float*)(ws + 392 * MiB); b.stab = (float*)(ws + 393 * MiB);
    b.kv = (float*)(ws + 752 * MiB); b.y = (float*)(ws + 816 * MiB); b.h = (float*)(ws + 880 * MiB); b.Sb = b.h;
    float* xfast = (float*)(ws + 944 * MiB);
    double* acc = (double*)(ws + 1008 * MiB);
    hipMemsetAsync(acc, 0, 4096, stream);
    a.xres = xfast; a.out = xfast; a.nl = NLD;
    int region = 0;
    auto fast = [&](int plo, int phi, int l, int slo, int shi) { a.ph_lo = plo; a.ph_hi = phi; a.l_lo = l; a.l_hi = l + 1; a.sub_lo = slo; a.sub_hi = shi; a.region = region++;
        hipLaunchKernelGGL(mk_fwd, dim3(grid), dim3(NWAVES * 64), LDS_BYTES, stream, a); };
    int stage = 0;
    auto cmp = [&](int kind, const void* f, const float* o, int c0, int c1) { hipLaunchKernelGGL(dbg::cmp_k, dim3(S), dim3(256), 0, stream, kind, f, o, c0, c1, acc + 2 * stage); ++stage; };
    fast(0, 3, 0, 0, 0);
    hipMemcpyAsync(b.x, d_in[0], (size_t)S * DM * 4, hipMemcpyDeviceToDevice, stream);
    hipLaunchKernelGGL(ref::rope_table_k, dim3(S * 32 / 256), dim3(256), 0, stream, b.ctab, b.stab);
    for (int l = 0; l < 4; ++l) {
        if (l < NLD) {
#if MK_DEBUG == 2
            fast(3, 4, l, 0, 4);
#else
            for (int s = 0; s < 4; ++s) fast(3, 4, l, s, s + 1);
#endif
        }
        ref::mixer(stream, d_in, l, b);
        if (l < NLD) { cmp(1, ws + WS_PROJ, b.proj, 0, 0); cmp(2, ws + WS_QM, b.q, 0, 0); cmp(3, ws + WS_KNVM, b.kv, 0, 0); cmp(4, ws + WS_Y, b.y, 0, 1024); cmp(4, ws + WS_Y, b.y, 1024, 2048); }
        ref::mixer_out(stream, d_in, l, b);
        if (l < NLD) { cmp(0, xfast, b.x, 0, 0);
#if MK_DEBUG == 2
            fast(3, 4, l, 4, 6);
#else
            fast(3, 4, l, 4, 5); fast(3, 4, l, 5, 6);
#endif
        }
        ref::cross(stream, d_in, l, b);
        if (l < NLD) { cmp(0, xfast, b.x, 0, 0);
#if MK_DEBUG == 2
            fast(3, 4, l, 6, 8);
#else
            fast(3, 4, l, 6, 7); fast(3, 4, l, 7, 8);
#endif
        }
        ref::ffn(stream, d_in, l, b);
        if (l < NLD) cmp(0, xfast, b.x, 0, 0);
    }
    hipLaunchKernelGGL(ref::rmsnorm_k, dim3(S), dim3(256), 0, stream, b.x, DM, (const float*)d_in[22], b.x, DM, DM);
    hipLaunchKernelGGL(dbg::fin_k, dim3(1), dim3(64), 0, stream, (const double*)acc, stage, (float)MK_DEBUG_THR, (float*)d_out);
#endif
}
```

```cpp
#include <hip/hip_runtime.h>
#include <cstdio>
#include <cstdint>
#include <cmath>
#define X_PRIO47 1
#define LAS __attribute__((address_space(3)))
#define GAS __attribute__((address_space(1)))
typedef unsigned short bf16_t;
typedef short bf16x8 __attribute__((ext_vector_type(8)));
#ifndef X_NODUMMY
#define X_NODUMMY 0
#endif
typedef short s16x4 __attribute__((ext_vector_type(4)));
typedef float f32x2 __attribute__((ext_vector_type(2)));
typedef float f32x4 __attribute__((ext_vector_type(4)));
typedef float f32x16 __attribute__((ext_vector_type(16)));
typedef unsigned u32x2 __attribute__((ext_vector_type(2)));
typedef unsigned u32x4 __attribute__((ext_vector_type(4)));
typedef GAS unsigned gu32;

namespace fk {
constexpr int S = 8192, DM = 2048, NPROJ = 4096, DFF = 5632;
constexpr float EPS = 1e-6f;
constexpr float LOG2E = 1.4426950408889634f;
constexpr float QSC_NA = 0.08838834764831845f * LOG2E, QSC_MLA = 0.07216878364870323f * LOG2E, QSC_X = 0.04419417382415922f * LOG2E;

__device__ __forceinline__ int lane_id(int dep = 0) { unsigned z; asm volatile("s_mul_i32 %0, %1, 0" : "=s"(z) : "s"(dep)); return (int)__builtin_amdgcn_mbcnt_hi(~0u, __builtin_amdgcn_mbcnt_lo(~0u, z)); }
__device__ __forceinline__ float shi(float v, int src) { return __int_as_float(__builtin_amdgcn_ds_bpermute(src << 2, __float_as_int(v))); }
__device__ __forceinline__ float shx(float v, int mask, int lane) { return shi(v, lane ^ mask); }
typedef float f32x2_cv __attribute__((ext_vector_type(2))); typedef __bf16 bf16x2_cv __attribute__((ext_vector_type(2)));
__device__ __forceinline__ unsigned cvt_pk_bf16(float lo, float hi) { const f32x2_cv v = {lo, hi}; const bf16x2_cv b = __builtin_convertvector(v, bf16x2_cv); return __builtin_bit_cast(unsigned, b); }
__device__ __forceinline__ float bf_lo(unsigned w) { return __uint_as_float(w << 16); }
__device__ __forceinline__ float bf_hi(unsigned w) { return __uint_as_float(w & 0xffff0000u); }
__device__ __forceinline__ u32x4 pack8(f32x4 a, f32x4 b) { u32x4 w; w.x = cvt_pk_bf16(a[0], a[1]); w.y = cvt_pk_bf16(a[2], a[3]); w.z = cvt_pk_bf16(b[0], b[1]); w.w = cvt_pk_bf16(b[2], b[3]); return w; }

constexpr int BM = 256, BK = 64, HALF = 128, HTB = HALF * BK * 2, STAGE_BYTES = 8 * HTB, NXCD = 8, WGM = 8;
__host__ __device__ __forceinline__ int lds_byte(int r, int c) { const int st = (r >> 4) * 2 + (c >> 5), rr = r & 15, cc = c & 31, ob = rr * 64 + cc * 2; return st * 1024 + (ob ^ (((ob >> 9) & 1) << 5)); }
__host__ __device__ __forceinline__ void stage_rc(int b, int& R, int& C) { const int st = b / 1024, sb = b % 1024, swz = sb ^ (((sb >> 9) & 1) << 5); R = (st >> 1) * 16 + swz / 64; C = (st & 1) * 32 + (swz % 64) / 2; }
__host__ __device__ __forceinline__ int perm32(int rho) { const int n = rho >> 4, i = rho & 15; return 8 * (i >> 2) + 4 * n + (i & 3); }

struct Unit { int pm, pn, z; };
struct Gemm { const bf16_t* A; const bf16_t* Bt; int lda, ldb, K; long sAz, sBz; };

struct GridOrder {
    int nM, nN, nZ, nwg, G, c; int xm, xi;
    __device__ __forceinline__ void init(int nM_, int nN_, int nZ_, int G_, int c_) { nM = nM_; nN = nN_; nZ = nZ_; nwg = nM * nN * nZ; G = G_; c = c_; xm = 0; xi = 0; }
    __device__ __forceinline__ void init_x(int nN_, int xi_, int rank_, int nlim = 1 << 30) { nM = 32; nN = nN_; nZ = 1; nwg = 4 * nN_ < nlim ? 4 * nN_ : nlim; G = 32; c = rank_; xm = 1; xi = xi_; }
    __device__ __forceinline__ bool next(int i, Unit& u) const {
        const long L = (long)i * G + c; if (L >= nwg) return false;
        int wgid = (int)L, pm, pn, z;
        if (xm) { pm = 4 * xi + (wgid & 3); pn = wgid >> 2; z = 0; }
        else if (nZ == 1) {
            { const int q = nwg / NXCD, r = nwg % NXCD, xcd = wgid % NXCD, off = wgid / NXCD; wgid = (xcd < r ? xcd * (q + 1) : r * (q + 1) + (xcd - r) * q) + off; }
            const int nig = WGM * nN, gid = wgid / nig, fm = gid * WGM, gsz = (nM - fm) < WGM ? (nM - fm) : WGM;
            pm = fm + ((wgid % nig) % gsz); pn = (wgid % nig) / gsz; z = 0;
        } else { const int per = nM * nN; z = wgid / per; const int r = wgid % per; pm = r % nM; pn = r / nM; }
        u.pm = pm; u.pn = pn; u.z = z;
        return true;
    }
};

template <int NAI> using AccT = f32x4[NAI][2][4][2];
typedef AccT<2> Acc;

template <int NP4, int NAI = 2> __device__ __forceinline__ void wave_rstd(float (&rs)[2][4], const float* ssq, int ld, int row0, int lane, int fr, float inv_dim) {
    const GAS f32x4* pa = (const GAS f32x4*)(ssq + (size_t)(row0 + lane) * ld); const GAS f32x4* pb = (const GAS f32x4*)(ssq + (size_t)(row0 + (NAI == 2 ? 128 : 0) + lane) * ld);
    float a = 0.f, b = 0.f;
#pragma unroll
    for (int j = 0; j < NP4; ++j) { const f32x4 v = pa[j]; a += (v[0] + v[1]) + (v[2] + v[3]); if (NAI == 2) { const f32x4 w = pb[j]; b += (w[0] + w[1]) + (w[2] + w[3]); } }
    a = 1.0f / sqrtf(a * inv_dim + EPS); b = 1.0f / sqrtf(b * inv_dim + EPS);
#pragma unroll
    for (int m = 0; m < 4; ++m) { rs[0][m] = shi(a, m * 16 + fr); rs[1][m] = (NAI == 2) ? shi(b, m * 16 + fr) : 0.f; }
}
__device__ __forceinline__ float dpp_add8(float v) {
    v += __int_as_float(__builtin_amdgcn_update_dpp(0, __float_as_int(v), 0xB1, 0xF, 0xF, true));
    v += __int_as_float(__builtin_amdgcn_update_dpp(0, __float_as_int(v), 0x4E, 0xF, 0xF, true));
    v += __int_as_float(__builtin_amdgcn_update_dpp(0, __float_as_int(v), 0x141, 0xF, 0xF, true));
    return v;
}
template <int NAI> struct RsRegs { f32x4 va[8], vb[NAI == 2 ? 8 : 1]; };
template <int NAI = 2> __device__ __forceinline__ void wave_rstd_issue8(RsRegs<NAI>& r, const float* ssq, int row0, int lane) {
    const GAS f32x4* pa = (const GAS f32x4*)(ssq + (size_t)row0 * 32) + lane; const GAS f32x4* pb = (const GAS f32x4*)(ssq + (size_t)(row0 + 128) * 32) + lane;
#pragma unroll
    for (int k = 0; k < 8; ++k) { r.va[k] = pa[64 * k]; if (NAI == 2) r.vb[k] = pb[64 * k]; }
}
template <int NAI = 2> __device__ __forceinline__ void wave_rstd_finish8(const RsRegs<NAI>& r, int lane, float inv_dim, LAS float* cache) {
    float sa[8], sb[8];
#pragma unroll
    for (int k = 0; k < 8; ++k) { const f32x4 v = r.va[k]; sa[k] = dpp_add8((v[0] + v[1]) + (v[2] + v[3])); if (NAI == 2) { const f32x4 w = r.vb[k]; sb[k] = dpp_add8((w[0] + w[1]) + (w[2] + w[3])); } }
    float xa = sa[0], xb = (NAI == 2) ? sb[0] : 0.f; const int kk = lane & 7;
#pragma unroll
    for (int k = 1; k < 8; ++k) { xa = (kk == k) ? sa[k] : xa; if (NAI == 2) xb = (kk == k) ? sb[k] : xb; }
    const int rr = 8 * kk + (lane >> 3);
    cache[rr] = 1.0f / sqrtf(xa * inv_dim + EPS); if (NAI == 2) cache[64 + rr] = 1.0f / sqrtf(xb * inv_dim + EPS);
}
template <int NAI = 2> __device__ __forceinline__ void wave_rstd_fill8(const float* ssq, int row0, int lane, float inv_dim, LAS float* cache) {
    RsRegs<NAI> r; wave_rstd_issue8<NAI>(r, ssq, row0, lane); wave_rstd_finish8<NAI>(r, lane, inv_dim, cache);
}
template <int NP4, int NAI = 2> __device__ __forceinline__ void wave_rstd_c(float (&rs)[2][4], const float* ssq, int ld, int row0, int lane, int fr, float inv_dim, LAS float* cache, int hit) {
    static_assert(NP4 == 8, "cached form: 32 partials per row");
    if (!hit) wave_rstd_fill8<NAI>(ssq, row0, lane, inv_dim, cache);
    const float a = cache[lane], b = (NAI == 2) ? cache[64 + lane] : 0.f;
#pragma unroll
    for (int m = 0; m < 4; ++m) { rs[0][m] = shi(a, m * 16 + fr); rs[1][m] = (NAI == 2) ? shi(b, m * 16 + fr) : 0.f; }
}
__device__ __forceinline__ float sumsq8(f32x4 a, f32x4 b) { return ((a[0] * a[0] + a[1] * a[1]) + (a[2] * a[2] + a[3] * a[3])) + ((b[0] * b[0] + b[1] * b[1]) + (b[2] * b[2] + b[3] * b[3])); }
__device__ __forceinline__ void rope8(f32x4& v0, f32x4& v1, f32x4 c, f32x4 s) {
    const f32x4 a = v0, b = v1;
    v0[0] = a[0] * c[0] - a[1] * s[0]; v0[1] = a[0] * s[0] + a[1] * c[0]; v0[2] = a[2] * c[1] - a[3] * s[1]; v0[3] = a[2] * s[1] + a[3] * c[1];
    v1[0] = b[0] * c[2] - b[1] * s[2]; v1[1] = b[0] * s[2] + b[1] * c[2]; v1[2] = b[2] * c[3] - b[3] * s[3]; v1[3] = b[2] * s[3] + b[3] * c[3];
}

template <int NP4> struct EpiRow {
    static constexpr bool HAS_MID = false, HAS_INIT = false;
    bf16_t* O; int ldc; long sOz;
    const float* ssq_in; int ld_in; float inv_dim;
    int rope_pn; int rope_full; const float* ctab; const float* stab;
    float* ssq_out; int ssq_pn0, ssq_pn1;
    __device__ __forceinline__ void mid(Acc&, const Unit&, int, int, int, int, LAS unsigned char*) const {}
    static constexpr bool RS_CACHE = (NP4 > 0);
    __device__ __forceinline__ void rs_issue(RsRegs<2>& r, const Unit& u, int wr, int lane) const {
        if constexpr (NP4 == 8) wave_rstd_issue8<2>(r, ssq_in, u.pm * BM + wr * 64, lane);
        else if constexpr (NP4 > 0) { const GAS f32x4* pa = (const GAS f32x4*)(ssq_in + (size_t)(u.pm * BM + wr * 64 + lane) * ld_in); const GAS f32x4* pb = (const GAS f32x4*)(ssq_in + (size_t)(u.pm * BM + wr * 64 + 128 + lane) * ld_in);
#pragma unroll
            for (int j = 0; j < NP4; ++j) { r.va[j] = pa[j]; r.vb[j] = pb[j]; } }
    }
    __device__ __forceinline__ void rs_finish(const RsRegs<2>& r, int wr, int wc, int lane, LAS unsigned char* ex) const {
        LAS float* cache = (LAS float*)(ex + (wr * 4 + wc) * 512);
        if constexpr (NP4 == 8) wave_rstd_finish8<2>(r, lane, inv_dim, cache);
        else if constexpr (NP4 > 0) { float a = 0.f, b = 0.f;
#pragma unroll
            for (int j = 0; j < NP4; ++j) { const f32x4 v = r.va[j], w = r.vb[j]; a += (v[0] + v[1]) + (v[2] + v[3]); b += (w[0] + w[1]) + (w[2] + w[3]); }
            cache[lane] = 1.0f / sqrtf(a * inv_dim + EPS); cache[64 + lane] = 1.0f / sqrtf(b * inv_dim + EPS); }
    }
    __device__ __forceinline__ void run(Acc& acc, const Unit& u, int wr, int wc, int fr, int fq, int lane, LAS unsigned char* ex, int hit = 0) const {
        float rs[2][4];
        if constexpr (NP4 > 0) {
            if (!hit) { RsRegs<2> r; rs_issue(r, u, wr, lane); rs_finish(r, wr, wc, lane, ex); }
            LAS float* cache = (LAS float*)(ex + (wr * 4 + wc) * 512); const float a = cache[lane], b = cache[64 + lane];
#pragma unroll
            for (int m = 0; m < 4; ++m) { rs[0][m] = shi(a, m * 16 + fr); rs[1][m] = shi(b, m * 16 + fr); }
        }
        const bool do_ssq = (u.pn >= ssq_pn0 && u.pn < ssq_pn1);
        const bool rope_t = (u.pn >= rope_pn);
        bf16_t* base = O + (size_t)u.z * sOz;
        const int col0 = u.pn * BM + wc * 32 + 8 * fq;
        f32x4 rc[2][4], rsn[2][4];
        if (rope_t) { const int j0 = 16 * (wc & 1) + 4 * fq;
#pragma unroll
            for (int ai = 0; ai < 2; ++ai)
#pragma unroll
                for (int m = 0; m < 4; ++m) { const int row = u.pm * BM + ai * HALF + wr * 64 + m * 16 + fr;
                    rc[ai][m] = *(const GAS f32x4*)(ctab + (size_t)row * 32 + j0); rsn[ai][m] = *(const GAS f32x4*)(stab + (size_t)row * 32 + j0); } }
#pragma unroll
        for (int ai = 0; ai < 2; ++ai)
#pragma unroll
            for (int m = 0; m < 4; ++m) {
                const int row = u.pm * BM + ai * HALF + wr * 64 + m * 16 + fr;
                const float s = (NP4 > 0) ? rs[ai][m] : 1.0f;
                float q = 0.f;
#pragma unroll
                for (int bj = 0; bj < 2; ++bj) {
                    f32x4 v0 = acc[ai][bj][m][0] * s, v1 = acc[ai][bj][m][1] * s;
                    if (rope_t && (rope_full || (bj == 0 && wc < 2))) rope8(v0, v1, rc[ai][m], rsn[ai][m]);
                    q += sumsq8(v0, v1);
                    *(GAS u32x4*)(base + (size_t)row * ldc + col0 + bj * HALF) = pack8(v0, v1);
                }
                if (do_ssq) { q += shx(q, 16, lane); q += shx(q, 32, lane); if (fq == 0) ((GAS float*)ssq_out)[(size_t)row * 16 + (u.pn - ssq_pn0) * 4 + wc] = q; }
            }
    }
};

template <bool MID> struct EpiRes {
    static constexpr bool HAS_MID = MID, HAS_INIT = true, RS_CACHE = false;
    const float* base32; bf16_t* xb; bf16_t* xo; float* ssq_x;
    const float* ssq_y;
    __device__ __forceinline__ void mid(Acc& acc, const Unit& u, int wr, int wc, int fr, int lane, LAS unsigned char* ex) const {
        if constexpr (MID) {
            const LAS float* cache = (const LAS float*)(ex + (wr * 4 + wc) * 1024);
            const float ra = cache[lane], rb = cache[64 + lane];
#pragma unroll
            for (int m = 0; m < 4; ++m) { const float r0 = shi(ra, m * 16 + fr), r1 = shi(rb, m * 16 + fr);
#pragma unroll
                for (int bj = 0; bj < 2; ++bj)
#pragma unroll
                    for (int n = 0; n < 2; ++n) { acc[0][bj][m][n] *= r0; acc[1][bj][m][n] *= r1; } }
        }
    }
    __device__ __forceinline__ void init(Acc& acc, const Unit& u, int wr, int wc, int fr, int fq, int lane, LAS unsigned char* ex) const {
        float sc[2][4];
        if constexpr (MID) {
            const int row0 = u.pm * BM + wr * 64; float a, b;
            LAS float* cache = (LAS float*)(ex + (wr * 4 + wc) * 1024);
            { const GAS f32x4* p = (const GAS f32x4*)(ssq_y + (size_t)(row0 + lane) * 16); const f32x4 a0 = p[0], a1 = p[1], b0 = p[2], b1 = p[3];
              const float na = (((a0[0] + a0[1]) + (a0[2] + a0[3])) + ((a1[0] + a1[1]) + (a1[2] + a1[3]))) * (1.0f / 1024.0f) + EPS, ml = (((b0[0] + b0[1]) + (b0[2] + b0[3])) + ((b1[0] + b1[1]) + (b1[2] + b1[3]))) * (1.0f / 1024.0f) + EPS;
              a = sqrtf(na); cache[lane] = sqrtf(ml / na); cache[128 + lane] = 1.0f / sqrtf(ml); }
            { const GAS f32x4* p = (const GAS f32x4*)(ssq_y + (size_t)(row0 + 128 + lane) * 16); const f32x4 a0 = p[0], a1 = p[1], b0 = p[2], b1 = p[3];
              const float na = (((a0[0] + a0[1]) + (a0[2] + a0[3])) + ((a1[0] + a1[1]) + (a1[2] + a1[3]))) * (1.0f / 1024.0f) + EPS, ml = (((b0[0] + b0[1]) + (b0[2] + b0[3])) + ((b1[0] + b1[1]) + (b1[2] + b1[3]))) * (1.0f / 1024.0f) + EPS;
              b = sqrtf(na); cache[64 + lane] = sqrtf(ml / na); cache[192 + lane] = 1.0f / sqrtf(ml); }
#pragma unroll
            for (int m = 0; m < 4; ++m) { sc[0][m] = shi(a, m * 16 + fr); sc[1][m] = shi(b, m * 16 + fr); }
        }
        const int col0 = u.pn * BM + wc * 32 + 8 * fq;
        if (base32) {
#pragma unroll
            for (int ai = 0; ai < 2; ++ai)
#pragma unroll
                for (int m = 0; m < 4; ++m) {
                    const size_t off = (size_t)(u.pm * BM + ai * HALF + wr * 64 + m * 16 + fr) * DM + col0;
#pragma unroll
                    for (int bj = 0; bj < 2; ++bj) {
                        f32x4 b0 = *(const GAS f32x4*)(base32 + off + bj * HALF), b1 = *(const GAS f32x4*)(base32 + off + bj * HALF + 4);
                        if constexpr (MID) { b0 = b0 * sc[ai][m]; b1 = b1 * sc[ai][m]; }
                        acc[ai][bj][m][0] = b0; acc[ai][bj][m][1] = b1;
                    }
                }
        } else {
            u32x4 w[2][4][2];
#pragma unroll
            for (int ai = 0; ai < 2; ++ai)
#pragma unroll
                for (int m = 0; m < 4; ++m) {
                    const size_t off = (size_t)(u.pm * BM + ai * HALF + wr * 64 + m * 16 + fr) * DM + col0;
#pragma unroll
                    for (int bj = 0; bj < 2; ++bj) w[ai][m][bj] = *(const GAS u32x4*)(xb + off + bj * HALF);
                }
#pragma unroll
            for (int ai = 0; ai < 2; ++ai)
#pragma unroll
                for (int m = 0; m < 4; ++m)
#pragma unroll
                    for (int bj = 0; bj < 2; ++bj) {
                        const u32x4 v = w[ai][m][bj];
                        f32x4 b0 = (f32x4){bf_lo(v.x), bf_hi(v.x), bf_lo(v.y), bf_hi(v.y)}, b1 = (f32x4){bf_lo(v.z), bf_hi(v.z), bf_lo(v.w), bf_hi(v.w)};
                        if constexpr (MID) { b0 = b0 * sc[ai][m]; b1 = b1 * sc[ai][m]; }
                        acc[ai][bj][m][0] = b0; acc[ai][bj][m][1] = b1;
                    }
        }
    }
    __device__ __forceinline__ void run(Acc& acc, const Unit& u, int wr, int wc, int fr, int fq, int lane, LAS unsigned char* ex) const {
        float rs[2][4];
        if constexpr (MID) { const LAS float* cache = (const LAS float*)(ex + (wr * 4 + wc) * 1024); const float ma = cache[128 + lane], mb = cache[192 + lane];
#pragma unroll
            for (int m = 0; m < 4; ++m) { rs[0][m] = shi(ma, m * 16 + fr); rs[1][m] = shi(mb, m * 16 + fr); } }
        const int col0 = u.pn * BM + wc * 32 + 8 * fq;
#pragma unroll
        for (int ai = 0; ai < 2; ++ai)
#pragma unroll
            for (int m = 0; m < 4; ++m) {
                const int row = u.pm * BM + ai * HALF + wr * 64 + m * 16 + fr;
                const float s = MID ? rs[ai][m] : 1.0f;
                const size_t off = (size_t)row * DM + col0;
                float q = 0.f;
#pragma unroll
                for (int bj = 0; bj < 2; ++bj) {
                    const f32x4 v0 = acc[ai][bj][m][0] * s, v1 = acc[ai][bj][m][1] * s;
                    *(GAS u32x4*)(xo + off + bj * HALF) = pack8(v0, v1);
                    q += sumsq8(v0, v1);
                }
                q += shx(q, 16, lane); q += shx(q, 32, lane);
                if (fq == 0) ((GAS float*)ssq_x)[(size_t)row * 32 + u.pn * 4 + wc] = q;
            }
    }
};

template <int NAI> struct EpiSoftmaxT {
    static constexpr bool HAS_MID = false, HAS_INIT = false, RS_CACHE = false;
    bf16_t* P; const float* ssq_x;
    __device__ __forceinline__ void mid(AccT<NAI>&, const Unit&, int, int, int, int, LAS unsigned char*) const {}
    __device__ __forceinline__ void run(AccT<NAI>& acc, const Unit& u, int wr, int wc, int fr, int fq, int lane, LAS unsigned char* ex) const {
        float rs[2][4];
        wave_rstd<8, NAI>(rs, ssq_x, 32, u.pm * (HALF * NAI) + wr * 64, lane, fr, 1.0f / (float)DM);
        LAS f32x2* X = (LAS f32x2*)ex;
#pragma unroll
        for (int ai = 0; ai < NAI; ++ai)
#pragma unroll
            for (int m = 0; m < 4; ++m) {
                const float s = rs[ai][m]; float mx = -INFINITY;
#pragma unroll
                for (int bj = 0; bj < 2; ++bj)
#pragma unroll
                    for (int n = 0; n < 2; ++n) { f32x4 v = acc[ai][bj][m][n] * s; acc[ai][bj][m][n] = v; mx = fmaxf(mx, fmaxf(fmaxf(v[0], v[1]), fmaxf(v[2], v[3]))); }
                mx = fmaxf(mx, shx(mx, 16, lane)); mx = fmaxf(mx, shx(mx, 32, lane));
                float sm = 0.f;
#pragma unroll
                for (int bj = 0; bj < 2; ++bj)
#pragma unroll
                    for (int n = 0; n < 2; ++n) { f32x4 v = acc[ai][bj][m][n];
                        v[0] = __builtin_amdgcn_exp2f(v[0] - mx); v[1] = __builtin_amdgcn_exp2f(v[1] - mx); v[2] = __builtin_amdgcn_exp2f(v[2] - mx); v[3] = __builtin_amdgcn_exp2f(v[3] - mx);
                        acc[ai][bj][m][n] = v; sm += (v[0] + v[1]) + (v[2] + v[3]); }
                sm += shx(sm, 16, lane); sm += shx(sm, 32, lane);
                rs[ai][m] = mx;
                if (fq == 0) X[(ai * HALF + wr * 64 + m * 16 + fr) * 4 + wc] = (f32x2){mx, sm};
            }
        asm volatile("s_waitcnt lgkmcnt(0)" ::: "memory"); __builtin_amdgcn_s_barrier(); asm volatile("" ::: "memory");
        const int col0 = u.pn * BM + wc * 32 + 8 * fq;
#pragma unroll
        for (int ai = 0; ai < NAI; ++ai)
#pragma unroll
            for (int m = 0; m < 4; ++m) {
                const int rl = ai * HALF + wr * 64 + m * 16 + fr, row = u.pm * (HALF * NAI) + rl;
                const f32x2 a = X[rl * 4 + 0], b = X[rl * 4 + 1], c = X[rl * 4 + 2], d = X[rl * 4 + 3];
                const float M = fmaxf(fmaxf(a[0], b[0]), fmaxf(c[0], d[0]));
                const float tot = (a[1] * __builtin_amdgcn_exp2f(a[0] - M) + b[1] * __builtin_amdgcn_exp2f(b[0] - M)) + (c[1] * __builtin_amdgcn_exp2f(c[0] - M) + d[1] * __builtin_amdgcn_exp2f(d[0] - M));
                const float f = __builtin_amdgcn_exp2f(rs[ai][m] - M) / tot;
#pragma unroll
                for (int bj = 0; bj < 2; ++bj)
                    *(GAS u32x4*)(P + (size_t)row * 1024 + col0 + bj * HALF) = pack8(acc[ai][bj][m][0] * f, acc[ai][bj][m][1] * f);
            }
    }
};

template <int NAI> struct EpiSwigluT {
    static constexpr bool HAS_MID = false, HAS_INIT = false;
    bf16_t* H; const float* ssq_x; int reuse = 0;
    __device__ __forceinline__ void mid(AccT<NAI>&, const Unit&, int, int, int, int, LAS unsigned char*) const {}
    static constexpr bool RS_CACHE = true;
    __device__ __forceinline__ void rs_issue(RsRegs<NAI>& r, const Unit& u, int wr, int lane) const { wave_rstd_issue8<NAI>(r, ssq_x, u.pm * (HALF * NAI) + wr * 64, lane); }
    __device__ __forceinline__ void rs_finish(const RsRegs<NAI>& r, int wr, int wc, int lane, LAS unsigned char* ex) const { wave_rstd_finish8<NAI>(r, lane, 1.0f / (float)DM, (LAS float*)(ex + (wr * 4 + wc) * 512)); }
    __device__ __forceinline__ void run(AccT<NAI>& acc, const Unit& u, int wr, int wc, int fr, int fq, int lane, LAS unsigned char* ex, int hit = 0) const {
        float rs[2][4];
        wave_rstd_c<8, NAI>(rs, ssq_x, 32, u.pm * (HALF * NAI) + wr * 64, lane, fr, 1.0f / (float)DM, (LAS float*)(ex + (wr * 4 + wc) * 512) + ((NAI == 1 && reuse) ? (u.pm & 1) * 64 : 0), hit | reuse);
        const int col0 = u.pn * HALF + wc * 32 + 8 * fq;
#pragma unroll
        for (int ai = 0; ai < NAI; ++ai)
#pragma unroll
            for (int m = 0; m < 4; ++m) {
                const int row = u.pm * (HALF * NAI) + ai * HALF + wr * 64 + m * 16 + fr; const float s = rs[ai][m];
                f32x4 o[2];
#pragma unroll
                for (int n = 0; n < 2; ++n) { const f32x4 g = acc[ai][0][m][n] * s, up = acc[ai][1][m][n] * s;
                    f32x4 t = g * (-LOG2E);
                    t = (f32x4){__builtin_amdgcn_exp2f(t[0]), __builtin_amdgcn_exp2f(t[1]), __builtin_amdgcn_exp2f(t[2]), __builtin_amdgcn_exp2f(t[3])};
                    t = t + 1.0f;
                    t = (f32x4){__builtin_amdgcn_rcpf(t[0]), __builtin_amdgcn_rcpf(t[1]), __builtin_amdgcn_rcpf(t[2]), __builtin_amdgcn_rcpf(t[3])};
                    o[n] = (g * up) * t; }
                *(GAS u32x4*)(H + (size_t)row * DFF + col0) = pack8(o[0], o[1]);
            }
    }
};

typedef EpiSoftmaxT<2> EpiSoftmax; typedef EpiSwigluT<2> EpiSwiglu;

template <class Epi, class Sched>
__device__ __forceinline__ void gemm_phase(LAS unsigned char* lds, LAS unsigned char* ex, const Gemm g, const Sched& S_, const Epi& E, int wid_, bool skip_epi = false) {
    int wid = wid_; asm volatile("" : "+s"(wid));
    const int lane = lane_id(), tid = wid * 64 + lane, wr = wid >> 2, wc = wid & 3, fr = lane & 15, fq = lane >> 4;
    int nt = g.K / BK; asm volatile("" : "+s"(nt));
    unsigned voffA[2], voffB[2];
#pragma unroll
    for (int i = 0; i < 2; ++i) { int R, C; stage_rc(tid * 16 + i * 8192, R, C); const int Rb = (R & ~31) + perm32(R & 31);
        voffA[i] = (unsigned)(R * g.lda + C) * 2u; voffB[i] = (unsigned)(Rb * g.ldb + C) * 2u; }
    const size_t kstep = (size_t)(BK * 2);
    const size_t hstepA = (size_t)HALF * g.lda * 2, hstepB = (size_t)HALF * g.ldb * 2;
    const unsigned ldsw = (unsigned)wid * 1024u;
    const int aoff = lds_byte(wr * 64 + fr, fq * 8), boff = lds_byte(wc * 32 + fr, fq * 8);
#define PG8_SA(b, h) (((b) * 2 + (h)) * HTB)
#define PG8_SB(b, h) ((4 + (b) * 2 + (h)) * HTB)
#define PG8_STAGE(bufoff, gbase, voff) do { _Pragma("unroll") for (int _i = 0; _i < 2; ++_i) \
        __builtin_amdgcn_global_load_lds((const unsigned*)((const char*)(gbase) + (voff)[_i]), (LAS unsigned*)(lds + (bufoff) + ldsw + _i * 8192), 16, 0, 0); } while (0)
#define PG8_LDA(dst, b, h) do { _Pragma("unroll") for (int m = 0; m < 4; ++m) _Pragma("unroll") for (int k = 0; k < 2; ++k) dst[m][k] = *(const LAS bf16x8*)(lds + PG8_SA(b, h) + aoff + m * 2048 + k * 1024); } while (0)
#define PG8_LDB(dst, b, h) do { _Pragma("unroll") for (int n = 0; n < 2; ++n) _Pragma("unroll") for (int k = 0; k < 2; ++k) dst[n][k] = *(const LAS bf16x8*)(lds + PG8_SB(b, h) + boff + n * 2048 + k * 1024); } while (0)
#define PG8_MMA(ai, bj, At, Bt) do { __builtin_amdgcn_s_setprio(1); _Pragma("unroll") for (int m = 0; m < 4; ++m) _Pragma("unroll") for (int n = 0; n < 2; ++n) _Pragma("unroll") for (int k = 0; k < 2; ++k) \
        acc[ai][bj][m][n] = __builtin_amdgcn_mfma_f32_16x16x32_bf16(Bt[n][k], At[m][k], acc[ai][bj][m][n], 0, 0, 0); __builtin_amdgcn_s_setprio(0); } while (0)
#define PG8_WAIT_V(n) asm volatile("s_waitcnt vmcnt(" #n ")" ::: "memory")
#define PG8_WAIT_L(n) asm volatile("s_waitcnt lgkmcnt(" #n ")" ::: "memory")
#define PG8_BAR __builtin_amdgcn_s_barrier()
#define PG8_SCHED __builtin_amdgcn_sched_barrier(0)
    Unit cur, nxt; int ui = 0; int prev_pm = -1; (void)prev_pm;
    if (!S_.next(0, cur)) return;
    Acc acc;
    if constexpr (!Epi::HAS_INIT) {
#pragma unroll
    for (int a = 0; a < 2; ++a)
#pragma unroll
        for (int b = 0; b < 2; ++b)
#pragma unroll
            for (int m = 0; m < 4; ++m)
#pragma unroll
                for (int n = 0; n < 2; ++n) acc[a][b][m][n] = (f32x4){0.f, 0.f, 0.f, 0.f};
    }
    bf16x8 At[4][2], B0[2][2], B1[2][2];
    const char* cA = (const char*)(g.A + (size_t)cur.z * g.sAz) + (size_t)cur.pm * 2 * hstepA; const char* cB = (const char*)(g.Bt + (size_t)cur.z * g.sBz) + (size_t)cur.pn * 2 * hstepB;
    RsRegs<2> rsr; (void)rsr; int rs_lane = 0; (void)rs_lane;
    if constexpr (Epi::RS_CACHE) { rs_lane = lane_id(2); E.rs_issue(rsr, cur, wr, rs_lane); }
    PG8_STAGE(PG8_SB(0, 0), cB, voffB); PG8_STAGE(PG8_SB(0, 1), cB + hstepB, voffB); PG8_STAGE(PG8_SA(0, 0), cA, voffA); PG8_STAGE(PG8_SA(0, 1), cA + hstepA, voffA);
    if constexpr (Epi::RS_CACHE) { E.rs_finish(rsr, wr, wc, rs_lane, ex); prev_pm = cur.pm; }
    if constexpr (Epi::HAS_INIT) { const int ln = lane_id(); E.init(acc, cur, wr, wc, ln & 15, ln >> 4, ln, ex); }
    if (wr == 1) PG8_BAR;
    PG8_WAIT_V(2); PG8_BAR;
    PG8_STAGE(PG8_SB(1, 0), cB + kstep, voffB); PG8_STAGE(PG8_SA(1, 0), cA + kstep, voffA); PG8_STAGE(PG8_SB(1, 1), cB + hstepB + kstep, voffB);
    PG8_WAIT_V(6); PG8_BAR;
    for (;;) {
        const bool has_next = S_.next(ui + 1, nxt);
        const char* nA = has_next ? (const char*)(g.A + (size_t)nxt.z * g.sAz) + (size_t)nxt.pm * 2 * hstepA : cA;
        const char* nB = has_next ? (const char*)(g.Bt + (size_t)nxt.z * g.sBz) + (size_t)nxt.pn * 2 * hstepB : cB;
#pragma nounroll
        for (int t = 0; t < nt; t += 2) {
            const bool last = (t == nt - 2);
            if constexpr (Epi::HAS_MID) { if (t == (nt >> 1)) { const int ln = lane_id(t + ui); E.mid(acc, cur, wr, wc, ln & 15, ln, ex); } }
            const char* a1 = cA + (size_t)(t + 1) * kstep;
            const char* a2 = last ? nA : cA + (size_t)(t + 2) * kstep; const char* b2 = last ? nB : cB + (size_t)(t + 2) * kstep;
            const char* a3 = a2 + kstep; const char* b3 = b2 + kstep;
            PG8_LDB(B0, 0, 0); PG8_LDB(B1, 0, 1); PG8_SCHED; PG8_LDA(At, 0, 0); PG8_STAGE(PG8_SA(1, 1), a1 + hstepA, voffA);
            PG8_WAIT_V(8); PG8_WAIT_L(0); PG8_BAR; PG8_MMA(0, 0, At, B0); PG8_MMA(0, 1, At, B1); PG8_BAR; PG8_SCHED;
            const bool nostage = X_NODUMMY && last && !has_next;
            PG8_LDA(At, 0, 1); if (!nostage) { PG8_STAGE(PG8_SB(0, 0), b2, voffB); PG8_STAGE(PG8_SB(0, 1), b2 + hstepB, voffB); PG8_STAGE(PG8_SA(0, 0), a2, voffA); }
            if (nostage) PG8_WAIT_V(2); else PG8_WAIT_V(8); PG8_WAIT_L(0); PG8_BAR; PG8_MMA(1, 0, At, B0); PG8_MMA(1, 1, At, B1); PG8_BAR; PG8_SCHED;
            PG8_LDB(B0, 1, 0); PG8_LDB(B1, 1, 1); PG8_SCHED; PG8_LDA(At, 1, 0); if (!nostage) PG8_STAGE(PG8_SA(0, 1), a2 + hstepA, voffA);
            if (nostage) PG8_WAIT_V(0); else PG8_WAIT_V(8); PG8_WAIT_L(0); PG8_BAR; PG8_MMA(0, 0, At, B0); PG8_MMA(0, 1, At, B1); PG8_BAR; PG8_SCHED;
            PG8_LDA(At, 1, 1); if (!nostage) { PG8_STAGE(PG8_SB(1, 0), b3, voffB); PG8_STAGE(PG8_SB(1, 1), b3 + hstepB, voffB); PG8_STAGE(PG8_SA(1, 0), a3, voffA); }
            if (!nostage) PG8_WAIT_V(8); PG8_WAIT_L(0); PG8_BAR; PG8_MMA(1, 0, At, B0); PG8_MMA(1, 1, At, B1); PG8_BAR; PG8_SCHED;
        }
        if (wr == 0) PG8_BAR;
        if (!skip_epi) { const int ln = lane_id(ui);
            if constexpr (Epi::RS_CACHE) { const int hit = (cur.pm == prev_pm) ? 1 : 0; prev_pm = cur.pm; E.run(acc, cur, wr, wc, ln & 15, ln >> 4, ln, ex, hit); }
            else E.run(acc, cur, wr, wc, ln & 15, ln >> 4, ln, ex); }
        if (!has_next) break;
        if constexpr (Epi::HAS_INIT) { const int ln = lane_id(ui + 1); E.init(acc, nxt, wr, wc, ln & 15, ln >> 4, ln, ex); }
        else {
#pragma unroll
        for (int a = 0; a < 2; ++a)
#pragma unroll
            for (int b = 0; b < 2; ++b)
#pragma unroll
                for (int m = 0; m < 4; ++m)
#pragma unroll
                    for (int n = 0; n < 2; ++n) acc[a][b][m][n] = (f32x4){0.f, 0.f, 0.f, 0.f};
        }
        cur = nxt; cA = nA; cB = nB; ++ui;
        if (wr == 1) PG8_BAR;
    }
    PG8_WAIT_V(0);
    PG8_BAR;
#undef PG8_SA
#undef PG8_SB
#undef PG8_STAGE
#undef PG8_LDA
#undef PG8_LDB
#undef PG8_MMA
#undef PG8_WAIT_V
#undef PG8_WAIT_L
#undef PG8_BAR
#undef PG8_SCHED
}

struct OneUnit { int pm, pn, has;
    __device__ __forceinline__ bool next(int i, Unit& u) const { u.pm = pm; u.pn = pn; u.z = 0; return i == 0 && has != 0; } };

template <class Epi, class Sched>
__device__ __forceinline__ void gemm_phase128(LAS unsigned char* lds, LAS unsigned char* ex, const Gemm g, const Sched& S_, const Epi& E, int wid_) {
    int wid = wid_; asm volatile("" : "+s"(wid));
    const int lane = lane_id(), tid = wid * 64 + lane, wr = wid >> 2, wc = wid & 3, fr = lane & 15;
    const int nt = g.K / BK;
    unsigned voffA[2], voffB[2];
#pragma unroll
    for (int i = 0; i < 2; ++i) { int R, C; stage_rc(tid * 16 + i * 8192, R, C); const int Rb = (R & ~31) + perm32(R & 31);
        voffA[i] = (unsigned)(R * g.lda + C) * 2u; voffB[i] = (unsigned)(Rb * g.ldb + C) * 2u; }
    const size_t kstep = (size_t)(BK * 2);
    const size_t hstepA = (size_t)HALF * g.lda * 2, hstepB = (size_t)HALF * g.ldb * 2;
    const unsigned ldsw = (unsigned)wid * 1024u;
    const int aoff = lds_byte(wr * 64 + fr, (lane >> 4) * 8), boff = lds_byte(wc * 32 + fr, (lane >> 4) * 8);
    constexpr int SLOT = 3 * HTB;
#define P1_STG(off, gbase, voff) do { _Pragma("unroll") for (int _i = 0; _i < 2; ++_i) \
        __builtin_amdgcn_global_load_lds((const unsigned*)((const char*)(gbase) + (voff)[_i]), (LAS unsigned*)(lds + (off) + ldsw + _i * 8192), 16, 0, 0); } while (0)
#define P1_STAGE(slot, pA, pB) do { P1_STG((slot) * SLOT, pA, voffA); P1_STG((slot) * SLOT + HTB, pB, voffB); P1_STG((slot) * SLOT + 2 * HTB, (pB) + hstepB, voffB); } while (0)
#define P1_LDA(dst, slot) do { _Pragma("unroll") for (int m = 0; m < 4; ++m) _Pragma("unroll") for (int k = 0; k < 2; ++k) dst[m][k] = *(const LAS bf16x8*)(lds + (slot) * SLOT + aoff + m * 2048 + k * 1024); } while (0)
#define P1_LDB(dst, slot, h) do { _Pragma("unroll") for (int n = 0; n < 2; ++n) _Pragma("unroll") for (int k = 0; k < 2; ++k) dst[n][k] = *(const LAS bf16x8*)(lds + (slot) * SLOT + (1 + (h)) * HTB + boff + n * 2048 + k * 1024); } while (0)
#define P1_MMA(bj, At, Bt) do { __builtin_amdgcn_s_setprio(1); _Pragma("unroll") for (int m = 0; m < 4; ++m) _Pragma("unroll") for (int n = 0; n < 2; ++n) _Pragma("unroll") for (int k = 0; k < 2; ++k) \
        acc[0][bj][m][n] = __builtin_amdgcn_mfma_f32_16x16x32_bf16(Bt[n][k], At[m][k], acc[0][bj][m][n], 0, 0, 0); __builtin_amdgcn_s_setprio(0); } while (0)
#define P1_WAIT_V(n) asm volatile("s_waitcnt vmcnt(" #n ")" ::: "memory")
#define P1_WAIT_L(n) asm volatile("s_waitcnt lgkmcnt(" #n ")" ::: "memory")
#define P1_BAR __builtin_amdgcn_s_barrier()
#define P1_SCHED __builtin_amdgcn_sched_barrier(0)
    Unit cur, nxt; int ui = 0;
    if (!S_.next(0, cur)) return;
    AccT<1> acc;
#pragma unroll
    for (int b = 0; b < 2; ++b)
#pragma unroll
        for (int m = 0; m < 4; ++m)
#pragma unroll
            for (int n = 0; n < 2; ++n) acc[0][b][m][n] = (f32x4){0.f, 0.f, 0.f, 0.f};
    bf16x8 At[4][2], B0[2][2], B1[2][2];
    const char* cA = (const char*)g.A + (size_t)cur.pm * hstepA; const char* cB = (const char*)g.Bt + (size_t)cur.pn * 2 * hstepB;
    P1_STAGE(0, cA, cB); P1_STAGE(1, cA + kstep, cB + kstep);
    if (wr == 1) P1_BAR;
    P1_WAIT_V(6); P1_BAR; P1_BAR;
    int slot = 0;
    for (;;) {
        const bool has_next = S_.next(ui + 1, nxt);
        const char* nA = has_next ? (const char*)g.A + (size_t)nxt.pm * hstepA : cA;
        const char* nB = has_next ? (const char*)g.Bt + (size_t)nxt.pn * 2 * hstepB : cB;
        for (int t = 0; t < nt; ++t) {
            const int t2 = t + 2;
            const char* a2 = (t2 < nt) ? cA + (size_t)t2 * kstep : nA + (size_t)(t2 - nt) * kstep;
            const char* b2 = (t2 < nt) ? cB + (size_t)t2 * kstep : nB + (size_t)(t2 - nt) * kstep;
            const int s2 = (slot == 0) ? 2 : slot - 1;
            P1_LDB(B0, slot, 0); P1_LDB(B1, slot, 1); P1_SCHED; P1_LDA(At, slot); P1_STAGE(s2, a2, b2);
            P1_WAIT_V(6); P1_WAIT_L(0); P1_BAR; P1_MMA(0, At, B0); P1_MMA(1, At, B1); P1_BAR; P1_SCHED;
            slot = (slot == 2) ? 0 : slot + 1;
        }
        if (wr == 0) P1_BAR;
        { const int ln = lane_id(ui); E.run(acc, cur, wr, wc, ln & 15, ln >> 4, ln, ex); }
        if (!has_next) break;
#pragma unroll
        for (int b = 0; b < 2; ++b)
#pragma unroll
            for (int m = 0; m < 4; ++m)
#pragma unroll
                for (int n = 0; n < 2; ++n) acc[0][b][m][n] = (f32x4){0.f, 0.f, 0.f, 0.f};
        cur = nxt; cA = nA; cB = nB; ++ui;
        if (wr == 1) P1_BAR;
    }
    P1_WAIT_V(0);
    P1_BAR;
#undef P1_STG
#undef P1_STAGE
#undef P1_LDA
#undef P1_LDB
#undef P1_MMA
#undef P1_WAIT_V
#undef P1_WAIT_L
#undef P1_BAR
#undef P1_SCHED
}
}
#ifndef X_PRIO47
#define X_PRIO47 0
#endif
#ifndef X_LATE
#define X_LATE 0
#endif
namespace att {
using namespace fk;
constexpr int NW = 8, QBLK = 32, KVBLK = 64;
constexpr int SHM_V = KVBLK * 128 * 2;
template <int MODE> struct AttL { static constexpr int KSLOT = MODE ? 16384 : 24576, OFF_K = 0, OFF_V = 3 * KSLOT, OFF_WS = OFF_V + 4 * SHM_V, OFF_BIAS = OFF_WS + NW * 64 * 4, END = OFF_BIAS + 4096; };
constexpr int OSTG_PITCH = 272, OSTG_WAVE = 32 * OSTG_PITCH;
static_assert(NW * OSTG_WAVE <= AttL<0>::OFF_WS && NW * OSTG_WAVE <= AttL<1>::OFF_WS && AttL<0>::END <= 147456 && AttL<1>::END <= 147456, "attention LDS map");
constexpr float THR2 = 11.0f;
#define KSWZ(row, colB) ((row) * 256 + ((colB) ^ (((row) & 7) << 4)))
#define KRSWZ(row, colB) ((row) * 128 + ((colB) ^ (((row) & 7) << 4)))
#define SBAR() __builtin_amdgcn_sched_barrier(0)
__device__ __forceinline__ int crow(int r, int hi) { return (r & 3) + 8 * (r >> 2) + 4 * hi; }

#define F2(P, I) ((f32x2){P[I], P[(I) + 1]})
__device__ __forceinline__ float vmax3(float a, float b, float c) { float r; asm("v_max3_f32 %0, %1, %2, %3" : "=v"(r) : "v"(a), "v"(b), "v"(c)); return r; }
__device__ __forceinline__ float vmax3g(float a, float b, float c, float after) { float r; asm("v_max3_f32 %0, %1, %2, %3" : "=v"(r) : "v"(a), "v"(b), "v"(c), "v"(after)); return r; }
__device__ __forceinline__ float vmax2(float a, float b) { float r; asm("v_max_f32 %0, %1, %2" : "=v"(r) : "v"(a), "v"(b)); return r; }
__device__ __forceinline__ void softmax_ref(f32x16& p0, f32x16& p1, f32x16& negm, bool& valid, float& alpha, bf16x8& pa0, bf16x8& pa1, bf16x8& pa2, bf16x8& pa3, float& l_reg) {
  float pmax;
  {
    const float g = fmaxf(p0[15], p1[15]);
    float m0 = vmax3g(p0[0], p0[1], p0[2], g), m1 = vmax3g(p0[8], p0[9], p0[10], g), m2 = vmax3g(p1[0], p1[1], p1[2], g), m3 = vmax3g(p1[8], p1[9], p1[10], g);
    m0 = vmax3(m0, p0[3], p0[4]); m1 = vmax3(m1, p0[11], p0[12]); m2 = vmax3(m2, p1[3], p1[4]); m3 = vmax3(m3, p1[11], p1[12]);
    m0 = vmax3(m0, p0[5], p0[6]); m1 = vmax3(m1, p0[13], p0[14]); m2 = vmax3(m2, p1[5], p1[6]); m3 = vmax3(m3, p1[13], p1[14]);
    m0 = vmax3(m0, m1, p0[7]); m2 = vmax3(m2, m3, p1[7]);
    pmax = vmax3(m0, m2, g); }
  { auto rr = __builtin_amdgcn_permlane32_swap(__float_as_uint(pmax), __float_as_uint(pmax), false, false);
    pmax = vmax2(__uint_as_float(rr[0]), __uint_as_float(rr[1])); }
  alpha = 1.f;
  if (!__builtin_expect(__all(valid && pmax <= THR2), 1)) {
    const bool fin = pmax > -INFINITY;
    const float d = valid ? fmaxf(pmax, 0.f) : (fin ? pmax : 0.f);
    alpha = valid ? __builtin_amdgcn_exp2f(-d) : 1.f;
    valid = valid || fin;
#pragma unroll
    for (int r = 0; r < 16; ++r) { p0[r] -= d; p1[r] -= d; negm[r] -= d; }
  }
#pragma unroll
  for (int r = 0; r < 16; ++r) p0[r] = __builtin_amdgcn_exp2f(p0[r]);
#pragma unroll
  for (int r = 0; r < 16; ++r) p1[r] = __builtin_amdgcn_exp2f(p1[r]);
#define PK4(P, BASE, OUT) do { u32x4 w = {cvt_pk_bf16(P[BASE + 0], P[BASE + 1]), cvt_pk_bf16(P[BASE + 2], P[BASE + 3]), cvt_pk_bf16(P[BASE + 4], P[BASE + 5]), cvt_pk_bf16(P[BASE + 6], P[BASE + 7])}; \
    OUT = *reinterpret_cast<bf16x8*>(&w); } while (0)
  PK4(p0, 0, pa0); PK4(p0, 8, pa1); PK4(p1, 0, pa2); PK4(p1, 8, pa3);
#undef PK4
  {
    f32x2 t0 = F2(p0, 0) + F2(p1, 0), t1 = F2(p0, 2) + F2(p1, 2), t2 = F2(p0, 4) + F2(p1, 4), t3 = F2(p0, 6) + F2(p1, 6);
    f32x2 t4 = F2(p0, 8) + F2(p1, 8), t5 = F2(p0, 10) + F2(p1, 10), t6 = F2(p0, 12) + F2(p1, 12), t7 = F2(p0, 14) + F2(p1, 14);
    t0 += t4; t1 += t5; t2 += t6; t3 += t7; t0 += t2; t1 += t3; t0 += t1;
    l_reg = l_reg * alpha + (t0[0] + t0[1]); }
}
template <int OFF> __device__ __forceinline__ bf16x8 lds_rd128(int addr) { bf16x8 r; asm volatile("ds_read_b128 %0, %1 offset:%2" : "=v"(r) : "v"(addr), "i"(OFF)); return r; }
template <int NP> __device__ __forceinline__ void qkt_pipe(f32x16& p0, f32x16& p1, const f32x16& cinit, const int (&an)[8], const int (&ar)[4], const bf16x8* qr) {
  bf16x8 ka[4], kb[4];
#define KRD(d0) do { constexpr int s_ = (d0) & 3; \
    if constexpr ((d0) < 8) { ka[s_] = lds_rd128<0>(an[(d0) & 7]); kb[s_] = lds_rd128<8192>(an[(d0) & 7]); } \
    else { ka[s_] = lds_rd128<16384>(ar[(d0) & 3]); kb[s_] = lds_rd128<16384 + 4096>(ar[(d0) & 3]); } } while (0)
#define KMM(d0) do { constexpr int s_ = (d0) & 3; constexpr int left_ = (NP - 1 - (d0)) < 2 ? (NP - 1 - (d0)) : 2; \
    if constexpr (left_ == 2) asm volatile("s_waitcnt lgkmcnt(4)" : "+v"(ka[s_]), "+v"(kb[s_])); else if constexpr (left_ == 1) asm volatile("s_waitcnt lgkmcnt(2)" : "+v"(ka[s_]), "+v"(kb[s_])); else asm volatile("s_waitcnt lgkmcnt(0)" : "+v"(ka[s_]), "+v"(kb[s_])); \
    if constexpr ((d0) == 0) { p0 = __builtin_amdgcn_mfma_f32_32x32x16_bf16(ka[s_], qr[d0], cinit, 0, 0, 0); p1 = __builtin_amdgcn_mfma_f32_32x32x16_bf16(kb[s_], qr[d0], cinit, 0, 0, 0); } \
    else { p0 = __builtin_amdgcn_mfma_f32_32x32x16_bf16(ka[s_], qr[d0], p0, 0, 0, 0); p1 = __builtin_amdgcn_mfma_f32_32x32x16_bf16(kb[s_], qr[d0], p1, 0, 0, 0); } \
    if constexpr ((d0) + 3 < NP) KRD((d0) + 3); } while (0)
  KRD(0); KRD(1); KRD(2);
  KMM(0); KMM(1); KMM(2); KMM(3); KMM(4); KMM(5); KMM(6); KMM(7);
  if constexpr (NP > 8) { KMM(8); KMM(9); KMM(10); KMM(11); }
#undef KRD
#undef KMM
}
__device__ __forceinline__ int v_st(int k, int c) { const int kk = (k & ~0xC) | ((k & 4) << 1) | ((k & 8) >> 1); return ((kk >> 3) * 4 + (c >> 5)) * 512 + ((kk & 7) * 32 + (c & 31)) * 2; }
__device__ __forceinline__ int v_rd_base(int lane) { return ((lane & 3) << 3) | (((lane >> 2) & 3) << 6) | (((lane >> 4) & 1) << 5) | (((lane >> 5) & 1) << 8); }
constexpr int v_rd_off(int d0, int ks, int half) { return d0 * 512 + ks * 4096 + half * 2048; }
template <int OFF> __device__ __forceinline__ s16x4 tr_read(int vb) {
  s16x4 r; asm volatile("ds_read_b64_tr_b16 %0, %1 offset:%2" : "=&v"(r) : "v"(vb), "i"(OFF) : "memory"); return r;
}
struct VSet { s16x4 l[4], h[4]; };
template <int KS> __device__ __forceinline__ void v_rd_set(VSet& f, int vb) {
  f.l[0] = tr_read<v_rd_off(0, KS, 0)>(vb); f.h[0] = tr_read<v_rd_off(0, KS, 1)>(vb); f.l[1] = tr_read<v_rd_off(1, KS, 0)>(vb); f.h[1] = tr_read<v_rd_off(1, KS, 1)>(vb);
  f.l[2] = tr_read<v_rd_off(2, KS, 0)>(vb); f.h[2] = tr_read<v_rd_off(2, KS, 1)>(vb); f.l[3] = tr_read<v_rd_off(3, KS, 0)>(vb); f.h[3] = tr_read<v_rd_off(3, KS, 1)>(vb);
}
#define VWAIT(n, f) asm volatile("s_waitcnt lgkmcnt(" #n ")" : "+v"(f.l[0]), "+v"(f.h[0]), "+v"(f.l[1]), "+v"(f.h[1]), "+v"(f.l[2]), "+v"(f.h[2]), "+v"(f.l[3]), "+v"(f.h[3]))
__device__ __forceinline__ void v_mm_set(f32x16* o, const VSet& f, bf16x8 pa) {
#define PK(L, H) (bf16x8){L[0], L[1], L[2], L[3], H[0], H[1], H[2], H[3]}
  o[0] = __builtin_amdgcn_mfma_f32_32x32x16_bf16(PK(f.l[0], f.h[0]), pa, o[0], 0, 0, 0);
  o[1] = __builtin_amdgcn_mfma_f32_32x32x16_bf16(PK(f.l[1], f.h[1]), pa, o[1], 0, 0, 0);
  o[2] = __builtin_amdgcn_mfma_f32_32x32x16_bf16(PK(f.l[2], f.h[2]), pa, o[2], 0, 0, 0);
  o[3] = __builtin_amdgcn_mfma_f32_32x32x16_bf16(PK(f.l[3], f.h[3]), pa, o[3], 0, 0, 0);
#undef PK
}
__device__ __forceinline__ void pv_d0(f32x16* o, int vb, bf16x8 pa0, bf16x8 pa1, bf16x8 pa2, bf16x8 pa3) {
  VSet A, B;
  v_rd_set<0>(A, vb); v_rd_set<1>(B, vb);
  VWAIT(8, A); SBAR(); v_mm_set(o, A, pa0); SBAR(); v_rd_set<2>(A, vb);
  VWAIT(8, B); SBAR(); v_mm_set(o, B, pa1); SBAR(); v_rd_set<3>(B, vb);
  VWAIT(8, A); SBAR(); v_mm_set(o, A, pa2); SBAR();
  VWAIT(0, B); SBAR(); v_mm_set(o, B, pa3);
}
#undef VWAIT
__device__ __forceinline__ void na_bias(f32x16& p0, f32x16& p1, const LAS float* bl, int kc_lo, bool inwin) {
#pragma unroll
  for (int r = 0; r < 16; ++r) { const int k0 = (r & 3) + 8 * (r >> 2);
    const bool v0 = inwin && ((unsigned)(k0 + kc_lo) < 16u), v1 = inwin && ((unsigned)(k0 + 32 + kc_lo) < 16u);
    const float b0 = bl[k0], b1 = bl[k0 + 32];
    p0[r] = v0 ? p0[r] + b0 : -INFINITY; p1[r] = v1 ? p1[r] + b1 : -INFINITY; }
}

struct AttnArgs {
  const bf16_t* Qn; const bf16_t* Qr;
  const bf16_t* Kn; const bf16_t* Kr; const bf16_t* Vh;
  bf16_t* Ob; float* ssq;
  int NT;
  int rq0, krow0; const float* rpb;
};

template <int MODE> __device__ __forceinline__ void attn_unit(const AttnArgs& a, LAS char* lds, int wid_) {
  int wid = wid_; asm volatile("" : "+s"(wid));
  constexpr int LDQ = MODE ? NPROJ : 1536, LDK = MODE ? NPROJ : 2048, LDKR = NPROJ, NQ = MODE ? 8 : 12, ND = MODE ? 4 : 5;
  constexpr int KSLOT = AttL<MODE>::KSLOT, OFF_K = AttL<MODE>::OFF_K, OFF_V = AttL<MODE>::OFF_V, OFF_WS = AttL<MODE>::OFF_WS, OFF_BIAS = AttL<MODE>::OFF_BIAS;
  const int lane = lane_id(a.NT + a.rq0), tid = wid * 64 + lane, r32 = lane & 31, hi = lane >> 5;
  LAS char* V_lds = lds + OFF_V; LAS char* K_lds = lds + OFF_K;

  LAS float* bias_l = (LAS float*)(lds + OFF_BIAS) + 128;
  f32x16 o[4] = {}; f32x16 negm = {}; bool valid = false; float l_reg = 0.f; bf16x8 qr[NQ];
  {
    const bf16_t* Qw = a.Qn + (size_t)(wid * QBLK + r32) * LDQ + hi * 8;
#pragma unroll
    for (int d0 = 0; d0 < 8; ++d0) qr[d0] = *(const GAS bf16x8*)(Qw + d0 * 16);
    if constexpr (MODE == 0) { const bf16_t* Qx = a.Qr + (size_t)(wid * QBLK + r32) * LDQ + hi * 8;
#pragma unroll
      for (int d0 = 0; d0 < 4; ++d0) qr[8 + d0] = *(const GAS bf16x8*)(Qx + d0 * 16); }
  }
  int rq = 0, rs = 0, kc_lo = 0, blane = 0;
  if constexpr (MODE == 1) {
    for (int i = tid; i < 15 * 32; i += NW * 64) { const int dr = i >> 5, dc = i & 31; bias_l[i] = dc < 31 ? ((const GAS float*)a.rpb)[dr * 31 + dc] * LOG2E : 0.f; }
    rq = a.rq0 + (wid >> 1); rs = rq - 4; rs = rs < 0 ? 0 : (rs > 120 ? 120 : rs);
    const int c = (wid & 1) * 32 + r32; int cs = c - 8; cs = cs < 0 ? 0 : (cs > 48 ? 48 : cs);
    kc_lo = 4 * hi - cs; blane = 4 * hi - c + 15;
  }
  unsigned kof[2], vof[2], krof = 0;
#pragma unroll
  for (int e = 0; e < 2; ++e) { const int q = 2 * wid + e;
    { const int row = 4 * q + (lane >> 4), ch = (lane & 15) ^ (row & 15); kof[e] = (unsigned)(row * LDK + ch * 8); }
    { const int sub = lane >> 5, kk = (q >> 1) * 8 + ((lane >> 2) & 7), k = kk, c = ((q & 1) * 2 + sub) * 32 + (lane & 3) * 8; vof[e] = (unsigned)(k * LDK + c); } }
  if constexpr (MODE == 0) { const int row = 8 * wid + (lane >> 3), ch = (lane & 7) ^ ((row >> 1) & 7); krof = (unsigned)(row * LDKR + ch * 8); }
  const int NT = a.NT;
#define GLDS(src, dst) __builtin_amdgcn_global_load_lds((const unsigned*)(src), (LAS unsigned*)(dst), 16, 0, 0)
#define DMA_K(t, slot) do { const int t_ = (t) < NT ? (t) : NT - 1; const bf16_t* kb_ = a.Kn + (size_t)t_ * KVBLK * LDK; LAS char* kd_ = K_lds + (slot) * KSLOT + wid * 2048; \
    GLDS(kb_ + kof[0], kd_); GLDS(kb_ + kof[1], kd_ + 1024); \
    if constexpr (MODE == 0) GLDS(a.Kr + (size_t)t_ * KVBLK * LDKR + krof, K_lds + (slot) * KSLOT + 16384 + wid * 1024); } while (0)
#define DMA_V(t, slot) do { const int t_ = (t) < NT ? (t) : NT - 1; const bf16_t* vb_ = a.Vh + (size_t)t_ * KVBLK * LDK; LAS char* vd_ = V_lds + (slot) * SHM_V + wid * 2048; \
    GLDS(vb_ + vof[0], vd_); GLDS(vb_ + vof[1], vd_ + 1024); } while (0)
#define WAITBAR() do { if constexpr (MODE == 0) asm volatile("s_waitcnt vmcnt(5) lgkmcnt(0)\n\ts_barrier" ::: "memory"); else asm volatile("s_waitcnt vmcnt(4) lgkmcnt(0)\n\ts_barrier" ::: "memory"); } while (0)
  const int vb0 = (int)(unsigned)(uintptr_t)V_lds + v_rd_base(lane);
  const int kl0 = (int)(unsigned)(uintptr_t)K_lds, kxn = ((r32 & 15) << 4) ^ (hi << 4), kxr = (((r32 >> 1) & 7) << 4) ^ (hi << 4);
#define RESC(al) do { if (__any((al) < 1.f)) { _Pragma("unroll") for (int d = 0; d < 4; ++d) _Pragma("unroll") for (int r = 0; r < 16; ++r) o[d][r] *= (al); } } while (0)
#define INW(t) (MODE == 0 || ((a.krow0 + (t)) >= rs && (a.krow0 + (t)) < rs + 8))
#define QK(slot, t) do { if (INW(t)) { int an_[8], ar_[4]; const int sb_ = kl0 + (slot) * KSLOT; \
      _Pragma("unroll") for (int q_ = 0; q_ < 4; ++q_) { an_[q_] = sb_ + r32 * 256 + ((q_ << 5) ^ kxn); an_[4 + q_] = an_[q_] ^ 128; ar_[q_] = sb_ + r32 * 128 + ((q_ << 5) ^ kxr); } \
      qkt_pipe<NQ>(P0, P1, negm, an_, ar_, qr); \
      if constexpr (MODE == 1) { int dr_ = a.krow0 + (t) - rq + 7; dr_ = dr_ < 0 ? 0 : (dr_ > 14 ? 14 : dr_); na_bias(P0, P1, bias_l + dr_ * 32 + blane, kc_lo, true); } } \
    else { _Pragma("unroll") for (int r_ = 0; r_ < 16; ++r_) { P0[r_] = -INFINITY; P1[r_] = -INFINITY; } } } while (0)
#define SMX() do { float al_; softmax_ref(P0, P1, negm, valid, al_, pa0, pa1, pa2, pa3, l_reg); RESC(al_); } while (0)
#define PV(slot, t) do { if (INW(t)) pv_d0(o, vb0 + (slot) * SHM_V, pa0, pa1, pa2, pa3); } while (0)
  f32x16 P0, P1; bf16x8 pa0, pa1, pa2, pa3;
  const bool late = X_LATE == 1 ? (wid >= 4) : (X_LATE == 2 ? ((wid & 1) != 0) : false);
  if (X_PRIO47 && wid >= 4) __builtin_amdgcn_s_setprio(1);
  int ks = 0, vs = 0;
  DMA_K(0, 0); DMA_V(0, 0); DMA_K(1, 1); DMA_V(1, 1);
#define STEP_HEAD(j) WAITBAR(); DMA_K((j) + 2, ks == 0 ? 2 : ks - 1); DMA_V((j) + 2, (vs + 2) & 3)
#define STEP_TAIL() ks = (ks == 2) ? 0 : ks + 1; vs = (vs + 1) & 3
  if (!late) {
    for (int j = 0; j < NT; ++j) { STEP_HEAD(j); QK(ks, j); if (INW(j)) { SMX(); } PV(vs, j); STEP_TAIL(); }
  } else {
    STEP_HEAD(0); QK(ks, 0); STEP_TAIL();
    for (int j = 1; j < NT; ++j) { STEP_HEAD(j); SMX(); PV((vs + 3) & 3, j - 1); QK(ks, j); STEP_TAIL(); }
    SMX(); PV((vs + 3) & 3, NT - 1);
  }
#undef STEP_HEAD
#undef STEP_TAIL
  if (X_PRIO47) __builtin_amdgcn_s_setprio(0);
  asm volatile("s_waitcnt vmcnt(0)" ::: "memory");
  float rl; { auto rr = __builtin_amdgcn_permlane32_swap(__float_as_uint(l_reg), __float_as_uint(l_reg), false, false); rl = __builtin_amdgcn_rcpf(__uint_as_float(rr[0]) + __uint_as_float(rr[1])); }
  __syncthreads();
  LAS char* stg = lds + wid * OSTG_WAVE;
#pragma unroll
  for (int d0 = 0; d0 < 4; ++d0)
#pragma unroll
    for (int g = 0; g < 4; ++g) { u32x2 w; w.x = cvt_pk_bf16(o[d0][4 * g] * rl, o[d0][4 * g + 1] * rl); w.y = cvt_pk_bf16(o[d0][4 * g + 2] * rl, o[d0][4 * g + 3] * rl);
      *(LAS u32x2*)(stg + r32 * OSTG_PITCH + (d0 * 32 + 8 * g + 4 * hi) * 2) = w; }
  asm volatile("s_waitcnt lgkmcnt(0)" ::: "memory");
#pragma unroll
  for (int i = 0; i < 8; ++i) { const int row = i * 4 + (lane >> 4), ch = lane & 15;
    const u32x4 v = *(const LAS u32x4*)(stg + row * OSTG_PITCH + ch * 16);
    *(GAS u32x4*)(a.Ob + (size_t)(wid * QBLK + row) * DM + ch * 8) = v;
    float q = (bf_lo(v.x) * bf_lo(v.x) + bf_hi(v.x) * bf_hi(v.x)) + (bf_lo(v.y) * bf_lo(v.y) + bf_hi(v.y) * bf_hi(v.y)) + (bf_lo(v.z) * bf_lo(v.z) + bf_hi(v.z) * bf_hi(v.z)) + (bf_lo(v.w) * bf_lo(v.w) + bf_hi(v.w) * bf_hi(v.w));
    q += shx(q, 1, lane); q += shx(q, 2, lane); q += shx(q, 4, lane); q += shx(q, 8, lane);
    if (ch == 0) ((GAS float*)a.ssq)[(size_t)(wid * QBLK + row) * 16] = q; }
  asm volatile("s_waitcnt lgkmcnt(0)" ::: "memory");
  __syncthreads();
#undef GLDS
#undef SMX
#undef DMA_K
#undef DMA_V
#undef WAITBAR
#undef RESC
#undef INW
#undef QK
#undef PV
}
#undef KSWZ
#undef KRSWZ
#undef SBAR
}
namespace att {
#define SBAR() __builtin_amdgcn_sched_barrier(0)
template <int N> __device__ __forceinline__ void lgk_wait_tied(bf16x8& f) { asm volatile("s_waitcnt lgkmcnt(%1)" : "+v"(f) : "n"(N)); }
struct VSet16 { s16x4 l[4], h[4]; };
template <int N> struct IC16 { static constexpr int value = N; };
__device__ __forceinline__ float vmax3gu(float a, float b, float c, unsigned after) { float r; asm("v_max3_f32 %0, %1, %2, %3" : "=v"(r) : "v"(a), "v"(b), "v"(c), "v"(after)); return r; }

template <int MODE, int PARW> __device__ __forceinline__ void attn_unit16(const AttnArgs& a, LAS char* lds, int wid_) {
  int wid = wid_; asm volatile("" : "+s"(wid));
  constexpr int LDQ = MODE ? NPROJ : 1536, LDK = MODE ? NPROJ : 2048, LDKR = NPROJ, NDC = MODE ? 4 : 6, NI = 4 * NDC;
  constexpr int KSLOT = AttL<MODE>::KSLOT, OFF_K = AttL<MODE>::OFF_K, OFF_V = AttL<MODE>::OFF_V, OFF_BIAS = AttL<MODE>::OFF_BIAS;
  const int lane = lane_id(a.NT + a.rq0), tid = wid * 64 + lane, c16 = lane & 15, g = lane >> 4;
  LAS char* V_lds = lds + OFF_V; LAS char* K_lds = lds + OFF_K;
  LAS float* bias_l = (LAS float*)(lds + OFF_BIAS) + 128;
  f32x4 o[8][2]; f32x4 cinit[2]; bool valid0 = false, valid1 = false; float l0 = 0.f, l1 = 0.f; bf16x8 qf[2][NDC];
#pragma unroll
  for (int db = 0; db < 8; ++db) { o[db][0] = (f32x4){0.f, 0.f, 0.f, 0.f}; o[db][1] = (f32x4){0.f, 0.f, 0.f, 0.f}; }
  cinit[0] = (f32x4){0.f, 0.f, 0.f, 0.f}; cinit[1] = (f32x4){0.f, 0.f, 0.f, 0.f};
#pragma unroll
  for (int qb = 0; qb < 2; ++qb) {
    const bf16_t* Qw = a.Qn + (size_t)(wid * QBLK + 16 * qb + c16) * LDQ + g * 8;
#pragma unroll
    for (int dc = 0; dc < 4; ++dc) qf[qb][dc] = *(const GAS bf16x8*)(Qw + dc * 32);
    if constexpr (MODE == 0) { const bf16_t* Qx = a.Qr + (size_t)(wid * QBLK + 16 * qb + c16) * LDQ + g * 8;
#pragma unroll
      for (int dc = 0; dc < 2; ++dc) qf[qb][4 + dc] = *(const GAS bf16x8*)(Qx + dc * 32); }
  }
  int rq = 0, rs = 0, klo0 = 0, klo1 = 0, bof0 = 0, bof1 = 0;
  if constexpr (MODE == 1) {
    for (int i = tid; i < 15 * 32; i += NW * 64) { const int dr = i >> 5, dc = i & 31; bias_l[i] = dc < 31 ? ((const GAS float*)a.rpb)[dr * 31 + dc] * LOG2E : 0.f; }
    rq = a.rq0 + (wid >> 1); rs = rq - 4; rs = rs < 0 ? 0 : (rs > 120 ? 120 : rs);
    const int c0 = (wid & 1) * 32 + c16, c1 = c0 + 16; int cs0 = c0 - 8, cs1 = c1 - 8; cs0 = cs0 < 0 ? 0 : (cs0 > 48 ? 48 : cs0); cs1 = cs1 < 0 ? 0 : (cs1 > 48 ? 48 : cs1);
    klo0 = 4 * g - cs0; klo1 = 4 * g - cs1; bof0 = 4 * g - c0 + 15; bof1 = 4 * g - c1 + 15;
  }
  unsigned kof[2], vof[2], krof = 0;
#pragma unroll
  for (int e = 0; e < 2; ++e) { const int q = 2 * wid + e, row = 4 * q + (lane >> 4);
    { const int ch = (lane & 15) ^ (row & 15); kof[e] = (unsigned)(row * LDK + ch * 8); }
    { const int ch = (lane & 15) ^ (2 * (row & 7)); vof[e] = (unsigned)(row * LDK + ch * 8); } }
  if constexpr (MODE == 0) { const int row = 8 * wid + (lane >> 3), ch = (lane & 7) ^ ((row >> 1) & 7); krof = (unsigned)(row * LDKR + ch * 8); }
  const int NT = a.NT;
#define GLDS(src, dst) __builtin_amdgcn_global_load_lds((const unsigned*)(src), (LAS unsigned*)(dst), 16, 0, 0)
#define DMA_K(t, slot) do { const int t_ = (t) < NT ? (t) : NT - 1; const bf16_t* kb_ = a.Kn + (size_t)t_ * KVBLK * LDK; LAS char* kd_ = K_lds + (slot) * KSLOT + wid * 2048; \
    GLDS(kb_ + kof[0], kd_); GLDS(kb_ + kof[1], kd_ + 1024); \
    if constexpr (MODE == 0) GLDS(a.Kr + (size_t)t_ * KVBLK * LDKR + krof, K_lds + (slot) * KSLOT + 16384 + wid * 1024); } while (0)
#define DMA_V(t, slot) do { const int t_ = (t) < NT ? (t) : NT - 1; const bf16_t* vb_ = a.Vh + (size_t)t_ * KVBLK * LDK; LAS char* vd_ = V_lds + (slot) * SHM_V + wid * 2048; \
    GLDS(vb_ + vof[0], vd_); GLDS(vb_ + vof[1], vd_ + 1024); } while (0)
#define WAITBAR() do { if constexpr (MODE == 0) asm volatile("s_waitcnt vmcnt(5) lgkmcnt(0)\n\ts_barrier" ::: "memory"); else asm volatile("s_waitcnt vmcnt(4) lgkmcnt(0)\n\ts_barrier" ::: "memory"); } while (0)
#define INW(t) (MODE == 0 || ((a.krow0 + (t)) >= rs && (a.krow0 + (t)) < rs + 8))
  const int kl0 = (int)(unsigned)(uintptr_t)K_lds;
  const int vX = ((c16 >> 1) & 1) ^ (8 * (g & 1) + 2 * (c16 >> 2));
  const int vb0 = (int)(unsigned)(uintptr_t)V_lds + 256 * (4 * g + (c16 >> 2)) + 16 * vX + 8 * (c16 & 1);
  int ks = 0, vs = 0;
  if (X_PRIO47 && wid >= 4) __builtin_amdgcn_s_setprio(1);
  DMA_K(0, 0); DMA_V(0, 0); DMA_K(1, 1); DMA_V(1, 1);
#define STEP_HEAD(j) WAITBAR(); DMA_K((j) + 2, ks == 0 ? 2 : ks - 1); DMA_V((j) + 2, (vs + 2) & 3)
#define STEP_TAIL() ks = (ks == 2) ? 0 : ks + 1; vs = (vs + 1) & 3
  auto step = [&](auto par_, const int j) __attribute__((always_inline)) {
      constexpr int PAR = decltype(par_)::value;
#define LIVE(kb, qb) (PAR < 0 || (PAR == 0 ? !(((qb) == 0 && (kb) >= 2) || ((qb) == 1 && (kb) == 3)) : !(((qb) == 0 && (kb) == 0) || ((qb) == 1 && (kb) <= 1))))
#define CLIVE(c, qb) (LIVE(2 * (c), qb) || LIVE(2 * (c) + 1, qb))
      f32x4 S[4][2];
      { const int sb_ = kl0 + ks * KSLOT;
        int an_[4], ar_[2];
#pragma unroll
        for (int dc = 0; dc < 4; ++dc) an_[dc] = sb_ + c16 * 256 + (((4 * dc + g) ^ c16) << 4);
#pragma unroll
        for (int dc = 0; dc < 2; ++dc) ar_[dc] = sb_ + 16384 + c16 * 128 + (((4 * dc + g) ^ ((c16 >> 1) & 7)) << 4);
        (void)ar_;
        bf16x8 kf[8];
#define KRD16(idx) do { constexpr int dc_ = (idx) >> 2, kb_ = (idx) & 3; \
          if constexpr (dc_ < 4) kf[(idx) & 7] = lds_rd128<kb_ * 4096>(an_[dc_ & 3]); else kf[(idx) & 7] = lds_rd128<kb_ * 2048>(ar_[dc_ & 1]); } while (0)
#define KMM16(idx) do { constexpr int dc_ = (idx) >> 2, kb_ = (idx) & 3; constexpr int left_ = (NI - 1 - (idx)) < 7 ? (NI - 1 - (idx)) : 7; \
          lgk_wait_tied<left_>(kf[(idx) & 7]); \
          if constexpr (dc_ == 0) { if constexpr (LIVE(kb_, 0)) S[kb_][0] = __builtin_amdgcn_mfma_f32_16x16x32_bf16(kf[(idx) & 7], qf[0][0], cinit[0], 0, 0, 0); \
                                    if constexpr (LIVE(kb_, 1)) S[kb_][1] = __builtin_amdgcn_mfma_f32_16x16x32_bf16(kf[(idx) & 7], qf[1][0], cinit[1], 0, 0, 0); } \
          else { if constexpr (LIVE(kb_, 0)) S[kb_][0] = __builtin_amdgcn_mfma_f32_16x16x32_bf16(kf[(idx) & 7], qf[0][dc_], S[kb_][0], 0, 0, 0); \
                 if constexpr (LIVE(kb_, 1)) S[kb_][1] = __builtin_amdgcn_mfma_f32_16x16x32_bf16(kf[(idx) & 7], qf[1][dc_], S[kb_][1], 0, 0, 0); } \
          if constexpr ((idx) + 8 < NI) KRD16((idx) + 8); } while (0)
        KRD16(0); KRD16(1); KRD16(2); KRD16(3); KRD16(4); KRD16(5); KRD16(6); KRD16(7);
        KMM16(0); KMM16(1); KMM16(2); KMM16(3); KMM16(4); KMM16(5); KMM16(6); KMM16(7);
        KMM16(8); KMM16(9); KMM16(10); KMM16(11); KMM16(12); KMM16(13); KMM16(14); KMM16(15);
        if constexpr (NDC > 4) { KMM16(16); KMM16(17); KMM16(18); KMM16(19); KMM16(20); KMM16(21); KMM16(22); KMM16(23); }
#undef KRD16
#undef KMM16
      }
      float pm0, pm1;
      if constexpr (MODE == 1) {
        int dr_ = a.krow0 + j - rq + 7; dr_ = dr_ < 0 ? 0 : (dr_ > 14 ? 14 : dr_);
        const LAS float* bl0 = bias_l + dr_ * 32 + bof0; const LAS float* bl1 = bias_l + dr_ * 32 + bof1;
        pm0 = -INFINITY; pm1 = -INFINITY;
#pragma unroll
        for (int kb = 0; kb < 4; ++kb) {
          if (LIVE(kb, 0)) {
#pragma unroll
            for (int i = 0; i < 4; ++i) { const int k0 = 16 * kb + i; const float b0 = bl0[k0]; const bool v0 = (unsigned)(k0 + klo0) < 16u; S[kb][0][i] = v0 ? S[kb][0][i] + b0 : -INFINITY; }
            pm0 = vmax3(pm0, S[kb][0][0], S[kb][0][1]); pm0 = vmax3(pm0, S[kb][0][2], S[kb][0][3]); }
          if (LIVE(kb, 1)) {
#pragma unroll
            for (int i = 0; i < 4; ++i) { const int k0 = 16 * kb + i; const float b1 = bl1[k0]; const bool v1 = (unsigned)(k0 + klo1) < 16u; S[kb][1][i] = v1 ? S[kb][1][i] + b1 : -INFINITY; }
            pm1 = vmax3(pm1, S[kb][1][0], S[kb][1][1]); pm1 = vmax3(pm1, S[kb][1][2], S[kb][1][3]); }
        }
      } else {
      {
        const unsigned gd = (__float_as_uint(S[0][0][3]) | __float_as_uint(S[1][0][3]) | __float_as_uint(S[2][0][3])) | (__float_as_uint(S[3][0][3]) | __float_as_uint(S[0][1][3]) | __float_as_uint(S[1][1][3])) | (__float_as_uint(S[2][1][3]) | __float_as_uint(S[3][1][3]));
        float a0 = vmax3gu(S[0][0][0], S[0][0][1], S[0][0][2], gd), b0 = vmax3gu(S[2][0][0], S[2][0][1], S[2][0][2], gd), a1 = vmax3gu(S[0][1][0], S[0][1][1], S[0][1][2], gd), b1 = vmax3gu(S[2][1][0], S[2][1][1], S[2][1][2], gd);
        a0 = vmax3(a0, S[0][0][3], S[1][0][0]); b0 = vmax3(b0, S[2][0][3], S[3][0][0]); a1 = vmax3(a1, S[0][1][3], S[1][1][0]); b1 = vmax3(b1, S[2][1][3], S[3][1][0]);
        a0 = vmax3(a0, S[1][0][1], S[1][0][2]); b0 = vmax3(b0, S[3][0][1], S[3][0][2]); a1 = vmax3(a1, S[1][1][1], S[1][1][2]); b1 = vmax3(b1, S[3][1][1], S[3][1][2]);
        a0 = vmax3(a0, b0, S[1][0][3]); a1 = vmax3(a1, b1, S[1][1][3]);
        pm0 = vmax2(a0, S[3][0][3]); pm1 = vmax2(a1, S[3][1][3]); }
      }
      { auto r0 = __builtin_amdgcn_permlane16_swap(__float_as_uint(pm0), __float_as_uint(pm0), false, false); pm0 = vmax2(__uint_as_float(r0[0]), __uint_as_float(r0[1]));
        auto r1 = __builtin_amdgcn_permlane16_swap(__float_as_uint(pm1), __float_as_uint(pm1), false, false); pm1 = vmax2(__uint_as_float(r1[0]), __uint_as_float(r1[1]));
        auto s0 = __builtin_amdgcn_permlane32_swap(__float_as_uint(pm0), __float_as_uint(pm0), false, false); pm0 = vmax2(__uint_as_float(s0[0]), __uint_as_float(s0[1]));
        auto s1 = __builtin_amdgcn_permlane32_swap(__float_as_uint(pm1), __float_as_uint(pm1), false, false); pm1 = vmax2(__uint_as_float(s1[0]), __uint_as_float(s1[1])); }
      if (!__builtin_expect(__all(valid0 && valid1 && pm0 <= THR2 && pm1 <= THR2), 1)) {
        { const bool fin = pm0 > -INFINITY; const float d = valid0 ? fmaxf(pm0, 0.f) : (fin ? pm0 : 0.f); const float al = valid0 ? __builtin_amdgcn_exp2f(-d) : 1.f; valid0 = valid0 || fin;
#pragma unroll
          for (int kb = 0; kb < 4; ++kb) if (LIVE(kb, 0)) S[kb][0] -= d;
          cinit[0] -= d; l0 *= al;
          if (__any(al < 1.f)) {
#pragma unroll
            for (int db = 0; db < 8; ++db) o[db][0] *= al; } }
        { const bool fin = pm1 > -INFINITY; const float d = valid1 ? fmaxf(pm1, 0.f) : (fin ? pm1 : 0.f); const float al = valid1 ? __builtin_amdgcn_exp2f(-d) : 1.f; valid1 = valid1 || fin;
#pragma unroll
          for (int kb = 0; kb < 4; ++kb) if (LIVE(kb, 1)) S[kb][1] -= d;
          cinit[1] -= d; l1 *= al;
          if (__any(al < 1.f)) {
#pragma unroll
            for (int db = 0; db < 8; ++db) o[db][1] *= al; } }
      }
#pragma unroll
      for (int kb = 0; kb < 4; ++kb)
#pragma unroll
        for (int qb = 0; qb < 2; ++qb)
          if (LIVE(kb, qb)) {
#pragma unroll
            for (int i = 0; i < 4; ++i) S[kb][qb][i] = __builtin_amdgcn_exp2f(S[kb][qb][i]); }
      bf16x8 pa[2][2];
      const f32x4 zero4 = {0.f, 0.f, 0.f, 0.f};
#pragma unroll
      for (int qb = 0; qb < 2; ++qb)
#pragma unroll
        for (int c = 0; c < 2; ++c) if (CLIVE(c, qb)) { const u32x4 w = pack8(LIVE(2 * c, qb) ? S[2 * c][qb] : zero4, LIVE(2 * c + 1, qb) ? S[2 * c + 1][qb] : zero4); pa[qb][c] = *reinterpret_cast<const bf16x8*>(&w); }
      { f32x4 t0 = zero4, t1 = zero4;
        if constexpr (PAR < 0) { t0 = (S[0][0] + S[1][0]) + (S[2][0] + S[3][0]); t1 = (S[0][1] + S[1][1]) + (S[2][1] + S[3][1]); }
        else {
#pragma unroll
          for (int kb = 0; kb < 4; ++kb) { if (LIVE(kb, 0)) t0 += S[kb][0]; if (LIVE(kb, 1)) t1 += S[kb][1]; } }
        l0 += (t0[0] + t0[1]) + (t0[2] + t0[3]); l1 += (t1[0] + t1[1]) + (t1[2] + t1[3]); }
      { const int vb = vb0 + vs * SHM_V;
        int va[8];
#pragma unroll
        for (int db = 0; db < 8; ++db) va[db] = vb ^ (32 * db);
        VSet16 A, B;
#define VRD16(f, c_, dbh_) do { _Pragma("unroll") for (int n_ = 0; n_ < 4; ++n_) { f.l[n_] = tr_read<(c_) * 8192>(va[4 * (dbh_) + n_]); f.h[n_] = tr_read<(c_) * 8192 + 4096>(va[4 * (dbh_) + n_]); } } while (0)
#define VWAIT16(n, f) asm volatile("s_waitcnt lgkmcnt(" #n ")" : "+v"(f.l[0]), "+v"(f.h[0]), "+v"(f.l[1]), "+v"(f.h[1]), "+v"(f.l[2]), "+v"(f.h[2]), "+v"(f.l[3]), "+v"(f.h[3]))
#define PKV(L, H) (bf16x8){L[0], L[1], L[2], L[3], H[0], H[1], H[2], H[3]}
#define VMM16(f, c_, dbh_) do { _Pragma("unroll") for (int n_ = 0; n_ < 4; ++n_) { const bf16x8 vf_ = PKV(f.l[n_], f.h[n_]); \
            if constexpr (CLIVE(c_, 0)) o[4 * (dbh_) + n_][0] = __builtin_amdgcn_mfma_f32_16x16x32_bf16(vf_, pa[0][c_], o[4 * (dbh_) + n_][0], 0, 0, 0); \
            if constexpr (CLIVE(c_, 1)) o[4 * (dbh_) + n_][1] = __builtin_amdgcn_mfma_f32_16x16x32_bf16(vf_, pa[1][c_], o[4 * (dbh_) + n_][1], 0, 0, 0); } } while (0)
        VRD16(A, 0, 0); VRD16(B, 0, 1);
        VWAIT16(8, A); SBAR(); VMM16(A, 0, 0); SBAR(); VRD16(A, 1, 0);
        VWAIT16(8, B); SBAR(); VMM16(B, 0, 1); SBAR(); VRD16(B, 1, 1);
        VWAIT16(8, A); SBAR(); VMM16(A, 1, 0); SBAR();
        VWAIT16(0, B); SBAR(); VMM16(B, 1, 1);
#undef VRD16
#undef VWAIT16
#undef VMM16
#undef PKV
      }
#undef LIVE
#undef CLIVE
  };
  for (int j = 0; j < NT; ++j) { STEP_HEAD(j); if (INW(j)) step(IC16<PARW>{}, j); STEP_TAIL(); }
#undef STEP_HEAD
#undef STEP_TAIL
  if (X_PRIO47) __builtin_amdgcn_s_setprio(0);
  asm volatile("s_waitcnt vmcnt(0)" ::: "memory");
  float rl0, rl1;
  { auto r0 = __builtin_amdgcn_permlane16_swap(__float_as_uint(l0), __float_as_uint(l0), false, false); l0 = __uint_as_float(r0[0]) + __uint_as_float(r0[1]);
    auto r1 = __builtin_amdgcn_permlane16_swap(__float_as_uint(l1), __float_as_uint(l1), false, false); l1 = __uint_as_float(r1[0]) + __uint_as_float(r1[1]);
    auto s0 = __builtin_amdgcn_permlane32_swap(__float_as_uint(l0), __float_as_uint(l0), false, false); rl0 = __builtin_amdgcn_rcpf(__uint_as_float(s0[0]) + __uint_as_float(s0[1]));
    auto s1 = __builtin_amdgcn_permlane32_swap(__float_as_uint(l1), __float_as_uint(l1), false, false); rl1 = __builtin_amdgcn_rcpf(__uint_as_float(s1[0]) + __uint_as_float(s1[1])); }
  __syncthreads();
  LAS char* stg = lds + wid * OSTG_WAVE;
#pragma unroll
  for (int db = 0; db < 8; ++db) {
    { u32x2 w; w.x = cvt_pk_bf16(o[db][0][0] * rl0, o[db][0][1] * rl0); w.y = cvt_pk_bf16(o[db][0][2] * rl0, o[db][0][3] * rl0); *(LAS u32x2*)(stg + c16 * OSTG_PITCH + (16 * db + 4 * g) * 2) = w; }
    { u32x2 w; w.x = cvt_pk_bf16(o[db][1][0] * rl1, o[db][1][1] * rl1); w.y = cvt_pk_bf16(o[db][1][2] * rl1, o[db][1][3] * rl1); *(LAS u32x2*)(stg + (16 + c16) * OSTG_PITCH + (16 * db + 4 * g) * 2) = w; }
  }
  asm volatile("s_waitcnt lgkmcnt(0)" ::: "memory");
#pragma unroll
  for (int i = 0; i < 8; ++i) { const int row = i * 4 + (lane >> 4), ch = lane & 15;
    const u32x4 v = *(const LAS u32x4*)(stg + row * OSTG_PITCH + ch * 16);
    *(GAS u32x4*)(a.Ob + (size_t)(wid * QBLK + row) * DM + ch * 8) = v;
    float q = (bf_lo(v.x) * bf_lo(v.x) + bf_hi(v.x) * bf_hi(v.x)) + (bf_lo(v.y) * bf_lo(v.y) + bf_hi(v.y) * bf_hi(v.y)) + (bf_lo(v.z) * bf_lo(v.z) + bf_hi(v.z) * bf_hi(v.z)) + (bf_lo(v.w) * bf_lo(v.w) + bf_hi(v.w) * bf_hi(v.w));
    q += shx(q, 1, lane); q += shx(q, 2, lane); q += shx(q, 4, lane); q += shx(q, 8, lane);
    if (ch == 0) ((GAS float*)a.ssq)[(size_t)(wid * QBLK + row) * 16] = q; }
  asm volatile("s_waitcnt lgkmcnt(0)" ::: "memory");
  __syncthreads();
#undef GLDS
#undef DMA_K
#undef DMA_V
#undef WAITBAR
#undef INW
}
#undef SBAR
}
#ifndef X_NTW
#define X_NTW 1
#endif
#ifndef X_LOCALFINAL
#define X_LOCALFINAL 1
#endif
#ifndef X_EARLYINV
#define X_EARLYINV 1
#endif
#ifndef X_REP0
#define X_REP0 0
#endif
#ifndef X_REPATT
#define X_REPATT 0
#endif
#ifndef X_REPG
#define X_REPG 0
#endif
#ifndef X_DUMMY_K
#define X_DUMMY_K 0
#endif
#ifndef X_DUMMY_NOEPI
#define X_DUMMY_NOEPI 0
#endif
#ifndef X_XCDLOCAL
#define X_XCDLOCAL 1
#endif
#ifndef X_REQUIRE_XMODE
#define X_REQUIRE_XMODE 0
#endif
#ifndef X_ATTLOCAL
#define X_ATTLOCAL 1
#endif
#ifndef X_BM128
#define X_BM128 1
#endif
#ifndef X_REPMASK
#define X_REPMASK 0
#endif
#define XREP(k) ((((X_REPMASK) >> (k)) & 1) ? 2 : 1)
namespace fk {
constexpr int NWAVES = 8;
constexpr size_t MiB = 1u << 20;
constexpr size_t WS_CTL = 0, CTL_ZERO_BYTES = 64 * 1024;
constexpr size_t WS_SSQX = 1 * MiB;
constexpr size_t WS_SSQC = 2 * MiB;
constexpr size_t WS_SSQY = 2 * MiB + 512 * 1024;
constexpr size_t WS_CTAB = 3 * MiB, WS_STAB = 4 * MiB;
constexpr size_t WS_W = 8 * MiB, W_LAYER = 101 * MiB;
constexpr size_t WL_IN = 0, WL_UQ = 16 * MiB, WL_UKV = 17 * MiB + 512 * 1024, WL_OUT = 18 * MiB + 512 * 1024, WL_QK = 26 * MiB + 512 * 1024, WL_VO = 30 * MiB + 512 * 1024,
                 WL_GU = 34 * MiB + 512 * 1024, WL_DN = 78 * MiB + 512 * 1024;
constexpr size_t WS_XB = 412 * MiB;
constexpr size_t WS_PROJ = 444 * MiB;
constexpr size_t WS_QM = 508 * MiB;
constexpr size_t WS_KNVM = 532 * MiB;
constexpr size_t WS_Y = 564 * MiB;
constexpr size_t WS_P = 596 * MiB;
constexpr size_t WS_TMP = 612 * MiB, T_LAYER = 35 * MiB;
constexpr size_t TL_XQ = 0, TL_XKV = 8 * MiB, TL_XO = 24 * MiB, TL_MEMN = 32 * MiB, TL_KVMEM = 33 * MiB;
constexpr size_t WS_H = 612 * MiB;
constexpr size_t WS_END = 752 * MiB;
static_assert(WS_W + 4 * W_LAYER <= WS_XB && WS_TMP + 4 * T_LAYER <= WS_END && WS_H + (size_t)S * DFF * 2 <= WS_END, "d_ws map");
constexpr int CW_BAR = 4096;
constexpr int RING_BYTES = 147456, EX_OFF = RING_BYTES, MISC_OFF = EX_OFF + 8192, LDS_BYTES = 159744;

#define RLX_AGENT __ATOMIC_RELAXED, __HIP_MEMORY_SCOPE_AGENT
#define LDS_WAIT() asm volatile("s_waitcnt lgkmcnt(0)" ::: "memory")
#define XB_TMO      128
#define XB_XCNT(j)  (256  + 64 * (j))
#define XB_XSUB(j)  (1280 + 64 * (j))
#define XB_XGEN(j)  (2304 + 64 * (j))
#define XB_TOP      3328
#define XB_TOPGEN   3392
#define XB_LSUB(j)  (3456 + 64 * (j))
#define XCD_BAR_WORDS 7552
#define XB_SPIN_CAP (1u << 18)
__device__ __forceinline__ unsigned xb_ld(unsigned* p)              { return __hip_atomic_load(p, __ATOMIC_RELAXED, __HIP_MEMORY_SCOPE_AGENT); }
__device__ __forceinline__ unsigned xb_add(unsigned* p, unsigned v) { return __hip_atomic_fetch_add(p, v, __ATOMIC_RELAXED, __HIP_MEMORY_SCOPE_AGENT); }
__device__ __forceinline__ unsigned xb_xcc_id() { return (unsigned)__builtin_amdgcn_s_getreg((3 << 11) | 20) & 0xFu; }
#define XB_SPIN(cond, bar) do { unsigned _sp = 0; while (cond) { __builtin_amdgcn_s_sleep(1); \
    if ((++_sp & 255u) == 0u) { if (xb_ld(&(bar)[XB_TMO])) break; if (_sp > XB_SPIN_CAP) { atomicAdd(&(bar)[XB_TMO], 1u); break; } } } } while (0)
struct XcdBarrier { unsigned* bar; unsigned x; volatile LAS unsigned* st; };
__device__ __forceinline__ XcdBarrier xcd_barrier_post(unsigned* bar, volatile LAS unsigned* st, int wave) {
    XcdBarrier b; b.bar = bar; b.x = xb_xcc_id(); b.st = st;
    if (wave == 0 && lane_id() == 0) st[2] = xb_add(&bar[XB_XCNT(b.x)], 1u);
    return b;
}
__device__ __forceinline__ void xcd_topology(const XcdBarrier& b, int wave) {
    if (wave == 0 && lane_id() == 0) {
        unsigned nx = 0u, ok = 1u, xi = 0u;
#pragma unroll
        for (unsigned j = 0; j < 16; ++j) { const unsigned c = xb_ld(&b.bar[XB_XCNT(j)]); if (c) { ++nx; if (c != 32u) ok = 0u; if (j < b.x) ++xi; } }
        if (nx != 8u || gridDim.x != 256u) ok = 0u;
        b.st[3] = ok; b.st[4] = xi;
    }
    __syncthreads();
}
__device__ __forceinline__ void xcd_local_barrier(const XcdBarrier& b, int wave, int grp) {
    asm volatile("s_waitcnt vmcnt(0)" ::: "memory");
    __syncthreads();
    if (wave == 0 && lane_id() == 0) {
        unsigned* c = &b.bar[XB_LSUB(4 * b.x + grp)];
        const unsigned target = b.st[6] + 8u; b.st[6] = target;
        (void)xb_add(c, 1u);
#if X_EARLYINV
        asm volatile("buffer_inv sc1" ::: "memory");
        XB_SPIN(xb_ld(c) < target, b.bar);
#else
        XB_SPIN(xb_ld(c) < target, b.bar);
        __builtin_amdgcn_fence(__ATOMIC_ACQUIRE, "agent");
#endif
        asm volatile("s_waitcnt vmcnt(0)" ::: "memory");
    }
    __syncthreads();
}
__device__ __forceinline__ void xcd_barrier_complete(unsigned* bar, unsigned x, unsigned& nloc, unsigned& nx) {
    const unsigned G = gridDim.x * gridDim.y * gridDim.z;
    unsigned sum, cnt, mine, sp = 0u;
    for (;;) {
        sum = 0u; cnt = 0u; mine = 0u;
#pragma unroll
        for (unsigned j = 0; j < 16; ++j) { const unsigned c = xb_ld(&bar[XB_XCNT(j)]); sum += c; cnt += (c > 0u) ? 1u : 0u; mine = (j == x) ? c : mine; }
        if (sum == G) break;
        __builtin_amdgcn_s_sleep(1);
        if ((++sp & 255u) == 0u) { if (xb_ld(&bar[XB_TMO])) break; if (sp > XB_SPIN_CAP) { atomicAdd(&bar[XB_TMO], 1u); break; } }
    }
    nloc = mine > 0u ? mine : 1u; nx = cnt > 0u ? cnt : 1u;
}
__device__ __forceinline__ void xcd_barrier(const XcdBarrier& b, int wave) {
    asm volatile("s_waitcnt vmcnt(0)" ::: "memory");
    __syncthreads();
    if (wave == 0 && lane_id() == 0) {
        unsigned* bar = b.bar;
        __builtin_amdgcn_s_waitcnt(0);
        unsigned nloc = b.st[0], nx = b.st[1];
        if (nloc == 0u) { xcd_barrier_complete(bar, b.x, nloc, nx); b.st[0] = nloc; b.st[1] = nx; }
        const unsigned old = xb_add(&bar[XB_XSUB(b.x)], 1u);
        const unsigned gen = old / nloc;
        if (old + 1u == (gen + 1u) * nloc) {
            __builtin_amdgcn_fence(__ATOMIC_RELEASE, "agent");
            asm volatile("s_waitcnt vmcnt(0)" ::: "memory");
            const unsigned og = xb_add(&bar[XB_TOP], 1u);
            const unsigned tg = og / nx;
            if (og + 1u == (tg + 1u) * nx) xb_add(&bar[XB_TOPGEN], 1u);
            else XB_SPIN(xb_ld(&bar[XB_TOPGEN]) == tg, bar);
            __builtin_amdgcn_fence(__ATOMIC_ACQUIRE, "agent");
            xb_add(&bar[XB_XGEN(b.x)], 1u);
            asm volatile("s_waitcnt vmcnt(0)" ::: "memory");
        } else {
            XB_SPIN(xb_ld(&bar[XB_XGEN(b.x)]) == gen, bar);
            __builtin_amdgcn_fence(__ATOMIC_ACQUIRE, "agent");
            asm volatile("s_waitcnt vmcnt(0)" ::: "memory");
        }
    }
    __syncthreads();
}

__device__ __forceinline__ int tr_dloc(int kind, int c) { return kind == 1 ? (2 * (c & 31) + (c >> 5)) : c; }
__device__ __forceinline__ void tr_item64(const float* W, int ldw, int K, bf16_t* WT, int kind, const float* gain, float cscale, LAS unsigned char* scr, int kb, int s0, int dbase, int lane) {
    const int k0 = 64 * kb, nb = lane & 15, kq = lane >> 4;
    f32x4 v[4][4];
#pragma unroll
    for (int i = 0; i < 4; ++i)
#pragma unroll
        for (int j = 0; j < 4; ++j) v[i][j] = __builtin_nontemporal_load((const GAS f32x4*)(W + (size_t)(k0 + 4 * (kq + 4 * i) + j) * ldw + s0 + 4 * nb));
#pragma unroll
    for (int i = 0; i < 4; ++i) {
        const int kk = 4 * (kq + 4 * i);
        f32x4 g = (f32x4){cscale, cscale, cscale, cscale};
        if (gain) g = *(const GAS f32x4*)(gain + k0 + kk) * cscale;
#pragma unroll
        for (int e = 0; e < 4; ++e) {
            u32x2 w; w.x = cvt_pk_bf16(v[i][0][e] * g[0], v[i][1][e] * g[1]); w.y = cvt_pk_bf16(v[i][2][e] * g[2], v[i][3][e] * g[3]);
            *(LAS u32x2*)(scr + tr_dloc(kind, 4 * nb + e) * 144 + kk * 2) = w;
        }
    }
    LDS_WAIT(); asm volatile("" ::: "memory");
#pragma unroll
    for (int i = 0; i < 8; ++i) { const int n = (lane >> 3) + 8 * i, ch = lane & 7;
        const u32x4 o = *(const LAS u32x4*)(scr + n * 144 + ch * 16);
        if (X_NTW) __builtin_nontemporal_store(o, (GAS u32x4*)(WT + (size_t)(dbase + n) * K + k0 + 8 * ch)); else *(GAS u32x4*)(WT + (size_t)(dbase + n) * K + k0 + 8 * ch) = o; }
    LDS_WAIT(); asm volatile("" ::: "memory");
}
__device__ __forceinline__ float wave_sum(float v, int lane) {
#pragma unroll
    for (int o = 1; o < 64; o <<= 1) v += shx(v, o, lane);
    return v;
}

#ifndef X_NADEAD
#define X_NADEAD 1
#endif
#ifndef X_REVL
#define X_REVL 0
#endif
#ifndef X_ATT16
#define X_ATT16 3
#endif
#ifndef X_CLKPROBE
#define X_CLKPROBE 0
#endif
#ifndef X_CLKQ
#define X_CLKQ 250.0f
#endif
#ifndef X_CLKUS
#define X_CLKUS 0
#endif
#ifndef X_CLKBLK
#define X_CLKBLK 0
#endif
struct Args { const float* in[23]; float* xres; float* out; unsigned char* ws; int ph_lo, ph_hi, nl, l_lo, l_hi, sub_lo, sub_hi, region; };

__global__ void __launch_bounds__(NWAVES * 64, 2) mk_fwd(Args args_unused) {
    (void)args_unused;
    typedef const __attribute__((address_space(4))) Args* KArgP;
    const KArgP ka0 = (KArgP)__builtin_amdgcn_kernarg_segment_ptr();
#define KA() ({ KArgP k_ = ka0; asm volatile("" : "+s"(k_)); k_; })

    extern __shared__ __attribute__((aligned(16))) unsigned char lds_raw[];
    LAS unsigned char* lds = (LAS unsigned char*)lds_raw;
    LAS unsigned char* ex = lds + EX_OFF;
    volatile LAS unsigned* MISC = (volatile LAS unsigned*)(lds + MISC_OFF);
    const int wave = __builtin_amdgcn_readfirstlane(threadIdx.x >> 6);
    const int G = gridDim.x, bx = blockIdx.x;
    const int vcu = (G % 8 == 0) ? (bx % 8) * (G / 8) + bx / 8 : bx;
    gu32* ctl = (gu32*)(KA()->ws + WS_CTL);
    for (int u = wave * 64 + lane_id(); u < (LDS_BYTES - MISC_OFF) / 4; u += NWAVES * 64) ((LAS unsigned*)(lds + MISC_OFF))[u] = 0u;
    __syncthreads();
    XcdBarrier bar = xcd_barrier_post((unsigned*)(ctl + CW_BAR) + KA()->region * XCD_BAR_WORDS, MISC + 8, wave);
    const int lo = KA()->ph_lo, hi = KA()->ph_hi;
#define IN(k) (lo <= (k) && (k) < hi)
#define GRID_BAR() xcd_barrier(bar, wave)
#define SEAM(local_ok) do { if (xmode && (local_ok)) xcd_local_barrier(bar, wave, xrank & 3); else xcd_barrier(bar, wave); } while (0)
#define PHASE_PTRS() unsigned char* ws = KA()->ws; asm volatile("" : "+s"(ws)); \
    float* ssq_x = (float*)(ws + WS_SSQX); float* ssq_c = (float*)(ws + WS_SSQC); float* ssq_y = (float*)(ws + WS_SSQY); \
    float* ctab = (float*)(ws + WS_CTAB); float* stab = (float*)(ws + WS_STAB); \
    bf16_t* XB = (bf16_t*)(ws + WS_XB); bf16_t* PROJ = (bf16_t*)(ws + WS_PROJ); bf16_t* QM = (bf16_t*)(ws + WS_QM); bf16_t* KNVM = (bf16_t*)(ws + WS_KNVM); \
    bf16_t* Y = (bf16_t*)(ws + WS_Y); bf16_t* P = (bf16_t*)(ws + WS_P); bf16_t* H = (bf16_t*)(ws + WS_H); \
    (void)ssq_x; (void)ssq_c; (void)ssq_y; (void)ctab; (void)stab; (void)XB; (void)PROJ; (void)QM; (void)KNVM; (void)Y; (void)P; (void)H
#define LAYER_PTRS() PHASE_PTRS(); int l = l0; asm volatile("" : "+s"(l)); unsigned char* wl = ws + WS_W + (size_t)l * W_LAYER; (void)wl
    const int gw = vcu * NWAVES + wave, NGW = G * NWAVES;
    const int nl = KA()->nl;

    for (int rep0_ = 0; rep0_ < (X_REP0 ? 2 : 1); ++rep0_) {
    constexpr int I_IN = 32 * 61, I_UQ = 8 * 24, I_UKV = 4 * 32, I_SQ = 32 * 32, I_G = 32 * 88, I_DN = 88 * 32;
    constexpr int I_LAYER = I_IN + I_UQ + I_UKV + 4 * I_SQ + 2 * I_G + I_DN, I_XKV0 = I_IN + I_UQ + I_UKV + I_SQ;
    if (IN(0)) {
        PHASE_PTRS();
        const int lane = lane_id(), tid = wave * 64 + lane; (void)tid;
        LAS unsigned char* scr = lds + wave * 16384;
#define IT_W0 gw
#define IT_NW NGW
#define IT_N (2 * I_SQ)
#define IT_LO I_XKV0
        for (int it = IT_W0; it < nl * IT_N; it += IT_NW) {
            const int l = it / IT_N; int r = (it % IT_N) + IT_LO;
            unsigned char* wl = ws + WS_W + (size_t)l * W_LAYER; unsigned char* tl = ws + WS_TMP + (size_t)l * T_LAYER;
            if (r < I_IN) { const int kb = r / 61, sb = r % 61;
                tr_item64(KA()->in[3] + (size_t)l * DM * 3904, 3904, DM, (bf16_t*)(wl + WL_IN), sb == 60 ? 1 : 0, KA()->in[2] + l * DM, sb < 16 ? QSC_NA : 1.0f, scr, kb, 64 * sb, 64 * sb, lane); continue; } r -= I_IN;
            if (r < I_UQ) { const int kb = r / 24, sb = r % 24, h = sb / 3, p = sb % 3;
                tr_item64(KA()->in[6] + (size_t)l * 512 * 1536, 1536, 512, (bf16_t*)(wl + WL_UQ), p == 2 ? 1 : 0, KA()->in[4] + l * 512, QSC_MLA, scr, kb, 64 * sb, p == 2 ? 1024 + 64 * h : 128 * h + 64 * p, lane); continue; } r -= I_UQ;
            if (r < I_UKV) { const int kb = r / 32, sb = r % 32, h = sb >> 2, p = sb & 3;
                tr_item64(KA()->in[7] + (size_t)l * 256 * 2048, 2048, 256, (bf16_t*)(wl + WL_UKV), 0, KA()->in[5] + l * 256, 1.0f, scr, kb, 64 * sb, (p >> 1) * 1024 + 128 * h + 64 * (p & 1), lane); continue; } r -= I_UKV;
            if (r < I_SQ) { const int kb = r / 32, sb = r % 32;
                const float* gn = (kb < 16) ? (KA()->in[9] + l * 1024) : (KA()->in[10] + l * 1024 - 1024);
                tr_item64(KA()->in[11] + (size_t)l * DM * DM, DM, DM, (bf16_t*)(wl + WL_OUT), 0, gn, 1.0f, scr, kb, 64 * sb, 64 * sb, lane); continue; } r -= I_SQ;
            if (r < I_SQ) { tr_item64(KA()->in[15] + (size_t)l * DM * DM, DM, DM, (bf16_t*)(tl + TL_XKV), 0, nullptr, 1.0f, scr, r / 32, 64 * (r % 32), 64 * (r % 32), lane); continue; } r -= I_SQ;
            if (r < I_SQ) { tr_item64(KA()->in[16] + (size_t)l * DM * DM, DM, DM, (bf16_t*)(tl + TL_XKV) + (size_t)DM * DM, 0, nullptr, 1.0f, scr, r / 32, 64 * (r % 32), 64 * (r % 32), lane); continue; } r -= I_SQ;
            if (r < I_SQ) { tr_item64(KA()->in[17] + (size_t)l * DM * DM, DM, DM, (bf16_t*)(tl + TL_XO), 0, nullptr, 1.0f, scr, r / 32, 64 * (r % 32), 64 * (r % 32), lane); continue; } r -= I_SQ;
            if (r < 2 * I_G) {
                const int up = r >= I_G; const int q = up ? r - I_G : r; const int kb = q / 88, sb = q % 88;
                tr_item64((up ? KA()->in[20] : KA()->in[19]) + (size_t)l * DM * DFF, DFF, DM, (bf16_t*)(wl + WL_GU), 0, KA()->in[18] + l * DM, 1.0f, scr, kb, 64 * sb, 256 * (sb >> 1) + 128 * up + 64 * (sb & 1), lane); continue; } r -= 2 * I_G;
            tr_item64(KA()->in[21] + (size_t)l * DFF * DM, DM, DFF, (bf16_t*)(wl + WL_DN), 0, nullptr, 1.0f, scr, r / 32, 64 * (r % 32), 64 * (r % 32), lane);
        }

#undef IT_W0
#undef IT_NW
#undef IT_N
#undef IT_LO
        for (int m = gw; m < nl * 256; m += NGW) {
            const int l = m >> 8, row = m & 255;
            const GAS f32x4* xr = (const GAS f32x4*)(KA()->in[1] + (size_t)row * DM) + lane; const GAS f32x4* gr = (const GAS f32x4*)(KA()->in[13] + (size_t)l * DM) + lane;
            f32x4 v[8]; float q = 0.f;
#pragma unroll
            for (int j = 0; j < 8; ++j) { v[j] = xr[64 * j]; q += (v[j][0] * v[j][0] + v[j][1] * v[j][1]) + (v[j][2] * v[j][2] + v[j][3] * v[j][3]); }
            const float rstd = 1.0f / sqrtf(wave_sum(q, lane) * (1.0f / DM) + EPS);
            bf16_t* o = (bf16_t*)(ws + WS_TMP + (size_t)l * T_LAYER + TL_MEMN) + (size_t)row * DM;
#pragma unroll
            for (int j = 0; j < 8; ++j) { const f32x4 gv = gr[64 * j]; u32x2 w; w.x = cvt_pk_bf16(v[j][0] * rstd * gv[0], v[j][1] * rstd * gv[1]); w.y = cvt_pk_bf16(v[j][2] * rstd * gv[2], v[j][3] * rstd * gv[3]);
                *(GAS u32x2*)(o + j * 256 + lane * 4) = w; }
        }
        if (IN(1) || X_REP0) GRID_BAR();
    }
    if (IN(1)) {
        PHASE_PTRS();
        const int nP1 = 16 * nl, split = (G >= 2 * nP1);
        if (bx < nP1 || !split) {
            Gemm g{(const bf16_t*)(ws + WS_TMP + TL_MEMN), (const bf16_t*)(ws + WS_TMP + TL_XKV), DM, DM, DM, (long)(T_LAYER / 2), (long)(T_LAYER / 2)};
            GridOrder So; So.init(1, 16, nl, G, bx);
            EpiRow<0> E{(bf16_t*)(ws + WS_TMP + TL_KVMEM), 4096, (long)(T_LAYER / 2), nullptr, 0, 0.f, 1 << 30, 0, nullptr, nullptr, nullptr, 0, 0};
            gemm_phase<EpiRow<0>, GridOrder>(lds, ex, g, So, E, wave);
        }
        if (bx >= nP1 || !split) {
        const int lane = lane_id(), tid = wave * 64 + lane;
        LAS unsigned char* scr = lds + wave * 16384;
        const int cb = split ? bx - nP1 : bx, NCB = split ? G - nP1 : G;
        const int gwc = cb * NWAVES + wave, NGWC = NCB * NWAVES;
#define IT_W0 gwc
#define IT_NW NGWC
#define IT_N (I_LAYER - 2 * I_SQ)
#define IT_LO 0
        for (int it = IT_W0; it < nl * IT_N; it += IT_NW) {
            const int l = X_REVL ? nl - 1 - it / IT_N : it / IT_N; int r = (it % IT_N) + IT_LO; if (r >= I_XKV0) r += 2 * I_SQ;
            unsigned char* wl = ws + WS_W + (size_t)l * W_LAYER; unsigned char* tl = ws + WS_TMP + (size_t)l * T_LAYER;
            if (r < I_IN) { const int kb = r / 61, sb = r % 61;
                tr_item64(KA()->in[3] + (size_t)l * DM * 3904, 3904, DM, (bf16_t*)(wl + WL_IN), sb == 60 ? 1 : 0, KA()->in[2] + l * DM, sb < 16 ? QSC_NA : 1.0f, scr, kb, 64 * sb, 64 * sb, lane); continue; } r -= I_IN;
            if (r < I_UQ) { const int kb = r / 24, sb = r % 24, h = sb / 3, p = sb % 3;
                tr_item64(KA()->in[6] + (size_t)l * 512 * 1536, 1536, 512, (bf16_t*)(wl + WL_UQ), p == 2 ? 1 : 0, KA()->in[4] + l * 512, QSC_MLA, scr, kb, 64 * sb, p == 2 ? 1024 + 64 * h : 128 * h + 64 * p, lane); continue; } r -= I_UQ;
            if (r < I_UKV) { const int kb = r / 32, sb = r % 32, h = sb >> 2, p = sb & 3;
                tr_item64(KA()->in[7] + (size_t)l * 256 * 2048, 2048, 256, (bf16_t*)(wl + WL_UKV), 0, KA()->in[5] + l * 256, 1.0f, scr, kb, 64 * sb, (p >> 1) * 1024 + 128 * h + 64 * (p & 1), lane); continue; } r -= I_UKV;
            if (r < I_SQ) { const int kb = r / 32, sb = r % 32;
                const float* gn = (kb < 16) ? (KA()->in[9] + l * 1024) : (KA()->in[10] + l * 1024 - 1024);
                tr_item64(KA()->in[11] + (size_t)l * DM * DM, DM, DM, (bf16_t*)(wl + WL_OUT), 0, gn, 1.0f, scr, kb, 64 * sb, 64 * sb, lane); continue; } r -= I_SQ;
            if (r < I_SQ) { tr_item64(KA()->in[15] + (size_t)l * DM * DM, DM, DM, (bf16_t*)(tl + TL_XKV), 0, nullptr, 1.0f, scr, r / 32, 64 * (r % 32), 64 * (r % 32), lane); continue; } r -= I_SQ;
            if (r < I_SQ) { tr_item64(KA()->in[16] + (size_t)l * DM * DM, DM, DM, (bf16_t*)(tl + TL_XKV) + (size_t)DM * DM, 0, nullptr, 1.0f, scr, r / 32, 64 * (r % 32), 64 * (r % 32), lane); continue; } r -= I_SQ;
            if (r < I_SQ) { tr_item64(KA()->in[17] + (size_t)l * DM * DM, DM, DM, (bf16_t*)(tl + TL_XO), 0, nullptr, 1.0f, scr, r / 32, 64 * (r % 32), 64 * (r % 32), lane); continue; } r -= I_SQ;
            if (r < 2 * I_G) {
                const int up = r >= I_G; const int q = up ? r - I_G : r; const int kb = q / 88, sb = q % 88;
                tr_item64((up ? KA()->in[20] : KA()->in[19]) + (size_t)l * DM * DFF, DFF, DM, (bf16_t*)(wl + WL_GU), 0, KA()->in[18] + l * DM, 1.0f, scr, kb, 64 * sb, 256 * (sb >> 1) + 128 * up + 64 * (sb & 1), lane); continue; } r -= 2 * I_G;
            tr_item64(KA()->in[21] + (size_t)l * DFF * DM, DM, DFF, (bf16_t*)(wl + WL_DN), 0, nullptr, 1.0f, scr, r / 32, 64 * (r % 32), 64 * (r % 32), lane);
        }

#undef IT_W0
#undef IT_NW
#undef IT_N
#undef IT_LO
        for (size_t i = (size_t)(cb * (NWAVES * 64) + tid); i < (size_t)nl * 192 * DM / 8; i += (size_t)NCB * NWAVES * 64) {
            const int l = (int)(i / (192 * DM / 8)); const size_t e = (i % (192 * DM / 8)) * 8;
            *(GAS u32x4*)((bf16_t*)(ws + WS_W + (size_t)l * W_LAYER + WL_IN) + (size_t)3904 * DM + e) = (u32x4){0u, 0u, 0u, 0u};
        }
        for (size_t i = (size_t)(cb * (NWAVES * 64) + tid); i < (size_t)nl * DM * DM / 8; i += (size_t)NCB * NWAVES * 64) {
            const int l = (int)(i / ((size_t)DM * DM / 8)); const size_t e = (i % ((size_t)DM * DM / 8)) * 8; const int k = (int)(e / DM);
            const float gsc = ((const GAS float*)KA()->in[12])[l * DM + k] * QSC_X;
            const f32x4 a = *(const GAS f32x4*)(KA()->in[14] + (size_t)l * DM * DM + e), b = *(const GAS f32x4*)(KA()->in[14] + (size_t)l * DM * DM + e + 4);
            *(GAS u32x4*)((bf16_t*)(ws + WS_TMP + (size_t)l * T_LAYER + TL_XQ) + e) = pack8(a * gsc, b * gsc);
        }
        for (int m = gwc; m < S; m += NGWC) {
            const GAS f32x4* xr = (const GAS f32x4*)(KA()->in[0] + (size_t)m * DM) + lane;
#pragma unroll
            for (int j = 0; j < 8; ++j) { const f32x4 v = xr[64 * j];
                float q = (v[0] * v[0] + v[1] * v[1]) + (v[2] * v[2] + v[3] * v[3]);
                q += shx(q, 1, lane); q += shx(q, 2, lane); q += shx(q, 4, lane); q += shx(q, 8, lane);
                if ((lane & 15) == 0) ((GAS float*)ssq_x)[(size_t)m * 32 + j * 4 + (lane >> 4)] = q;
                u32x2 w; w.x = cvt_pk_bf16(v[0], v[1]); w.y = cvt_pk_bf16(v[2], v[3]);
                *(GAS u32x2*)(XB + (size_t)m * DM + j * 256 + lane * 4) = w; }
        }
        for (int idx = cb * (NWAVES * 64) + tid; idx < S * 32; idx += NCB * NWAVES * 64) {
            const int pos = idx >> 5, j = idx & 31;
            const float inv = (float)exp2(-(double)j * (13.287712379549449 / 32.0));
            const float ang = (float)pos * inv;
            const double a = (double)ang;
            const double n = rint(a * 0.63661977236758134);
            const double r = fma(-n, 1.5707963267948966, a) - n * 6.123233995736766e-17;
            const int qd = (int)((long long)n & 3);
            const float rf = (float)r, z = rf * rf;
            const float sn = rf + rf * z * (-1.6666654611e-1f + z * (8.3321608736e-3f + z * -1.9515295891e-4f));
            const float cn = 1.0f - 0.5f * z + z * z * (4.166664568298827e-2f + z * (-1.388731625493765e-3f + z * 2.443315711809948e-5f));
            float c, s;
            if (qd == 0) { s = sn; c = cn; } else if (qd == 1) { s = cn; c = -sn; } else if (qd == 2) { s = -sn; c = -cn; } else { s = -cn; c = sn; }
            ((GAS float*)ctab)[idx] = c; ((GAS float*)stab)[idx] = s;
        }
        }
        if (IN(2)) GRID_BAR();
    }
    }
    if (IN(2)) {
        for (int l0 = 0; l0 < nl; ++l0) {
            LAYER_PTRS(); unsigned char* tl = ws + WS_TMP + (size_t)l * T_LAYER;
            { Gemm g{(const bf16_t*)(tl + TL_KVMEM), (const bf16_t*)(tl + TL_XQ), 4096, DM, 512, 512, 512};
              GridOrder So; So.init(1, 8, 4, G, (bx + G - ((l * 64) % G)) % G);
              EpiRow<0> E{(bf16_t*)(wl + WL_QK), DM, (long)256 * DM, nullptr, 0, 0.f, 1 << 30, 0, nullptr, nullptr, nullptr, 0, 0};
              gemm_phase<EpiRow<0>, GridOrder>(lds, ex, g, So, E, wave); }
            { Gemm g{(const bf16_t*)(tl + TL_XO), (const bf16_t*)(tl + TL_KVMEM) + 2048, DM, 4096, 512, 512, 512};
              GridOrder So; So.init(8, 1, 4, G, (bx + G - ((l * 64 + 32) % G)) % G);
              EpiRow<0> E{(bf16_t*)(wl + WL_VO), 1024, 256, nullptr, 0, 0.f, 1 << 30, 0, nullptr, nullptr, nullptr, 0, 0};
              gemm_phase<EpiRow<0>, GridOrder>(lds, ex, g, So, E, wave); }
        }
    }
    if (IN(3)) {
        const int slo = KA()->sub_lo, shi = KA()->sub_hi;
#define SUB(k) (slo <= (k) && (k) < shi)
        GRID_BAR();
        xcd_topology(bar, wave);
        const int xmode = X_XCDLOCAL ? (int)__builtin_amdgcn_readfirstlane((int)MISC[11]) : 0, xidx = (int)__builtin_amdgcn_readfirstlane((int)MISC[12]), xrank = (int)__builtin_amdgcn_readfirstlane((int)MISC[10]);
#if X_REQUIRE_XMODE
        if (!xmode) return;
#endif
#define ORDER(So, nN_) do { if (xmode) So.init_x(nN_, xidx, xrank); else So.init(S / BM, nN_, 1, G, bx); } while (0)
        for (int l0 = KA()->l_lo; l0 < KA()->l_hi; ++l0) {
            for (int rep_ = 0; rep_ < (X_REPG ? 2 : XREP(0)); ++rep_)
            if (SUB(0)) { LAYER_PTRS();
                Gemm g{XB, (const bf16_t*)(wl + WL_IN), DM, DM, DM, 0, 0};
                GridOrder So; ORDER(So, NPROJ / BM);
                EpiRow<8> E{PROJ, NPROJ, 0, ssq_x, 32, 1.0f / DM, 15, 0, ctab, stab, ssq_c, 12, 15};
                gemm_phase<EpiRow<8>, GridOrder>(lds, ex, g, So, E, wave);
                SEAM(true);
            }
            for (int rep_ = 0; rep_ < (X_REPG ? 2 : XREP(1)); ++rep_)
            if (SUB(1)) { LAYER_PTRS();
                { Gemm g{PROJ + 3072, (const bf16_t*)(wl + WL_UQ), NPROJ, 512, 512, 0, 0};
                  GridOrder So; ORDER(So, 6);
                  EpiRow<2> E{QM, 1536, 0, ssq_c, 16, 1.0f / 512.0f, 4, 1, ctab, stab, nullptr, 0, 0};
                  gemm_phase<EpiRow<2>, GridOrder>(lds, ex, g, So, E, wave); }
                { Gemm g{PROJ + 3584, (const bf16_t*)(wl + WL_UKV), NPROJ, 256, 256, 0, 0};
                  GridOrder So; if (xmode) So.init_x(8, xidx, (xrank + 8) & 31); else So.init(S / BM, 8, 1, G, (bx + G - (192 % G)) % G);
                  EpiRow<1> E{KNVM, 2048, 0, ssq_c + 8, 16, 1.0f / 256.0f, 1 << 30, 0, nullptr, nullptr, nullptr, 0, 0};
                  gemm_phase<EpiRow<1>, GridOrder>(lds, ex, g, So, E, wave); }
                GRID_BAR();
            }
            for (int rep_ = 0; rep_ < ((X_REPATT || (X_REPMASK & 0x304)) ? 2 : 1); ++rep_)
            if (SUB(2)) { LAYER_PTRS();
#if X_CLKPROBE == 2
                const unsigned long long pt0 = __builtin_readcyclecounter(), pr0 = __builtin_amdgcn_s_memrealtime();
#endif
                if (!(X_REPMASK & 0x300) || rep_ == 1 || (X_REPMASK & 0x200))
                for (int u0 = bx; u0 < 256; u0 += G) {
                    const int u = (xmode && X_ATTLOCAL) ? ((4 * xidx + (xrank & 3)) * 8 + (xrank >> 2)) : u0;
                    const int h = u & 7, qb = u >> 3; const size_t row0 = (size_t)qb * 256;
                    att::AttnArgs a{QM + row0 * 1536 + h * 128, QM + row0 * 1536 + 1024 + h * 64, KNVM + h * 128, PROJ + 3840, KNVM + 1024 + h * 128,
                                    Y + row0 * DM + 1024 + h * 128, ssq_y + row0 * 16 + 8 + h, S / 64, 0, 0, nullptr};
                    if (X_ATT16 & 1) att::attn_unit16<0, -1>(a, (LAS char*)lds, wave); else att::attn_unit<0>(a, (LAS char*)lds, wave);
                }
#if X_CLKPROBE == 2
                { const unsigned long long pt1 = __builtin_readcyclecounter(), pr1 = __builtin_amdgcn_s_memrealtime();
                  if (bx == X_CLKBLK && wave == 0 && lane_id() == 0) *(GAS float*)(ws + 60000) = ((X_CLKUS ? (float)(pr1 - pr0) * 0.01f : (float)(pt1 - pt0) / (float)(pr1 - pr0) * 100.f) > X_CLKQ) ? 1000.f : 0.f; }
#endif
                if (!(X_REPMASK & 0x300) || rep_ == 1 || (X_REPMASK & 0x100))
                for (int u0 = bx; u0 < 256; u0 += G) {
                    const int u = (xmode && X_ATTLOCAL) ? ((4 * xidx + (xrank & 3)) * 8 + (xrank >> 2)) : u0;
                    const int h = u & 7, rg = u >> 3, rq0 = 4 * rg; int t0 = rq0 - 4; t0 = t0 < 0 ? 0 : (t0 > 116 ? 116 : t0);
                    const size_t row0 = (size_t)rq0 * 64, key0 = (size_t)t0 * 64;
                    att::AttnArgs a{PROJ + row0 * NPROJ + h * 128, nullptr, PROJ + key0 * NPROJ + 1024 + h * 128, nullptr, PROJ + key0 * NPROJ + 2048 + h * 128,
                                    Y + row0 * DM + h * 128, ssq_y + row0 * 16 + h, 12, rq0, t0, KA()->in[8] + ((size_t)l * 8 + h) * 15 * 31};
                    if (X_ATT16 & 2) { if (X_NADEAD) { if (wave & 1) att::attn_unit16<1, 1>(a, (LAS char*)lds, wave); else att::attn_unit16<1, 0>(a, (LAS char*)lds, wave); } else att::attn_unit16<1, -1>(a, (LAS char*)lds, wave); } else att::attn_unit<1>(a, (LAS char*)lds, wave);
                }
                SEAM(X_ATTLOCAL);
            }
            for (int rep_ = 0; rep_ < XREP(3); ++rep_)
            if (SUB(3)) { LAYER_PTRS(); const bool dummy_ = (rep_ + 1 < XREP(3));
                Gemm g{Y, (const bf16_t*)(wl + WL_OUT), DM, DM, DM, 0, 0};
                GridOrder So; ORDER(So, DM / BM);
                EpiRes<true> E{(l == 0) ? KA()->in[0] : nullptr, XB, dummy_ ? QM : XB, dummy_ ? (float*)KNVM : ssq_x, ssq_y};
                gemm_phase<EpiRes<true>, GridOrder>(lds, ex, g, So, E, wave);
                SEAM(true);
            }
            for (int rep_ = 0; rep_ < (X_REPG ? 2 : XREP(4)); ++rep_)
            if (SUB(4)) { LAYER_PTRS();
                Gemm g{XB, (const bf16_t*)(wl + WL_QK), DM, DM, DM, 0, 0};
                if (xmode && X_BM128) {
                    OneUnit So{2 * (4 * xidx + (xrank & 3)) + ((xrank >> 2) & 1), xrank >> 3, 1};
                    EpiSoftmaxT<1> E{P, ssq_x};
                    gemm_phase128<EpiSoftmaxT<1>, OneUnit>(lds, ex, g, So, E, wave);
                } else {
                GridOrder So; ORDER(So, 4);
                EpiSoftmax E{P, ssq_x};
                gemm_phase<EpiSoftmax, GridOrder>(lds, ex, g, So, E, wave);
                }
                SEAM(true);
            }
            for (int rep_ = 0; rep_ < XREP(5); ++rep_)
            if (SUB(5)) { LAYER_PTRS(); const bool dummy_ = (rep_ + 1 < XREP(5));
                Gemm g{P, (const bf16_t*)(wl + WL_VO), 1024, 1024, (dummy_ && X_DUMMY_K) ? X_DUMMY_K : 1024, 0, 0};
                GridOrder So; ORDER(So, DM / BM);
                EpiRes<false> E{nullptr, XB, dummy_ ? QM : XB, dummy_ ? (float*)KNVM : ssq_x, nullptr};
                gemm_phase<EpiRes<false>, GridOrder>(lds, ex, g, So, E, wave, dummy_ && X_DUMMY_NOEPI);
                SEAM(true);
            }
            for (int rep_ = 0; rep_ < (X_REPG ? 2 : XREP(6)); ++rep_)
            if (SUB(6)) { LAYER_PTRS();
                Gemm g{XB, (const bf16_t*)(wl + WL_GU), DM, DM, DM, 0, 0};
                if (xmode && X_BM128) {
                    { GridOrder So; So.init_x(2 * DFF / BM, xidx, xrank, 160);
                      EpiSwiglu E{H, ssq_x};
                      gemm_phase<EpiSwiglu, GridOrder>(lds, ex, g, So, E, wave); }
                    { OneUnit So{2 * (4 * xidx + (xrank & 3)) + ((xrank >> 2) & 1), 40 + (xrank >> 3), 1};
                      EpiSwigluT<1> E{H, ssq_x, 1};
                      gemm_phase128<EpiSwigluT<1>, OneUnit>(lds, ex, g, So, E, wave); }
                } else {
                GridOrder So; ORDER(So, 2 * DFF / BM);
                EpiSwiglu E{H, ssq_x};
                gemm_phase<EpiSwiglu, GridOrder>(lds, ex, g, So, E, wave);
                }
                SEAM(true);
            }
            for (int rep_ = 0; rep_ < XREP(7); ++rep_)
            if (SUB(7)) { LAYER_PTRS(); const bool dummy_ = (rep_ + 1 < XREP(7));
                Gemm g{H, (const bf16_t*)(wl + WL_DN), DFF, DFF, DFF, 0, 0};
                GridOrder So; ORDER(So, DM / BM);
                EpiRes<false> E{nullptr, XB, dummy_ ? QM : XB, dummy_ ? (float*)KNVM : ssq_x, nullptr};
                gemm_phase<EpiRes<false>, GridOrder>(lds, ex, g, So, E, wave);
                SEAM(shi == 8 && slo == 0 && (l0 + 1 < KA()->l_hi || (X_LOCALFINAL && IN(4))));
            }
        }
#undef SUB
    }
    if (IN(4)) {
        PHASE_PTRS();
        const int lane = lane_id();
        const int xm4 = (X_LOCALFINAL && X_XCDLOCAL && IN(3)) ? (int)__builtin_amdgcn_readfirstlane((int)MISC[11]) : 0;
        const int xi4 = (int)__builtin_amdgcn_readfirstlane((int)MISC[12]), xr4 = (int)__builtin_amdgcn_readfirstlane((int)MISC[10]);
        const int m0 = xm4 ? (4 * xi4 + (xr4 & 3)) * 256 + (xr4 >> 2) * 32 + wave * 4 : gw, m1 = xm4 ? m0 + 4 : S, ms = xm4 ? 1 : NGW;
        for (int m = m0; m < m1; m += ms) {
            const GAS u32x4* xr = (const GAS u32x4*)(XB + (size_t)m * DM) + lane; const GAS f32x4* gr = (const GAS f32x4*)(KA()->in[22]);
            f32x4 v[8]; float q = 0.f;
#pragma unroll
            for (int j = 0; j < 4; ++j) { const u32x4 w = xr[64 * j]; v[2 * j] = (f32x4){bf_lo(w.x), bf_hi(w.x), bf_lo(w.y), bf_hi(w.y)}; v[2 * j + 1] = (f32x4){bf_lo(w.z), bf_hi(w.z), bf_lo(w.w), bf_hi(w.w)}; }
#pragma unroll
            for (int j = 0; j < 8; ++j) q += (v[j][0] * v[j][0] + v[j][1] * v[j][1]) + (v[j][2] * v[j][2] + v[j][3] * v[j][3]);
            const float rstd = 1.0f / sqrtf(wave_sum(q, lane) * (1.0f / DM) + EPS);
            float* o = KA()->out + (size_t)m * DM;
#pragma unroll
            for (int j = 0; j < 4; ++j) { const int c = j * 512 + lane * 8;
                *(GAS f32x4*)(o + c) = v[2 * j] * rstd * gr[c / 4]; *(GAS f32x4*)(o + c + 4) = v[2 * j + 1] * rstd * gr[c / 4 + 1]; }
#if X_CLKPROBE
            if (m == 0 && lane == 0) *(GAS float*)o = *(GAS float*)(ws + 60000);
#endif
        }
    }
#undef IN
#undef GRID_BAR
}
}
#ifndef MK_DEBUG
#define MK_DEBUG 0
#endif
static int mk_setup(int& grid) {
    static int g = 0;
    if (g == 0) {
        int dev = 0, cus = 0, per_cu = 0;
        if (hipGetDevice(&dev) != hipSuccess || hipDeviceGetAttribute(&cus, hipDeviceAttributeMultiprocessorCount, dev) != hipSuccess) { fprintf(stderr, "kernel_launch: device query failed\n"); g = -1; return g; }
        if (hipFuncSetAttribute((const void*)fk::mk_fwd, hipFuncAttributeMaxDynamicSharedMemorySize, fk::LDS_BYTES) != hipSuccess) { fprintf(stderr, "kernel_launch: hipFuncSetAttribute failed\n"); g = -1; return g; }
        if (hipOccupancyMaxActiveBlocksPerMultiprocessor(&per_cu, (const void*)fk::mk_fwd, fk::NWAVES * 64, fk::LDS_BYTES) != hipSuccess || per_cu < 1) { fprintf(stderr, "kernel_launch: occupancy query says %d blocks per CU\n", per_cu); }
        (void)hipGetLastError();
        g = cus;
#ifdef X_FORCE_GRID
        g = X_FORCE_GRID;
#endif
    }
    grid = g; return g;
}
#if MK_DEBUG
namespace dbg {
using namespace fk;
__global__ void cmp_k(int kind, const void* fast, const float* orc, int c0, int c1, double* acc) {
    const int row = blockIdx.x; double e = 0.0, r = 0.0;
    const bf16_t* fb = (const bf16_t*)fast; const float* ff = (const float*)fast;
    const int ncol = kind == 0 ? 2048 : kind == 1 ? 3904 : kind == 2 ? 1536 : kind == 3 ? 2048 : (c1 - c0);
    for (int c = threadIdx.x; c < ncol; c += 256) {
        float f, o;
        if (kind == 0) { f = ff[(size_t)row * 2048 + c]; o = orc[(size_t)row * 2048 + c]; }
        else if (kind == 1) { o = orc[(size_t)row * 3904 + c]; int fc = c; float sc = 1.f;
            if (c < 1024) sc = 1.0f / QSC_NA; else if (c >= 3840) { const int j = c - 3840; fc = 3840 + 2 * (j & 31) + (j >> 5); }
            f = __uint_as_float((unsigned)fb[(size_t)row * 4096 + fc] << 16) * sc; }
        else if (kind == 2) { o = orc[(size_t)row * 1536 + c]; const int h = c / 192, d = c % 192; int fc;
            if (d < 128) fc = h * 128 + d; else { const int j = d - 128; fc = 1024 + h * 64 + 2 * (j & 31) + (j >> 5); }
            f = __uint_as_float((unsigned)fb[(size_t)row * 1536 + fc] << 16) * (1.0f / QSC_MLA); }
        else if (kind == 3) { o = orc[(size_t)row * 2048 + c]; const int h = c / 256, d = c % 256; const int fc = d < 128 ? h * 128 + d : 1024 + h * 128 + (d - 128);
            f = __uint_as_float((unsigned)fb[(size_t)row * 2048 + fc] << 16); }
        else { o = orc[(size_t)row * 2048 + c0 + c]; f = __uint_as_float((unsigned)fb[(size_t)row * 2048 + c0 + c] << 16); }
        const double d = (double)f - (double)o; e += (f == f) ? d * d : 1e30; r += (double)o * (double)o;
    }
    for (int o = 32; o > 0; o >>= 1) { e += __shfl_xor(e, o); r += __shfl_xor(r, o); }
    if ((threadIdx.x & 63) == 0) { atomicAdd(acc, e); atomicAdd(acc + 1, r); }
}
__global__ void fin_k(const double* acc, int nstage, float thr, float* out) {
    if (threadIdx.x == 0 && blockIdx.x == 0) {
        int code = -1;
        for (int s = 0; s < nstage; ++s) { const double e = acc[2 * s], r = acc[2 * s + 1]; if (!(e <= (double)thr * r)) { code = s; break; } }
        if (code >= 0) out[0] += 100.0f * (float)(10 + code);
    }
}
}
#endif

extern "C" void kernel_launch(void* const* d_in, const int* in_sizes, int n_in, void* d_out, int out_size, void* d_ws, size_t ws_size, hipStream_t stream) {
    using namespace fk;
    int grid = 0;
    if (mk_setup(grid) <= 0) return;
    const size_t need = MK_DEBUG ? 1010 * MiB : WS_END;
    if (n_in != 23 || out_size != S * DM || ws_size < need) { fprintf(stderr, "kernel_launch: unexpected shapes n_in %d out %d ws %zu (need %zu)\n", n_in, out_size, ws_size, need); return; }
    unsigned char* ws = (unsigned char*)d_ws;
    if (hipMemsetAsync(ws + WS_CTL, 0, CTL_ZERO_BYTES, stream) != hipSuccess) { fprintf(stderr, "kernel_launch: memset failed\n"); return; }
    Args a{};
    for (int i = 0; i < 23; ++i) a.in[i] = (const float*)d_in[i];
    a.ws = ws;
#if !MK_DEBUG
    a.xres = (float*)d_out; a.out = (float*)d_out;
    a.ph_lo = 0; a.ph_hi = 5; a.nl = 4; a.l_lo = 0; a.l_hi = 4; a.sub_lo = 0; a.sub_hi = 8; a.region = 0;
    hipLaunchKernelGGL(mk_fwd, dim3(grid), dim3(NWAVES * 64), LDS_BYTES, stream, a);
    const hipError_t le = hipPeekAtLastError();
    if (le != hipSuccess) fprintf(stderr, "kernel_launch: launch failed: %s\n", hipGetErrorName(le));
#else
    constexpr int NLD = MK_DEBUG_NL;
    ref::Bufs b;
    b.x = (float*)d_out;
    b.proj = (float*)(ws + 210 * MiB); b.q = (float*)(ws + 338 * MiB);
    b.memn = (float*)(ws + 386 * MiB); b.kmem = (float*)(ws + 388 * MiB); b.vmem = (float*)(ws + 390 * MiB);
    b.ctab = (float*)(ws + 392 * MiB); b.stab = (float*)(ws + 393 * MiB);
    b.kv = (float*)(ws + 752 * MiB); b.y = (float*)(ws + 816 * MiB); b.h = (float*)(ws + 880 * MiB); b.Sb = b.h;
    float* xfast = (float*)(ws + 944 * MiB);
    double* acc = (double*)(ws + 1008 * MiB);
    hipMemsetAsync(acc, 0, 4096, stream);
    a.xres = xfast; a.out = xfast; a.nl = NLD;
    int region = 0;
    auto fast = [&](int plo, int phi, int l, int slo, int shi) { a.ph_lo = plo; a.ph_hi = phi; a.l_lo = l; a.l_hi = l + 1; a.sub_lo = slo; a.sub_hi = shi; a.region = region++;
        hipLaunchKernelGGL(mk_fwd, dim3(grid), dim3(NWAVES * 64), LDS_BYTES, stream, a); };
    int stage = 0;
    auto cmp = [&](int kind, const void* f, const float* o, int c0, int c1) { hipLaunchKernelGGL(dbg::cmp_k, dim3(S), dim3(256), 0, stream, kind, f, o, c0, c1, acc + 2 * stage); ++stage; };
    fast(0, 3, 0, 0, 0);
    hipMemcpyAsync(b.x, d_in[0], (size_t)S * DM * 4, hipMemcpyDeviceToDevice, stream);
    hipLaunchKernelGGL(ref::rope_table_k, dim3(S * 32 / 256), dim3(256), 0, stream, b.ctab, b.stab);
    for (int l = 0; l < 4; ++l) {
        if (l < NLD) {
#if MK_DEBUG == 2
            fast(3, 4, l, 0, 4);
#else
            for (int s = 0; s < 4; ++s) fast(3, 4, l, s, s + 1);
#endif
        }
        ref::mixer(stream, d_in, l, b);
        if (l < NLD) { cmp(1, ws + WS_PROJ, b.proj, 0, 0); cmp(2, ws + WS_QM, b.q, 0, 0); cmp(3, ws + WS_KNVM, b.kv, 0, 0); cmp(4, ws + WS_Y, b.y, 0, 1024); cmp(4, ws + WS_Y, b.y, 1024, 2048); }
        ref::mixer_out(stream, d_in, l, b);
        if (l < NLD) { cmp(0, xfast, b.x, 0, 0);
#if MK_DEBUG == 2
            fast(3, 4, l, 4, 6);
#else
            fast(3, 4, l, 4, 5); fast(3, 4, l, 5, 6);
#endif
        }
        ref::cross(stream, d_in, l, b);
        if (l < NLD) { cmp(0, xfast, b.x, 0, 0);
#if MK_DEBUG == 2
            fast(3, 4, l, 6, 8);
#else
            fast(3, 4, l, 6, 7); fast(3, 4, l, 7, 8);
#endif
        }
        ref::ffn(stream, d_in, l, b);
        if (l < NLD) cmp(0, xfast, b.x, 0, 0);
    }
    hipLaunchKernelGGL(ref::rmsnorm_k, dim3(S), dim3(256), 0, stream, b.x, DM, (const float*)d_in[22], b.x, DM, DM);
    hipLaunchKernelGGL(dbg::fin_k, dim3(1), dim3(64), 0, stream, (const double*)acc, stage, (float)MK_DEBUG_THR, (float*)d_out);
#endif
}
```
